# Optimizing an MI355X kernel written in HIP

```python
import jax, jax.numpy as jnp
from jax import lax
import numpy as np

D_MODEL = 1024
BATCH = 2
SEQ = 8192
DEPTH = 2

EXPAND = 2
D_INNER = EXPAND * D_MODEL
POOL_WINDOWS = (2, 4, 8, 16)
N_POOL_GROUPS = len(POOL_WINDOWS)
POOL_GROUP_DIM = D_INNER // N_POOL_GROUPS
HEAD_DIM = 128
N_HEADS = D_INNER // HEAD_DIM
MOBA_BLOCK = 256
MOBA_TOPK = 3
Q_CHUNK = 16
ROPE_THETA = 10000.0
EPS = 1e-6
N_MIXERS = 2

kernel_name = "hybrid_pool_moba_gated"


def rms_norm(x, g):
    xf = x.astype(jnp.float32)
    y = xf * lax.rsqrt(jnp.mean(xf * xf, axis=-1, keepdims=True) + EPS)
    return (y * g.astype(jnp.float32)).astype(x.dtype)


def rope(x):
    S = x.shape[2]
    inv = ROPE_THETA ** (-jnp.arange(0, HEAD_DIM, 2, dtype=jnp.float32) / HEAD_DIM)
    ang = jnp.arange(S, dtype=jnp.float32)[:, None] * inv[None, :]
    cos, sin = jnp.cos(ang), jnp.sin(ang)
    xf = x.astype(jnp.float32)
    x1, x2 = xf[..., : HEAD_DIM // 2], xf[..., HEAD_DIM // 2:]
    out = jnp.concatenate([x1 * cos - x2 * sin, x2 * cos + x1 * sin], axis=-1)
    return out.astype(x.dtype)


def pool_mixer(u, w_pool, pool_scale):
    B, S, _ = u.shape
    uf = u.astype(jnp.float32).reshape(B, S, N_POOL_GROUPS, POOL_GROUP_DIM)
    cs = jnp.cumsum(uf, axis=1)
    pos = jnp.arange(1, S + 1, dtype=jnp.float32)
    outs = []
    for g, w in enumerate(POOL_WINDOWS):
        cg = cs[:, :, g]
        lag = jnp.pad(cg, ((0, 0), (w, 0), (0, 0)))[:, :S]
        cnt = jnp.minimum(pos, float(w))[None, :, None]
        outs.append((cg - lag) / cnt - uf[:, :, g])
    pooled = jnp.stack(outs, axis=2).astype(u.dtype)
    mixed = jnp.einsum('bsgc,gcd->bsgd', pooled, w_pool).reshape(B, S, D_INNER)
    return mixed * pool_scale


def pool_layer(x, norm_g, w_in, w_pool, pool_scale, w_out):
    h = rms_norm(x, norm_g)
    u, z = jnp.split(h @ w_in, 2, axis=-1)
    y = pool_mixer(u, w_pool, pool_scale) * jax.nn.silu(z)
    return x + y @ w_out


def moba_attention(q, k, v):
    B, H, S, dh = q.shape
    nb = -(-S // MOBA_BLOCK)
    pad = nb * MOBA_BLOCK - S
    kp = jnp.pad(k, ((0, 0), (0, 0), (0, pad), (0, 0)))
    vp = jnp.pad(v, ((0, 0), (0, 0), (0, pad), (0, 0)))
    kb = kp.reshape(B, H, nb, MOBA_BLOCK, dh)
    vb = vp.reshape(B, H, nb, MOBA_BLOCK, dh)
    k_mean = jnp.mean(kb.astype(jnp.float32), axis=3)

    q_blk = jnp.arange(S) // MOBA_BLOCK
    gate = jnp.einsum('bhsd,bhnd->bhsn', q.astype(jnp.float32), k_mean)
    past = jnp.arange(nb)[None, :] < q_blk[:, None]
    gate = jnp.where(past, gate, -jnp.inf)
    n_sel = min(MOBA_TOPK, nb)
    _, sel = lax.top_k(gate, n_sel)
    sel_valid = sel < q_blk[:, None]

    nc = S // Q_CHUNK

    def to_chunks(t):
        return jnp.moveaxis(t.reshape(B, H, nc, Q_CHUNK, *t.shape[3:]), 2, 0)

    scale = HEAD_DIM ** -0.5
    gather = jax.vmap(jax.vmap(lambda blocks, idx: blocks[idx]))

    def chunk_fn(args):
        c, qc, selc, validc = args
        start = c * Q_CHUNK
        own = start // MOBA_BLOCK
        k_own = lax.dynamic_slice_in_dim(kp, own * MOBA_BLOCK, MOBA_BLOCK, axis=2)
        v_own = lax.dynamic_slice_in_dim(vp, own * MOBA_BLOCK, MOBA_BLOCK, axis=2)
        q_pos = start + jnp.arange(Q_CHUNK)
        k_pos = own * MOBA_BLOCK + jnp.arange(MOBA_BLOCK)
        s_own = jnp.einsum('bhqd,bhkd->bhqk', qc, k_own).astype(jnp.float32) * scale
        s_own = jnp.where(k_pos[None, :] <= q_pos[:, None], s_own, -jnp.inf)
        k_sel = gather(kb, selc)
        v_sel = gather(vb, selc)
        s_sel = jnp.einsum('bhqd,bhqnkd->bhqnk', qc, k_sel).astype(jnp.float32) * scale
        s_sel = jnp.where(validc[..., None], s_sel, -jnp.inf)
        s = jnp.concatenate([s_own, s_sel.reshape(B, H, Q_CHUNK, n_sel * MOBA_BLOCK)], axis=-1)
        p = jax.nn.softmax(s, axis=-1).astype(v.dtype)
        p_own = p[..., :MOBA_BLOCK]
        p_sel = p[..., MOBA_BLOCK:].reshape(B, H, Q_CHUNK, n_sel, MOBA_BLOCK)
        return (jnp.einsum('bhqk,bhkd->bhqd', p_own, v_own)
                + jnp.einsum('bhqnk,bhqnkd->bhqd', p_sel, v_sel))

    out = lax.map(chunk_fn, (jnp.arange(nc), to_chunks(q), to_chunks(sel), to_chunks(sel_valid)))
    return jnp.moveaxis(out, 0, 2).reshape(B, H, S, dh)


def moba_layer(x, norm_g, w_in, q_norm, k_norm, w_out):
    B, S, _ = x.shape
    h = rms_norm(x, norm_g)
    q, k, v, z = jnp.split(h @ w_in, 4, axis=-1)

    def heads(t):
        return t.reshape(B, S, N_HEADS, HEAD_DIM).transpose(0, 2, 1, 3)

    q = rope(rms_norm(heads(q), q_norm))
    k = rope(rms_norm(heads(k), k_norm))
    v = heads(v)
    o = moba_attention(q, k, v).transpose(0, 2, 1, 3).reshape(B, S, D_INNER)
    return x + (o * jax.nn.silu(z)) @ w_out


def setup_inputs(seed: int = 0) -> dict:
    key = jax.random.key(seed)
    ks = jax.random.split(key, 12)
    f32 = jnp.float32
    nrm = jax.random.normal
    x = nrm(ks[0], (BATCH, SEQ, D_MODEL), f32)
    norm0 = 1.0 + 0.02 * nrm(ks[1], (D_MODEL,), f32)
    w_in0 = nrm(ks[2], (D_MODEL, 2 * D_INNER), f32) * D_MODEL ** -0.5
    w_pool0 = nrm(ks[3], (N_POOL_GROUPS, POOL_GROUP_DIM, POOL_GROUP_DIM), f32) * POOL_GROUP_DIM ** -0.5
    pool_scale0 = 1.0 + 0.02 * nrm(ks[4], (D_INNER,), f32)
    w_out0 = nrm(ks[5], (D_INNER, D_MODEL), f32) * D_INNER ** -0.5
    norm1 = 1.0 + 0.02 * nrm(ks[6], (D_MODEL,), f32)
    w_in1 = nrm(ks[7], (D_MODEL, 4 * D_INNER), f32) * D_MODEL ** -0.5
    q_norm1 = 1.0 + 0.02 * nrm(ks[8], (HEAD_DIM,), f32)
    k_norm1 = 1.0 + 0.02 * nrm(ks[9], (HEAD_DIM,), f32)
    w_out1 = nrm(ks[10], (D_INNER, D_MODEL), f32) * D_INNER ** -0.5
    return {"x": x,
            "norm0": norm0, "w_in0": w_in0, "w_pool0": w_pool0,
            "pool_scale0": pool_scale0, "w_out0": w_out0,
            "norm1": norm1, "w_in1": w_in1, "q_norm1": q_norm1,
            "k_norm1": k_norm1, "w_out1": w_out1}


def reference(x, norm0, w_in0, w_pool0, pool_scale0, w_out0,
              norm1, w_in1, q_norm1, k_norm1, w_out1):
    layers = (
        (pool_layer, (norm0, w_in0, w_pool0, pool_scale0, w_out0)),
        (moba_layer, (norm1, w_in1, q_norm1, k_norm1, w_out1)),
    )
    for i in range(DEPTH):
        layer_fn, params = layers[i]
        x = layer_fn(x, *params)
    return x
```

```cpp
#include <hip/hip_runtime.h>
#include <hip/hip_cooperative_groups.h>
#include <cstdio>
#include <cstdint>
namespace cg = cooperative_groups;

#define LAS __attribute__((address_space(3)))
typedef unsigned short bf16_t;
typedef short bf16x8 __attribute__((ext_vector_type(8)));
typedef float f32x4 __attribute__((ext_vector_type(4)));
typedef float f32x2 __attribute__((ext_vector_type(2)));
typedef unsigned u32x4 __attribute__((ext_vector_type(4)));
typedef unsigned u32x2 __attribute__((ext_vector_type(2)));

constexpr int SEQ = 8192, NBATCH = 2, M = NBATCH * SEQ, D = 1024, DI = 2048, NH = 16, HD = 128, BLK = 256, NB = SEQ / BLK;
constexpr int NG = 4, HG = NH / NG, GW = HG * HD;
constexpr float EPS = 1e-6f;
constexpr float QSCALE = 0.08838834764831845f * 1.4426950408889634f;

constexpr size_t MiB = 1u << 20;
constexpr size_t WS_CTL = 0, CTL_BYTES = 65536;
constexpr size_t WS_KMEAN = 1 * MiB;
constexpr size_t WS_SEL = 2 * MiB;
constexpr size_t WS_LPART = 3 * MiB;
constexpr size_t WS_TAB = 4 * MiB;
constexpr size_t WS_WIN1 = 8 * MiB, WS_WOUT1 = 24 * MiB;
constexpr size_t WS_LIST = 28 * MiB;
constexpr size_t WS_WIN0 = 28 * MiB, WS_WP = 36 * MiB, WS_WOUT0 = 38 * MiB;
constexpr size_t WS_H0 = 42 * MiB, WS_POOLED = 42 * MiB, WS_U = 106 * MiB, WS_SZ0 = 170 * MiB;
constexpr size_t WS_H1 = 32 * MiB, WS_QG = 64 * MiB, WS_KG = 80 * MiB, WS_VG = 96 * MiB, WS_SZG = 112 * MiB;
constexpr size_t WS_OPART = 128 * MiB, WS_A = 192 * MiB, WS_END = 256 * MiB;

constexpr int LDS_BYTES = 140 * 1024;
constexpr int NTHREADS = 512;
#ifndef PH_MASK
#define PH_MASK 0xfff
#endif

__device__ __forceinline__ unsigned cvt_pk_bf16(float lo, float hi) { unsigned r; asm volatile("v_cvt_pk_bf16_f32 %0, %1, %2" : "=v"(r) : "v"(lo), "v"(hi)); return r; }
__device__ __forceinline__ float bf_lo(unsigned u) { return __uint_as_float(u << 16); }
__device__ __forceinline__ float bf_hi(unsigned u) { return __uint_as_float(u & 0xffff0000u); }
__device__ __forceinline__ float silu_f(float z) { return z * __builtin_amdgcn_rcpf(1.0f + __builtin_amdgcn_exp2f(-1.4426950408889634f * z)); }
__device__ __forceinline__ float wave_sum(float v) {
#pragma unroll
    for (int o = 1; o < 64; o <<= 1) v += __shfl_xor(v, o);
    return v;
}

namespace pg8 {
constexpr int BM = 256, BK = 64, HALF = 128, HTB = HALF * BK * 2, STAGE_BYTES = 8 * HTB, NXCD = 8, WGM = 8;
__host__ __device__ __forceinline__ int lds_byte(int r, int c) { const int st = (r >> 4) * 2 + (c >> 5), rr = r & 15, cc = c & 31, ob = rr * 64 + cc * 2; return st * 1024 + (ob ^ (((ob >> 9) & 1) << 5)); }
__host__ __device__ __forceinline__ void stage_rc(int b, int& R, int& C) { const int st = b / 1024, sb = b % 1024, swz = sb ^ (((sb >> 9) & 1) << 5); R = (st >> 1) * 16 + swz / 64; C = (st & 1) * 32 + (swz % 64) / 2; }
__host__ __device__ __forceinline__ int perm32(int rho) { const int n = rho >> 4, i = rho & 15; return 8 * (i >> 2) + 4 * n + (i & 3); }

struct Unit { int pm, pn; };
template <int LDA_, int LDB_, int K_> struct Gemm { const bf16_t* A; const bf16_t* Bt; static constexpr int lda = LDA_, ldb = LDB_, K = K_; };
struct StaticOrder {
    int nM, nN, nwg, G, c;
    __device__ void init(int M_, int N_, int G_, int c_) { nM = M_ / BM; nN = N_ / BM; nwg = nM * nN; G = G_; c = c_; }
    __device__ bool next(int i, Unit& u) const {
        const long L = (long)i * G + c; if (L >= nwg) return false;
        int wgid = (int)L; { const int q = nwg / NXCD, r = nwg % NXCD, xcd = wgid % NXCD, off = wgid / NXCD; wgid = (xcd < r ? xcd * (q + 1) : r * (q + 1) + (xcd - r) * q) + off; }
        const int nig = WGM * nN, gid = wgid / nig, fm = gid * WGM, gsz = (nM - fm) < WGM ? (nM - fm) : WGM;
        u.pm = fm + ((wgid % nig) % gsz); u.pn = (wgid % nig) / gsz; return true;
    }
};
template <class Epi, class Map, class GemmT>
__device__ __forceinline__ void gemm_phase(LAS unsigned char* lds, const GemmT g, const StaticOrder& S, const Map& MP, const Epi& E) {
    int tid_ = threadIdx.x; asm volatile("" : "+v"(tid_));
    const int tid = tid_, wid = __builtin_amdgcn_readfirstlane(tid >> 6), lane = tid & 63, wr = wid >> 2, wc = wid & 3, fr = lane & 15, fq = lane >> 4;
    constexpr int K = GemmT::K, nt = K / BK;
    unsigned voffA[2], voffB[2];
#pragma unroll
    for (int i = 0; i < 2; ++i) { int R, C; stage_rc(tid * 16 + i * 8192, R, C); const int Rb = Epi::PERM ? ((R & ~31) + perm32(R & 31)) : R;
        voffA[i] = (unsigned)(R * GemmT::lda + C) * 2u; voffB[i] = (unsigned)(Rb * GemmT::ldb + C) * 2u; }
    constexpr size_t kstep = (size_t)(BK * 2);
    constexpr size_t hstepA = (size_t)HALF * GemmT::lda * 2, hstepB = (size_t)HALF * GemmT::ldb * 2;
    const unsigned ldsw = (unsigned)wid * 1024u;
    const int aoff = lds_byte(wr * 64 + fr, fq * 8), boff = lds_byte(wc * 32 + fr, fq * 8);
#define PG8_SA(b, h) (((b) * 2 + (h)) * HTB)
#define PG8_SB(b, h) ((4 + (b) * 2 + (h)) * HTB)
#define PG8_STAGE(bufoff, gbase, voff) do { _Pragma("unroll") for (int _i = 0; _i < 2; ++_i) \
        __builtin_amdgcn_global_load_lds((const unsigned*)((const char*)(gbase) + (voff)[_i]), (LAS unsigned*)(lds + (bufoff) + ldsw + _i * 8192), 16, 0, 0); } while (0)
#define PG8_LDA(dst, b, h) do { _Pragma("unroll") for (int m = 0; m < 4; ++m) _Pragma("unroll") for (int k = 0; k < 2; ++k) dst[m][k] = *(const LAS bf16x8*)(lds + PG8_SA(b, h) + aoff + m * 2048 + k * 1024); } while (0)
#define PG8_LDB(dst, b, h) do { _Pragma("unroll") for (int n = 0; n < 2; ++n) _Pragma("unroll") for (int k = 0; k < 2; ++k) dst[n][k] = *(const LAS bf16x8*)(lds + PG8_SB(b, h) + boff + n * 2048 + k * 1024); } while (0)
#define PG8_MMA(ai, bj, At, Bt) do { __builtin_amdgcn_s_setprio(1); _Pragma("unroll") for (int m = 0; m < 4; ++m) _Pragma("unroll") for (int n = 0; n < 2; ++n) _Pragma("unroll") for (int k = 0; k < 2; ++k) \
        acc[ai][bj][m][n] = __builtin_amdgcn_mfma_f32_16x16x32_bf16(Bt[n][k], At[m][k], acc[ai][bj][m][n], 0, 0, 0); __builtin_amdgcn_s_setprio(0); } while (0)
#define PG8_WAIT_V(n) asm volatile("s_waitcnt vmcnt(" #n ")" ::: "memory")
#define PG8_WAIT_L(n) asm volatile("s_waitcnt lgkmcnt(" #n ")" ::: "memory")
#define PG8_BAR __builtin_amdgcn_s_barrier()
#define PG8_SCHED __builtin_amdgcn_sched_barrier(0)
    Unit cur, nxt; int ui = 0;
    if (!S.next(0, cur)) return;
    f32x4 acc[2][2][4][2];
#pragma unroll
    for (int a = 0; a < 2; ++a)
#pragma unroll
        for (int b = 0; b < 2; ++b)
#pragma unroll
            for (int m = 0; m < 4; ++m)
#pragma unroll
                for (int n = 0; n < 2; ++n) acc[a][b][m][n] = (f32x4){0.f, 0.f, 0.f, 0.f};
    bf16x8 At[4][2], B0[2][2], B1[2][2];
    const char* cA = (const char*)(g.A + MP.a_off(cur)); const char* cB = (const char*)(g.Bt + MP.b_off(cur));
    PG8_STAGE(PG8_SB(0, 0), cB, voffB); PG8_STAGE(PG8_SB(0, 1), cB + hstepB, voffB); PG8_STAGE(PG8_SA(0, 0), cA, voffA); PG8_STAGE(PG8_SA(0, 1), cA + hstepA, voffA);
    if (wr == 1) PG8_BAR;
    PG8_WAIT_V(2); PG8_BAR;
    PG8_STAGE(PG8_SB(1, 0), cB + kstep, voffB); PG8_STAGE(PG8_SA(1, 0), cA + kstep, voffA); PG8_STAGE(PG8_SB(1, 1), cB + hstepB + kstep, voffB);
    PG8_WAIT_V(6); PG8_BAR;
    for (;;) {
        const bool has_next = S.next(ui + 1, nxt);
        const char* nA = has_next ? (const char*)(g.A + MP.a_off(nxt)) : cA; const char* nB = has_next ? (const char*)(g.Bt + MP.b_off(nxt)) : cB;
        for (int t = 0; t < nt; t += 2) {
            const bool last = (t == nt - 2);
            const char* a1 = cA + (size_t)(t + 1) * kstep;
            const char* a2 = last ? nA : cA + (size_t)(t + 2) * kstep; const char* b2 = last ? nB : cB + (size_t)(t + 2) * kstep;
            const char* a3 = a2 + kstep; const char* b3 = b2 + kstep;
            PG8_LDB(B0, 0, 0); PG8_LDB(B1, 0, 1); PG8_SCHED; PG8_LDA(At, 0, 0); PG8_STAGE(PG8_SA(1, 1), a1 + hstepA, voffA);
            PG8_WAIT_V(8); PG8_WAIT_L(0); PG8_BAR; PG8_MMA(0, 0, At, B0); PG8_MMA(0, 1, At, B1); PG8_BAR; PG8_SCHED;
            PG8_LDA(At, 0, 1); PG8_STAGE(PG8_SB(0, 0), b2, voffB); PG8_STAGE(PG8_SB(0, 1), b2 + hstepB, voffB); PG8_STAGE(PG8_SA(0, 0), a2, voffA);
            PG8_WAIT_V(8); PG8_WAIT_L(0); PG8_BAR; PG8_MMA(1, 0, At, B0); PG8_MMA(1, 1, At, B1); PG8_BAR; PG8_SCHED;
            PG8_LDB(B0, 1, 0); PG8_LDB(B1, 1, 1); PG8_SCHED; PG8_LDA(At, 1, 0); PG8_STAGE(PG8_SA(0, 1), a2 + hstepA, voffA);
            PG8_WAIT_V(8); PG8_WAIT_L(0); PG8_BAR; PG8_MMA(0, 0, At, B0); PG8_MMA(0, 1, At, B1); PG8_BAR; PG8_SCHED;
            PG8_LDA(At, 1, 1); PG8_STAGE(PG8_SB(1, 0), b3, voffB); PG8_STAGE(PG8_SB(1, 1), b3 + hstepB, voffB); PG8_STAGE(PG8_SA(1, 0), a3, voffA);
            PG8_WAIT_V(8); PG8_WAIT_L(0); PG8_BAR; PG8_MMA(1, 0, At, B0); PG8_MMA(1, 1, At, B1); PG8_BAR; PG8_SCHED;
        }
        if (wr == 0) PG8_BAR;
        E(acc, cur, wr, wc, fr, fq);
        if (!has_next) break;
#pragma unroll
        for (int a = 0; a < 2; ++a)
#pragma unroll
            for (int b = 0; b < 2; ++b)
#pragma unroll
                for (int m = 0; m < 4; ++m)
#pragma unroll
                    for (int n = 0; n < 2; ++n) acc[a][b][m][n] = (f32x4){0.f, 0.f, 0.f, 0.f};
        cur = nxt; cA = nA; cB = nB; ++ui;
        if (wr == 1) PG8_BAR;
    }
    PG8_WAIT_V(0);
    PG8_BAR;
#undef PG8_SA
#undef PG8_SB
#undef PG8_STAGE
#undef PG8_LDA
#undef PG8_LDB
#undef PG8_MMA
#undef PG8_WAIT_V
#undef PG8_WAIT_L
#undef PG8_BAR
#undef PG8_SCHED
}

template <int ldc, int tiles_per_dst, int silu_dst> struct EpiSplit {
    static constexpr bool PERM = true;
    bf16_t *d0, *d1, *d2, *d3;
    __device__ __forceinline__ void operator()(const f32x4 (&acc)[2][2][4][2], const Unit& u, int wr, int wc, int fr, int fq) const {
        const int di = u.pn / tiles_per_dst, ct = u.pn - di * tiles_per_dst;
        bf16_t* base = di == 0 ? d0 : di == 1 ? d1 : di == 2 ? d2 : d3; const bool act = (di == silu_dst);
        const int row0 = u.pm * BM + wr * 64 + fr, col0 = ct * BM + wc * 32 + 8 * fq;
#pragma unroll
        for (int ai = 0; ai < 2; ++ai)
#pragma unroll
            for (int m = 0; m < 4; ++m) { bf16_t* rowp = base + (size_t)(row0 + ai * HALF + m * 16) * ldc + col0;
#pragma unroll
                for (int bj = 0; bj < 2; ++bj) { f32x4 v0 = acc[ai][bj][m][0], v1 = acc[ai][bj][m][1];
                    if (act) { v0 = (f32x4){silu_f(v0[0]), silu_f(v0[1]), silu_f(v0[2]), silu_f(v0[3])}; v1 = (f32x4){silu_f(v1[0]), silu_f(v1[1]), silu_f(v1[2]), silu_f(v1[3])}; }
                    u32x4 w; w.x = cvt_pk_bf16(v0[0], v0[1]); w.y = cvt_pk_bf16(v0[2], v0[3]); w.z = cvt_pk_bf16(v1[0], v1[1]); w.w = cvt_pk_bf16(v1[2], v1[3]);
                    *(u32x4*)(rowp + bj * HALF) = w; } }
    }
};
struct EpiGate {
    static constexpr bool PERM = true; static constexpr int ldc = DI;
    bf16_t* Y; const bf16_t* SZ; const float* scale;
    __device__ __forceinline__ void operator()(const f32x4 (&acc)[2][2][4][2], const Unit& u, int wr, int wc, int fr, int fq) const {
        const int row0 = u.pm * BM + wr * 64 + fr, col0 = u.pn * BM + wc * 32 + 8 * fq;
        f32x4 sc[2][2];
#pragma unroll
        for (int bj = 0; bj < 2; ++bj) { sc[bj][0] = *(const f32x4*)(scale + col0 + bj * HALF); sc[bj][1] = *(const f32x4*)(scale + col0 + bj * HALF + 4); }
#pragma unroll
        for (int ai = 0; ai < 2; ++ai)
#pragma unroll
            for (int m = 0; m < 4; ++m) { const size_t off = (size_t)(row0 + ai * HALF + m * 16) * ldc + col0;
#pragma unroll
                for (int bj = 0; bj < 2; ++bj) { const u32x4 z = *(const u32x4*)(SZ + off + bj * HALF);
                    const f32x4 v0 = acc[ai][bj][m][0] * sc[bj][0], v1 = acc[ai][bj][m][1] * sc[bj][1];
                    u32x4 w; w.x = cvt_pk_bf16(v0[0] * bf_lo(z.x), v0[1] * bf_hi(z.x)); w.y = cvt_pk_bf16(v0[2] * bf_lo(z.y), v0[3] * bf_hi(z.y));
                    w.z = cvt_pk_bf16(v1[0] * bf_lo(z.z), v1[1] * bf_hi(z.z)); w.w = cvt_pk_bf16(v1[2] * bf_lo(z.w), v1[3] * bf_hi(z.w));
                    *(u32x4*)(Y + off + bj * HALF) = w; } }
    }
};
struct EpiRes {
    static constexpr bool PERM = false; static constexpr int ldc = D;
    const float* base; float* out;
    __device__ __forceinline__ void operator()(const f32x4 (&acc)[2][2][4][2], const Unit& u, int wr, int wc, int fr, int fq) const {
        const int row0 = u.pm * BM + wr * 64 + fr, col0 = u.pn * BM + wc * 32 + 4 * fq;
#pragma unroll
        for (int ai = 0; ai < 2; ++ai)
#pragma unroll
            for (int m = 0; m < 4; ++m) { const size_t off = (size_t)(row0 + ai * HALF + m * 16) * ldc + col0;
#pragma unroll
                for (int bj = 0; bj < 2; ++bj)
#pragma unroll
                    for (int n = 0; n < 2; ++n) { const f32x4 b = *(const f32x4*)(base + off + bj * HALF + n * 16); *(f32x4*)(out + off + bj * HALF + n * 16) = b + acc[ai][bj][m][n]; } }
    }
};
template <int lda, int ldb> struct MapPlain { __device__ __forceinline__ size_t a_off(const Unit& u) const { return (size_t)u.pm * BM * lda; } __device__ __forceinline__ size_t b_off(const Unit& u) const { return (size_t)u.pn * BM * ldb; } };
struct MapPool { __device__ __forceinline__ size_t a_off(const Unit& u) const { return (size_t)u.pm * BM * DI + (size_t)(u.pn >> 1) * 512; } __device__ __forceinline__ size_t b_off(const Unit& u) const { return (size_t)u.pn * BM * 512; } };
struct MapQkvz { int g; __device__ __forceinline__ size_t a_off(const Unit& u) const { return (size_t)u.pm * BM * D; } __device__ __forceinline__ size_t b_off(const Unit& u) const { return (size_t)((u.pn >> 1) * DI + g * GW + (u.pn & 1) * BM) * D; } };
}

struct Args { const float* in[11]; float* out; unsigned char* ws; int ph_lo, ph_hi, coop, pad; };

__device__ __forceinline__ void transpose_item(const float* W, int K, int N, bf16_t* WT, LAS float* scr, int item, int lane) {
    const int nblk = N / 32, kb = item / nblk, nb = item % nblk, k0 = 64 * kb, n0 = 32 * nb;
#pragma unroll 8
    for (int i = 0; i < 32; ++i) { const int kk = 2 * i + (lane >> 5); scr[kk * 33 + (lane & 31)] = W[(size_t)(k0 + kk) * N + n0 + (lane & 31)]; }
    asm volatile("s_waitcnt lgkmcnt(0)" ::: "memory");
    const int c = lane & 7;
#pragma unroll
    for (int j = 0; j < 4; ++j) { const int n = (lane >> 3) + 8 * j; const LAS float* s = scr + (8 * c) * 33 + n;
        u32x4 o; o.x = cvt_pk_bf16(s[0 * 33], s[1 * 33]); o.y = cvt_pk_bf16(s[2 * 33], s[3 * 33]); o.z = cvt_pk_bf16(s[4 * 33], s[5 * 33]); o.w = cvt_pk_bf16(s[6 * 33], s[7 * 33]);
        *(u32x4*)(WT + (size_t)(n0 + n) * K + k0 + 8 * c) = o; }
    asm volatile("s_waitcnt lgkmcnt(0)" ::: "memory");
}
__device__ __forceinline__ void rms_row(const float* xrow, const float* gain, bf16_t* orow, int lane) {
    const f32x4* xr = (const f32x4*)xrow + lane; const f32x4* gr = (const f32x4*)gain + lane;
    f32x4 v[4]; float s = 0.f;
#pragma unroll
    for (int j = 0; j < 4; ++j) { v[j] = xr[64 * j]; s += (v[j].x * v[j].x + v[j].y * v[j].y) + (v[j].z * v[j].z + v[j].w * v[j].w); }
    const float rstd = 1.0f / sqrtf(wave_sum(s) * (1.f / D) + EPS);
    u32x2* o8 = (u32x2*)orow + lane;
#pragma unroll
    for (int j = 0; j < 4; ++j) { const f32x4 gg = gr[64 * j]; u32x2 w; w.x = cvt_pk_bf16(v[j].x * rstd * gg.x, v[j].y * rstd * gg.y); w.y = cvt_pk_bf16(v[j].z * rstd * gg.z, v[j].w * rstd * gg.w); o8[64 * j] = w; }
}
__device__ __forceinline__ void rope_entry(int idx, f32x2* tab) {
    const int pos = idx >> 6, i = idx & 63;
    const float inv = (float)exp2(-(double)(2 * i) * (13.287712379549449 / 128.0));
    const float angf = (float)pos * inv;
    const double a = (double)angf; const double q = rint(a * 0.6366197723675814); const double r = a - q * 1.5707963267948966;
    const double r2 = r * r;
    double sn = r * (1.0 - r2 / 6.0 * (1.0 - r2 / 20.0 * (1.0 - r2 / 42.0 * (1.0 - r2 / 72.0 * (1.0 - r2 / 110.0 * (1.0 - r2 / 156.0))))));
    double cs = 1.0 - r2 / 2.0 * (1.0 - r2 / 12.0 * (1.0 - r2 / 30.0 * (1.0 - r2 / 56.0 * (1.0 - r2 / 90.0 * (1.0 - r2 / 132.0)))));
    const int qi = ((int)q) & 3;
    double c2, s2;
    if (qi == 0) { c2 = cs; s2 = sn; } else if (qi == 1) { c2 = -sn; s2 = cs; } else if (qi == 2) { c2 = -cs; s2 = -sn; } else { c2 = sn; s2 = -cs; }
    tab[idx] = (f32x2){(float)c2, (float)s2};
}

__global__ void __launch_bounds__(NTHREADS, 2) mega_fwd(Args args) {
    extern __shared__ __attribute__((aligned(16))) unsigned char lds_raw[];
    LAS unsigned char* lds = (LAS unsigned char*)lds_raw;
    cg::grid_group grid = cg::this_grid();
    const int G = gridDim.x, bx = blockIdx.x;
    unsigned char* ws = args.ws;
#define XIN (args.in[0])
#define norm0 (args.in[1])
#define w_in0 (args.in[2])
#define w_pool0 (args.in[3])
#define pool_scale0 (args.in[4])
#define w_out0 (args.in[5])
#define norm1 (args.in[6])
#define w_in1 (args.in[7])
#define q_norm1 (args.in[8])
#define k_norm1 (args.in[9])
#define w_out1 (args.in[10])
    float* out = args.out;
#define WIN0 ((bf16_t*)(ws + WS_WIN0))
#define WP ((bf16_t*)(ws + WS_WP))
#define WOUT0 ((bf16_t*)(ws + WS_WOUT0))
#define WIN1 ((bf16_t*)(ws + WS_WIN1))
#define WOUT1 ((bf16_t*)(ws + WS_WOUT1))
#define H0 ((bf16_t*)(ws + WS_H0))
#define POOLED ((bf16_t*)(ws + WS_POOLED))
#define U ((bf16_t*)(ws + WS_U))
#define SZ0 ((bf16_t*)(ws + WS_SZ0))
#define H1 ((bf16_t*)(ws + WS_H1))
#define QG ((bf16_t*)(ws + WS_QG))
#define KG ((bf16_t*)(ws + WS_KG))
#define VG ((bf16_t*)(ws + WS_VG))
#define SZG ((bf16_t*)(ws + WS_SZG))
#define OPART ((bf16_t*)(ws + WS_OPART))
#define AT ((bf16_t*)(ws + WS_A))
#define KMEAN ((float*)(ws + WS_KMEAN))
#define SEL ((unsigned*)(ws + WS_SEL))
#define LPART ((float*)(ws + WS_LPART))
#define TAB ((f32x2*)(ws + WS_TAB))
#define LIST ((unsigned short*)(ws + WS_LIST))
#define CNT ((unsigned*)(ws + WS_CTL))
    const int lo = args.ph_lo, hi = args.ph_hi;
#define IN(k) (lo <= (k) && (k) < hi)
#define SYNC(k) do { if (IN(k) && IN((k) + 1) && args.coop) grid.sync(); } while (0)
    {
        if (IN(0) && (PH_MASK & 1)) {
            int tid = threadIdx.x; asm volatile("" : "+v"(tid)); const int lane = tid & 63, wave = __builtin_amdgcn_readfirstlane(tid >> 6); (void)lane; (void)wave;
            LAS float* scr = (LAS float*)(lds + wave * 16384);
            const int gw = bx * 8 + wave, NGW = G * 8;
            constexpr int I0 = (D / 64) * (2 * DI / 32), IP = (512 / 64) * (512 / 32), I1 = (DI / 64) * (D / 32), I2 = (D / 64) * (4 * DI / 32), I3 = I1;
            constexpr int NITEMS = I0 + 4 * IP + I1 + I2 + I3;
            for (int it = gw; it < NITEMS; it += NGW) {
                int r = it;
                if (r < I0) { transpose_item(w_in0, D, 2 * DI, WIN0, scr, r, lane); continue; } r -= I0;
                if (r < 4 * IP) { const int gp = r / IP; transpose_item(w_pool0 + (size_t)gp * 512 * 512, 512, 512, WP + (size_t)gp * 512 * 512, scr, r - gp * IP, lane); continue; } r -= 4 * IP;
                if (r < I1) { transpose_item(w_out0, DI, D, WOUT0, scr, r, lane); continue; } r -= I1;
                if (r < I2) { transpose_item(w_in1, D, 4 * DI, WIN1, scr, r, lane); continue; } r -= I2;
                transpose_item(w_out1, DI, D, WOUT1, scr, r, lane);
            }
            for (int idx = bx * NTHREADS + tid; idx < SEQ * 64; idx += G * NTHREADS) rope_entry(idx, TAB);
            for (int m = gw; m < M; m += NGW) rms_row(XIN + (size_t)m * D, norm0, H0 + (size_t)m * D, lane);
        }
        SYNC(0);
        if (IN(1) && (PH_MASK & 2)) {
            int tid = threadIdx.x; asm volatile("" : "+v"(tid)); const int lane = tid & 63, wave = __builtin_amdgcn_readfirstlane(tid >> 6); (void)lane; (void)wave;
            pg8::Gemm<D, D, D> g{H0, WIN0}; pg8::StaticOrder S; S.init(M, 2 * DI, G, bx);
            pg8::EpiSplit<DI, 8, 1> E{U, SZ0, U, U}; pg8::MapPlain<D, D> MP;
            pg8::gemm_phase(lds, g, S, MP, E);
        }
        SYNC(1);
        if (IN(2) && (PH_MASK & 4)) {
            int tid = threadIdx.x; asm volatile("" : "+v"(tid)); const int lane = tid & 63, wave = __builtin_amdgcn_readfirstlane(tid >> 6); (void)lane; (void)wave;
            const int cgp = tid & 255, hh = tid >> 8, col = cgp * 8, w = 2 << (cgp >> 6);
            for (int unit = bx; unit < M / 64; unit += G) {
                const int r0 = unit * 64 + hh * 32, p0 = r0 & (SEQ - 1);
                float sum[8];
#pragma unroll
                for (int e = 0; e < 8; ++e) sum[e] = 0.f;
                for (int i = 1; i < w; ++i) { if (p0 - i >= 0) { const u32x4 v = *(const u32x4*)(U + (size_t)(r0 - i) * DI + col);
                    sum[0] += bf_lo(v.x); sum[1] += bf_hi(v.x); sum[2] += bf_lo(v.y); sum[3] += bf_hi(v.y); sum[4] += bf_lo(v.z); sum[5] += bf_hi(v.z); sum[6] += bf_lo(v.w); sum[7] += bf_hi(v.w); } }
                for (int t = 0; t < 32; ++t) {
                    const int p = p0 + t; const u32x4 v = *(const u32x4*)(U + (size_t)(r0 + t) * DI + col);
                    float c[8] = {bf_lo(v.x), bf_hi(v.x), bf_lo(v.y), bf_hi(v.y), bf_lo(v.z), bf_hi(v.z), bf_lo(v.w), bf_hi(v.w)};
                    const float rc = 1.0f / (float)((p + 1) < w ? (p + 1) : w);
                    float o[8];
#pragma unroll
                    for (int e = 0; e < 8; ++e) { sum[e] += c[e]; o[e] = sum[e] * rc - c[e]; }
                    u32x4 wv; wv.x = cvt_pk_bf16(o[0], o[1]); wv.y = cvt_pk_bf16(o[2], o[3]); wv.z = cvt_pk_bf16(o[4], o[5]); wv.w = cvt_pk_bf16(o[6], o[7]);
                    *(u32x4*)(POOLED + (size_t)(r0 + t) * DI + col) = wv;
                    if (p - w + 1 >= 0) { const u32x4 q = *(const u32x4*)(U + (size_t)(r0 + t - w + 1) * DI + col);
                        sum[0] -= bf_lo(q.x); sum[1] -= bf_hi(q.x); sum[2] -= bf_lo(q.y); sum[3] -= bf_hi(q.y); sum[4] -= bf_lo(q.z); sum[5] -= bf_hi(q.z); sum[6] -= bf_lo(q.w); sum[7] -= bf_hi(q.w); }
                }
            }
        }
        SYNC(2);
        if (IN(3) && (PH_MASK & 8)) {
            int tid = threadIdx.x; asm volatile("" : "+v"(tid)); const int lane = tid & 63, wave = __builtin_amdgcn_readfirstlane(tid >> 6); (void)lane; (void)wave;
            pg8::Gemm<DI, 512, 512> g{POOLED, WP}; pg8::StaticOrder S; S.init(M, DI, G, bx);
            pg8::EpiGate E{U, SZ0, pool_scale0}; pg8::MapPool MP;
            pg8::gemm_phase(lds, g, S, MP, E);
        }
        SYNC(3);
        if (IN(4) && (PH_MASK & 16)) {
            int tid = threadIdx.x; asm volatile("" : "+v"(tid)); const int lane = tid & 63, wave = __builtin_amdgcn_readfirstlane(tid >> 6); (void)lane; (void)wave;
            pg8::Gemm<DI, DI, DI> g{U, WOUT0}; pg8::StaticOrder S; S.init(M, D, G, bx);
            pg8::EpiRes E{XIN, out}; pg8::MapPlain<DI, DI> MP;
            pg8::gemm_phase(lds, g, S, MP, E);
        }
        SYNC(4);
        if (IN(5) && (PH_MASK & 32)) {
            int tid = threadIdx.x; asm volatile("" : "+v"(tid)); const int lane = tid & 63, wave = __builtin_amdgcn_readfirstlane(tid >> 6); (void)lane; (void)wave;
            const int gw = bx * 8 + wave, NGW = G * 8;
            for (int m = gw; m < M; m += NGW) rms_row(out + (size_t)m * D, norm1, H1 + (size_t)m * D, lane);
        }
        SYNC(5);
#pragma unroll
        for (int g = 0; g < NG; ++g) {
            const int pb = 6 + 5 * g;
            if (IN(pb) && (PH_MASK & 64)) {
            int tid = threadIdx.x; asm volatile("" : "+v"(tid)); const int lane = tid & 63, wave = __builtin_amdgcn_readfirstlane(tid >> 6); (void)lane; (void)wave;
                pg8::Gemm<D, D, D> gm{H1, WIN1}; pg8::StaticOrder S; S.init(M, 4 * GW, G, bx);
                pg8::EpiSplit<GW, 2, 3> E{QG, KG, VG, SZG}; pg8::MapQkvz MP{g};
                pg8::gemm_phase(lds, gm, S, MP, E);
            }
            SYNC(pb);
            if (IN(pb + 1) && (PH_MASK & 128)) {
            int tid = threadIdx.x; asm volatile("" : "+v"(tid)); const int lane = tid & 63, wave = __builtin_amdgcn_readfirstlane(tid >> 6); (void)lane; (void)wave;
                LAS float* wsum = (LAS float*)lds;
                const int lp = lane & 31, half = lane >> 5;
                for (int unit = bx; unit < 8 * NB; unit += G) {
                    const int bh = unit >> 5, n = unit & 31, b = bh >> 2, hl = bh & 3;
                    const float gq0 = q_norm1[2 * lp], gq1 = q_norm1[2 * lp + 1], gq2 = q_norm1[64 + 2 * lp], gq3 = q_norm1[65 + 2 * lp];
                    const float gk0 = k_norm1[2 * lp], gk1 = k_norm1[2 * lp + 1], gk2 = k_norm1[64 + 2 * lp], gk3 = k_norm1[65 + 2 * lp];
                    float ks0 = 0.f, ks1 = 0.f, ks2 = 0.f, ks3 = 0.f;
                    for (int it = 0; it < 16; ++it) {
                        const int r = wave * 32 + it * 2 + half, pos = n * BLK + r;
                        const size_t off = (size_t)(b * SEQ + pos) * GW + hl * HD + 2 * lp;
                        const f32x2 cs0 = TAB[pos * 64 + 2 * lp], cs1 = TAB[pos * 64 + 2 * lp + 1];
                        {
                            const unsigned a = *(const unsigned*)(KG + off), c = *(const unsigned*)(KG + off + 64);
                            float x0 = bf_lo(a), x1 = bf_hi(a), x2 = bf_lo(c), x3 = bf_hi(c);
                            float ss = (x0 * x0 + x1 * x1) + (x2 * x2 + x3 * x3);
#pragma unroll
                            for (int o = 1; o < 32; o <<= 1) ss += __shfl_xor(ss, o);
                            const float rstd = 1.0f / sqrtf(ss * (1.f / HD) + EPS);
                            x0 *= rstd * gk0; x1 *= rstd * gk1; x2 *= rstd * gk2; x3 *= rstd * gk3;
                            const float o0 = x0 * cs0.x - x2 * cs0.y, o2 = x2 * cs0.x + x0 * cs0.y, o1 = x1 * cs1.x - x3 * cs1.y, o3 = x3 * cs1.x + x1 * cs1.y;
                            ks0 += o0; ks1 += o1; ks2 += o2; ks3 += o3;
                            *(unsigned*)(KG + off) = cvt_pk_bf16(o0, o1); *(unsigned*)(KG + off + 64) = cvt_pk_bf16(o2, o3);
                        }
                        {
                            const unsigned a = *(const unsigned*)(QG + off), c = *(const unsigned*)(QG + off + 64);
                            float x0 = bf_lo(a), x1 = bf_hi(a), x2 = bf_lo(c), x3 = bf_hi(c);
                            float ss = (x0 * x0 + x1 * x1) + (x2 * x2 + x3 * x3);
#pragma unroll
                            for (int o = 1; o < 32; o <<= 1) ss += __shfl_xor(ss, o);
                            const float rstd = QSCALE / sqrtf(ss * (1.f / HD) + EPS);
                            x0 *= rstd * gq0; x1 *= rstd * gq1; x2 *= rstd * gq2; x3 *= rstd * gq3;
                            const float o0 = x0 * cs0.x - x2 * cs0.y, o2 = x2 * cs0.x + x0 * cs0.y, o1 = x1 * cs1.x - x3 * cs1.y, o3 = x3 * cs1.x + x1 * cs1.y;
                            *(unsigned*)(QG + off) = cvt_pk_bf16(o0, o1); *(unsigned*)(QG + off + 64) = cvt_pk_bf16(o2, o3);
                        }
                    }
                    ks0 += __shfl_xor(ks0, 32); ks1 += __shfl_xor(ks1, 32); ks2 += __shfl_xor(ks2, 32); ks3 += __shfl_xor(ks3, 32);
                    if (half == 0) { wsum[wave * 128 + 2 * lp] = ks0; wsum[wave * 128 + 2 * lp + 1] = ks1; wsum[wave * 128 + 64 + 2 * lp] = ks2; wsum[wave * 128 + 65 + 2 * lp] = ks3; }
                    __syncthreads();
                    if (tid < 128) { float s = 0.f;
#pragma unroll
                        for (int w8 = 0; w8 < 8; ++w8) s += wsum[w8 * 128 + tid];
                        KMEAN[((size_t)(g * 8 + bh) * NB + n) * HD + tid] = s * (1.f / BLK); }
                    __syncthreads();
                }
            }
            SYNC(pb + 1);
            if (IN(pb + 2) && (PH_MASK & 256)) {
            int tid = threadIdx.x; asm volatile("" : "+v"(tid)); const int lane = tid & 63, wave = __builtin_amdgcn_readfirstlane(tid >> 6); (void)lane; (void)wave;
                LAS unsigned char* qt = lds;
                LAS float* km = (LAS float*)(lds + 256 * 272);
                LAS float* mv = (LAS float*)(lds + 256 * 272 + 16384);
                LAS int* mi = (LAS int*)(lds + 256 * 272 + 16384 + 3072);
                for (int unit = bx; unit < 8 * NB; unit += G) {
                    const int bh = unit >> 5, qb = unit & 31, b = bh >> 2, hl = bh & 3;
                    const int qi = tid & 255, hf = tid >> 8;
                    const int s = qb * BLK + qi; const size_t mrow = (size_t)b * SEQ + s;
                    if (qb > 0) {
                        for (int c = tid; c < 256 * 16; c += NTHREADS) { const int r = c >> 4, cc = c & 15;
                            *(LAS u32x4*)(qt + r * 272 + cc * 16) = *(const u32x4*)(QG + ((size_t)b * SEQ + qb * BLK + r) * GW + hl * HD + cc * 8); }
                        for (int c = tid; c < qb * 32; c += NTHREADS) *(LAS f32x4*)(km + c * 4) = *(const f32x4*)(KMEAN + (size_t)(g * 8 + bh) * NB * HD + c * 4);
                        __syncthreads();
                        float v0 = -INFINITY, v1 = -INFINITY, v2 = -INFINITY; int i0 = 255, i1 = 255, i2 = 255;
                        for (int n = hf; n < qb; n += 2) {
                            float acc = 0.f;
#pragma unroll 4
                            for (int c = 0; c < 16; ++c) { const u32x4 qv = *(const LAS u32x4*)(qt + qi * 272 + c * 16); const f32x4 ka = *(const LAS f32x4*)(km + n * 128 + c * 8), kb = *(const LAS f32x4*)(km + n * 128 + c * 8 + 4);
                                acc += bf_lo(qv.x) * ka.x + bf_hi(qv.x) * ka.y + bf_lo(qv.y) * ka.z + bf_hi(qv.y) * ka.w + bf_lo(qv.z) * kb.x + bf_hi(qv.z) * kb.y + bf_lo(qv.w) * kb.z + bf_hi(qv.w) * kb.w; }
                            if (acc > v0) { v2 = v1; i2 = i1; v1 = v0; i1 = i0; v0 = acc; i0 = n; }
                            else if (acc > v1) { v2 = v1; i2 = i1; v1 = acc; i1 = n; }
                            else if (acc > v2) { v2 = acc; i2 = n; }
                        }
                        if (hf == 1) { mv[qi * 3] = v0; mv[qi * 3 + 1] = v1; mv[qi * 3 + 2] = v2; mi[qi * 3] = i0; mi[qi * 3 + 1] = i1; mi[qi * 3 + 2] = i2; }
                        __syncthreads();
                        if (hf == 0) {
#pragma unroll
                            for (int e = 0; e < 3; ++e) { const float acc = mv[qi * 3 + e]; const int n = mi[qi * 3 + e];
                                if (n < 255) {
                                    const bool g0 = acc > v0 || (acc == v0 && n < i0), g1 = acc > v1 || (acc == v1 && n < i1), g2 = acc > v2 || (acc == v2 && n < i2);
                                    if (g0) { v2 = v1; i2 = i1; v1 = v0; i1 = i0; v0 = acc; i0 = n; }
                                    else if (g1) { v2 = v1; i2 = i1; v1 = acc; i1 = n; }
                                    else if (g2) { v2 = acc; i2 = n; }
                                } }
                            SEL[mrow * NH + g * HG + hl] = (unsigned)i0 | ((unsigned)i1 << 8) | ((unsigned)i2 << 16);
                            const int sl[3] = {i0, i1, i2};
#pragma unroll
                            for (int e = 0; e < 3; ++e) if (sl[e] < 255) { const int li = bh * NB + sl[e]; const unsigned pos = atomicAdd(&CNT[g * 256 + li], 1u); LIST[(size_t)li * SEQ + pos] = (unsigned short)(s | (e << 13)); }
                        }
                        __syncthreads();
                    } else if (hf == 0) {
                        SEL[mrow * NH + g * HG + hl] = 0x00ffffffu;
                    }
                }
            }
            SYNC(pb + 2);
            if (IN(pb + 3) && (PH_MASK & 512)) {
            int tid = threadIdx.x; asm volatile("" : "+v"(tid)); const int lane = tid & 63, wave = __builtin_amdgcn_readfirstlane(tid >> 6); (void)lane; (void)wave;
                LAS unsigned char* Ks = lds;
                LAS unsigned char* Vt = lds + 256 * 272;
                LAS int* pre = (LAS int*)(lds + 256 * 272 + 128 * 528);
                LAS float* red = (LAS float*)(lds + 256 * 272 + 128 * 528 + 2048);
                {
                    float mq = 0.f, mk = 0.f;
                    if (tid < 128) { mq = fabsf(q_norm1[tid]); mk = fabsf(k_norm1[tid]); }
#pragma unroll
                    for (int o = 1; o < 64; o <<= 1) { mq = fmaxf(mq, __shfl_xor(mq, o)); mk = fmaxf(mk, __shfl_xor(mk, o)); }
                    if (lane == 0) { red[wave * 2] = mq; red[wave * 2 + 1] = mk; }
                    if (tid < 256) pre[tid + 1] = 1 + (int)((CNT[g * 256 + tid] + 255u) >> 8);
                    if (tid == 0) pre[0] = 0;
                    __syncthreads();
                    if (tid == 0) { int a = 0; for (int i = 1; i <= 256; ++i) { a += pre[i]; pre[i] = a; } }
                    __syncthreads();
                }
                const float MSH = 128.0f * QSCALE * fmaxf(red[0], red[2]) * fmaxf(red[1], red[3]) * 1.02f;
                const int total = pre[256];
                const int fr = lane & 15, fq = lane >> 4;
#pragma unroll 1
                for (int item = bx; item < total; item += G) {
                    int loi = 0, hii = 256;
                    while (hii - loi > 1) { const int mid = (loi + hii) >> 1; if (pre[mid] <= item) loi = mid; else hii = mid; }
                    const int li = loi, c = item - pre[li], bh = li >> 5, n = li & 31, b = bh >> 2, hl = bh & 3;
                    const int cnt = (int)CNT[g * 256 + li];
                    const size_t rowbase = (size_t)b * SEQ;
                    __syncthreads();
                    for (int cc = tid; cc < 256 * 16; cc += NTHREADS) { const int r = cc >> 4, c16 = cc & 15;
                        *(LAS u32x4*)(Ks + r * 272 + c16 * 16) = *(const u32x4*)(KG + (rowbase + n * BLK + r) * GW + hl * HD + c16 * 8); }
                    for (int task = tid; task < 1024; task += NTHREADS) {
                        const int a = (task & 15) | ((task >> 5) & 3) << 4, cch = ((task >> 4) & 1) | ((task >> 7) << 1);
                        u32x4 v[4];
#pragma unroll
                        for (int kk = 0; kk < 4; ++kk) v[kk] = *(const u32x4*)(VG + (rowbase + n * BLK + a * 4 + kk) * GW + hl * HD + cch * 8);
#pragma unroll
                        for (int e = 0; e < 4; ++e) {
                            const unsigned w0 = e == 0 ? v[0].x : e == 1 ? v[0].y : e == 2 ? v[0].z : v[0].w, w1 = e == 0 ? v[1].x : e == 1 ? v[1].y : e == 2 ? v[1].z : v[1].w;
                            const unsigned w2 = e == 0 ? v[2].x : e == 1 ? v[2].y : e == 2 ? v[2].z : v[2].w, w3 = e == 0 ? v[3].x : e == 1 ? v[3].y : e == 2 ? v[3].z : v[3].w;
                            u32x2 lo2, hi2;
                            lo2.x = (w0 & 0xffffu) | (w1 << 16); lo2.y = (w2 & 0xffffu) | (w3 << 16);
                            hi2.x = (w0 >> 16) | (w1 & 0xffff0000u); hi2.y = (w2 >> 16) | (w3 & 0xffff0000u);
                            *(LAS u32x2*)(Vt + (cch * 8 + 2 * e) * 528 + a * 8) = lo2;
                            *(LAS u32x2*)(Vt + (cch * 8 + 2 * e + 1) * 528 + a * 8) = hi2;
                        }
                    }
                    int qpos[2], qslot[2]; bool qok[2];
                    bf16x8 qf[2][4];
#pragma unroll
                    for (int t = 0; t < 2; ++t) {
                        const int ridx = wave * 32 + t * 16 + fr;
                        if (c == 0) { qpos[t] = n * BLK + ridx; qslot[t] = 3; qok[t] = true; }
                        else { const int lidx = (c - 1) * 256 + ridx; qok[t] = lidx < cnt; const unsigned e = LIST[(size_t)li * SEQ + (qok[t] ? lidx : 0)]; qpos[t] = e & 8191; qslot[t] = e >> 13; }
                        const bf16_t* qp = QG + (rowbase + qpos[t]) * GW + hl * HD + fq * 8;
#pragma unroll
                        for (int ks = 0; ks < 4; ++ks) qf[t][ks] = *(const bf16x8*)(qp + ks * 32);
                    }
                    __syncthreads();
                    f32x4 oacc[2][8]; float lsum[2] = {0.f, 0.f};
#pragma unroll
                    for (int t = 0; t < 2; ++t)
#pragma unroll
                        for (int dt = 0; dt < 8; ++dt) oacc[t][dt] = (f32x4){0.f, 0.f, 0.f, 0.f};
                    const int qrel0 = qpos[0] - n * BLK, qrel1 = qpos[1] - n * BLK;
#pragma unroll 1
                    for (int kg = 0; kg < 8; ++kg) {
                        f32x4 sacc[2][2];
#pragma unroll
                        for (int kt = 0; kt < 2; ++kt) { sacc[kt][0] = (f32x4){0.f, 0.f, 0.f, 0.f}; sacc[kt][1] = (f32x4){0.f, 0.f, 0.f, 0.f};
#pragma unroll
                            for (int ks = 0; ks < 4; ++ks) { const bf16x8 kf = *(const LAS bf16x8*)(Ks + (kg * 32 + kt * 16 + fr) * 272 + ks * 64 + fq * 16);
                                sacc[kt][0] = __builtin_amdgcn_mfma_f32_16x16x32_bf16(kf, qf[0][ks], sacc[kt][0], 0, 0, 0);
                                sacc[kt][1] = __builtin_amdgcn_mfma_f32_16x16x32_bf16(kf, qf[1][ks], sacc[kt][1], 0, 0, 0); } }
                        bf16x8 pb[2];
#pragma unroll
                        for (int t = 0; t < 2; ++t) {
                            float p[8];
#pragma unroll
                            for (int kt = 0; kt < 2; ++kt)
#pragma unroll
                                for (int j = 0; j < 4; ++j) { float pv = __builtin_amdgcn_exp2f(sacc[kt][t][j] - MSH);
                                    if (c == 0) { const int key = kg * 32 + kt * 16 + fq * 4 + j; if (key > (t == 0 ? qrel0 : qrel1)) pv = 0.f; }
                                    p[kt * 4 + j] = pv; lsum[t] += pv; }
                            u32x4 w; w.x = cvt_pk_bf16(p[0], p[1]); w.y = cvt_pk_bf16(p[2], p[3]); w.z = cvt_pk_bf16(p[4], p[5]); w.w = cvt_pk_bf16(p[6], p[7]);
                            pb[t] = __builtin_bit_cast(bf16x8, w);
                        }
#pragma unroll
                        for (int dt = 0; dt < 8; ++dt) {
                            const u32x2 va = *(const LAS u32x2*)(Vt + (dt * 16 + fr) * 528 + kg * 64 + fq * 8), vb = *(const LAS u32x2*)(Vt + (dt * 16 + fr) * 528 + kg * 64 + 32 + fq * 8);
                            u32x4 vv; vv.x = va.x; vv.y = va.y; vv.z = vb.x; vv.w = vb.y; const bf16x8 vf = __builtin_bit_cast(bf16x8, vv);
                            oacc[0][dt] = __builtin_amdgcn_mfma_f32_16x16x32_bf16(vf, pb[0], oacc[0][dt], 0, 0, 0);
                            oacc[1][dt] = __builtin_amdgcn_mfma_f32_16x16x32_bf16(vf, pb[1], oacc[1][dt], 0, 0, 0);
                        }
                    }
#pragma unroll
                    for (int t = 0; t < 2; ++t) {
                        float l = lsum[t]; l += __shfl_xor(l, 16); l += __shfl_xor(l, 32);
                        if (qok[t]) {
                            const size_t pair = (rowbase + qpos[t]) * HG + hl;
                            bf16_t* op = OPART + (pair * 4 + qslot[t]) * HD + fq * 4;
#pragma unroll
                            for (int dt = 0; dt < 8; ++dt) { u32x2 w; w.x = cvt_pk_bf16(oacc[t][dt][0], oacc[t][dt][1]); w.y = cvt_pk_bf16(oacc[t][dt][2], oacc[t][dt][3]); *(u32x2*)(op + dt * 16) = w; }
                            if (fq == 0) LPART[pair * 4 + qslot[t]] = l;
                        }
                    }
                }
            }
            SYNC(pb + 3);
            if (IN(pb + 4) && (PH_MASK & 1024)) {
            int tid = threadIdx.x; asm volatile("" : "+v"(tid)); const int lane = tid & 63, wave = __builtin_amdgcn_readfirstlane(tid >> 6); (void)lane; (void)wave;
                for (int idx = bx * NTHREADS + tid; idx < M * HG * 16; idx += G * NTHREADS) {
                    const int pair = idx >> 4, ch = idx & 15, m = pair >> 2, hl = pair & 3;
                    const unsigned sel = SEL[(size_t)m * NH + g * HG + hl];
                    float o[8]; float l = LPART[(size_t)pair * 4 + 3];
                    { const u32x4 v = *(const u32x4*)(OPART + ((size_t)pair * 4 + 3) * HD + ch * 8);
                      o[0] = bf_lo(v.x); o[1] = bf_hi(v.x); o[2] = bf_lo(v.y); o[3] = bf_hi(v.y); o[4] = bf_lo(v.z); o[5] = bf_hi(v.z); o[6] = bf_lo(v.w); o[7] = bf_hi(v.w); }
#pragma unroll
                    for (int e = 0; e < 3; ++e) if (((sel >> (8 * e)) & 0xffu) != 0xffu) {
                        const u32x4 v = *(const u32x4*)(OPART + ((size_t)pair * 4 + e) * HD + ch * 8); l += LPART[(size_t)pair * 4 + e];
                        o[0] += bf_lo(v.x); o[1] += bf_hi(v.x); o[2] += bf_lo(v.y); o[3] += bf_hi(v.y); o[4] += bf_lo(v.z); o[5] += bf_hi(v.z); o[6] += bf_lo(v.w); o[7] += bf_hi(v.w); }
                    const float rl = 1.0f / l;
                    const u32x4 z = *(const u32x4*)(SZG + (size_t)m * GW + hl * HD + ch * 8);
                    u32x4 w; w.x = cvt_pk_bf16(o[0] * rl * bf_lo(z.x), o[1] * rl * bf_hi(z.x)); w.y = cvt_pk_bf16(o[2] * rl * bf_lo(z.y), o[3] * rl * bf_hi(z.y));
                    w.z = cvt_pk_bf16(o[4] * rl * bf_lo(z.z), o[5] * rl * bf_hi(z.z)); w.w = cvt_pk_bf16(o[6] * rl * bf_lo(z.w), o[7] * rl * bf_hi(z.w));
                    *(u32x4*)(AT + (size_t)m * DI + g * GW + hl * HD + ch * 8) = w;
                }
            }
            SYNC(pb + 4);
        }
        if (IN(6 + 5 * NG) && (PH_MASK & 2048)) {
            int tid = threadIdx.x; asm volatile("" : "+v"(tid)); const int lane = tid & 63, wave = __builtin_amdgcn_readfirstlane(tid >> 6); (void)lane; (void)wave;
            pg8::Gemm<DI, DI, DI> gm{AT, WOUT1}; pg8::StaticOrder S; S.init(M, D, G, bx);
            pg8::EpiRes E{out, out}; pg8::MapPlain<DI, DI> MP;
            pg8::gemm_phase(lds, gm, S, MP, E);
        }
    }
}

constexpr int NPHASES = 6 + 5 * NG + 1;

extern "C" void kernel_launch(void* const* d_in, const int* in_sizes, int n_in, void* d_out, int out_size, void* d_ws, size_t ws_size, hipStream_t stream) {
    static int grid = 0;
    if (grid == 0) {
        int dev = 0, cus = 0, per_cu = 0;
        hipGetDevice(&dev);
        hipDeviceGetAttribute(&cus, hipDeviceAttributeMultiprocessorCount, dev);
        hipFuncSetAttribute((const void*)mega_fwd, hipFuncAttributeMaxDynamicSharedMemorySize, LDS_BYTES);
        hipOccupancyMaxActiveBlocksPerMultiprocessor(&per_cu, (const void*)mega_fwd, NTHREADS, LDS_BYTES);
        if (per_cu < 1) { fprintf(stderr, "kernel_launch: occupancy query says %d blocks per CU\n", per_cu); per_cu = 1; }
        grid = cus;
        if (ws_size < WS_END) fprintf(stderr, "kernel_launch: workspace too small: %zu < %zu\n", ws_size, (size_t)WS_END);
    }
    hipMemsetAsync((char*)d_ws + WS_CTL, 0, CTL_BYTES, stream);
    Args a{};
    for (int i = 0; i < 11; ++i) a.in[i] = (const float*)d_in[i];
    a.out = (float*)d_out; a.ws = (unsigned char*)d_ws; a.pad = 0;
#if defined(MK_PER_PHASE)
    for (int ph = 0; ph < NPHASES; ++ph) { a.ph_lo = ph; a.ph_hi = ph + 1; a.coop = 0; hipLaunchKernelGGL(mega_fwd, dim3(grid), dim3(NTHREADS), LDS_BYTES, stream, a); }
#else
    a.ph_lo = 0; a.ph_hi = NPHASES; a.coop = 1;
    void* kargs[] = {&a};
    hipError_t e = hipLaunchCooperativeKernel((const void*)mega_fwd, dim3(grid), dim3(NTHREADS), kargs, LDS_BYTES, stream);
    if (e != hipSuccess) fprintf(stderr, "cooperative launch failed: %s (grid %d)\n", hipGetErrorString(e), grid);
#endif
}
```

```cpp
#include <hip/hip_runtime.h>
#include <hip/hip_cooperative_groups.h>
#include <cstdio>
#include <cstdint>
namespace cg = cooperative_groups;

#define LAS __attribute__((address_space(3)))
typedef unsigned short bf16_t;
typedef short bf16x8 __attribute__((ext_vector_type(8)));
typedef float f32x4 __attribute__((ext_vector_type(4)));
typedef float f32x2 __attribute__((ext_vector_type(2)));
typedef unsigned u32x4 __attribute__((ext_vector_type(4)));
typedef unsigned u32x2 __attribute__((ext_vector_type(2)));

constexpr int SEQ = 8192, NBATCH = 2, M = NBATCH * SEQ, D = 1024, DI = 2048, NH = 16, HD = 128, BLK = 256, NB = SEQ / BLK;
constexpr int NG = 4, HG = NH / NG, GW = HG * HD;
constexpr float EPS = 1e-6f;
constexpr float QSCALE = 0.08838834764831845f * 1.4426950408889634f;

constexpr size_t MiB = 1u << 20;
constexpr size_t WS_CTL = 0, CTL_BYTES = 65536;
constexpr size_t WS_BAR = 8192;
constexpr size_t WS_KMEAN = 1 * MiB;
constexpr size_t WS_SEL = 2 * MiB;
constexpr size_t WS_LPART = 3 * MiB;
constexpr size_t WS_TAB = 4 * MiB;
constexpr size_t WS_WIN1 = 8 * MiB, WS_WOUT1 = 24 * MiB;
constexpr size_t WS_LIST = 28 * MiB;
constexpr size_t WS_WIN0 = 28 * MiB, WS_WP = 36 * MiB, WS_WOUT0 = 38 * MiB;
constexpr size_t WS_H0 = 42 * MiB, WS_POOLED = 42 * MiB, WS_U = 106 * MiB, WS_SZ0 = 170 * MiB;
constexpr size_t WS_H1 = 32 * MiB, WS_QG = 64 * MiB, WS_KG = 80 * MiB, WS_VG = 96 * MiB, WS_SZG = 112 * MiB;
constexpr size_t WS_OPART = 128 * MiB, WS_A = 192 * MiB, WS_END = 256 * MiB;

constexpr int LDS_BYTES = 140 * 1024;
constexpr int NTHREADS = 512;
#ifndef PH_MASK
#define PH_MASK 0xfff
#endif

__device__ __forceinline__ unsigned cvt_pk_bf16(float lo, float hi) { unsigned r; asm volatile("v_cvt_pk_bf16_f32 %0, %1, %2" : "=v"(r) : "v"(lo), "v"(hi)); return r; }
__device__ __forceinline__ float bf_lo(unsigned u) { return __uint_as_float(u << 16); }
__device__ __forceinline__ float bf_hi(unsigned u) { return __uint_as_float(u & 0xffff0000u); }
__device__ __forceinline__ float silu_f(float z) { return z * __builtin_amdgcn_rcpf(1.0f + __builtin_amdgcn_exp2f(-1.4426950408889634f * z)); }
__device__ __forceinline__ float wave_sum(float v) {
#pragma unroll
    for (int o = 1; o < 64; o <<= 1) v += __shfl_xor(v, o);
    return v;
}

namespace pg8 {
constexpr int BM = 256, BK = 64, HALF = 128, HTB = HALF * BK * 2, STAGE_BYTES = 8 * HTB, NXCD = 8, WGM = 8;
__host__ __device__ __forceinline__ int lds_byte(int r, int c) { const int st = (r >> 4) * 2 + (c >> 5), rr = r & 15, cc = c & 31, ob = rr * 64 + cc * 2; return st * 1024 + (ob ^ (((ob >> 9) & 1) << 5)); }
__host__ __device__ __forceinline__ void stage_rc(int b, int& R, int& C) { const int st = b / 1024, sb = b % 1024, swz = sb ^ (((sb >> 9) & 1) << 5); R = (st >> 1) * 16 + swz / 64; C = (st & 1) * 32 + (swz % 64) / 2; }
__host__ __device__ __forceinline__ int perm32(int rho) { const int n = rho >> 4, i = rho & 15; return 8 * (i >> 2) + 4 * n + (i & 3); }

struct Unit { int pm, pn; };
template <int LDA_, int LDB_, int K_> struct Gemm { const bf16_t* A; const bf16_t* Bt; static constexpr int lda = LDA_, ldb = LDB_, K = K_; };
struct StaticOrder {
    int nM, nN, nwg, G, c;
    __device__ void init(int M_, int N_, int G_, int c_) { nM = M_ / BM; nN = N_ / BM; nwg = nM * nN; G = G_; c = c_; }
    __device__ bool next(int i, Unit& u) const {
        const long L = (long)i * G + c; if (L >= nwg) return false;
        int wgid = (int)L; { const int q = nwg / NXCD, r = nwg % NXCD, xcd = wgid % NXCD, off = wgid / NXCD; wgid = (xcd < r ? xcd * (q + 1) : r * (q + 1) + (xcd - r) * q) + off; }
        const int nig = WGM * nN, gid = wgid / nig, fm = gid * WGM, gsz = (nM - fm) < WGM ? (nM - fm) : WGM;
        u.pm = fm + ((wgid % nig) % gsz); u.pn = (wgid % nig) / gsz; return true;
    }
};
template <class Epi, class Map, class GemmT>
__device__ __forceinline__ void gemm_phase(LAS unsigned char* lds, const GemmT g, const StaticOrder& S, const Map& MP, const Epi& E) {
    int tid_ = threadIdx.x; asm volatile("" : "+v"(tid_));
    const int tid = tid_, wid = __builtin_amdgcn_readfirstlane(tid >> 6), lane = tid & 63, wr = wid >> 2, wc = wid & 3, fr = lane & 15, fq = lane >> 4;
    constexpr int K = GemmT::K, nt = K / BK;
    unsigned voffA[2], voffB[2];
#pragma unroll
    for (int i = 0; i < 2; ++i) { int R, C; stage_rc(tid * 16 + i * 8192, R, C); const int Rb = Epi::PERM ? ((R & ~31) + perm32(R & 31)) : R;
        voffA[i] = (unsigned)(R * GemmT::lda + C) * 2u; voffB[i] = (unsigned)(Rb * GemmT::ldb + C) * 2u; }
    constexpr size_t kstep = (size_t)(BK * 2);
    constexpr size_t hstepA = (size_t)HALF * GemmT::lda * 2, hstepB = (size_t)HALF * GemmT::ldb * 2;
    const unsigned ldsw = (unsigned)wid * 1024u;
    const int aoff = lds_byte(wr * 64 + fr, fq * 8), boff = lds_byte(wc * 32 + fr, fq * 8);
#define PG8_SA(b, h) (((b) * 2 + (h)) * HTB)
#define PG8_SB(b, h) ((4 + (b) * 2 + (h)) * HTB)
#define PG8_STAGE(bufoff, gbase, voff) do { _Pragma("unroll") for (int _i = 0; _i < 2; ++_i) \
        __builtin_amdgcn_global_load_lds((const unsigned*)((const char*)(gbase) + (voff)[_i]), (LAS unsigned*)(lds + (bufoff) + ldsw + _i * 8192), 16, 0, 0); } while (0)
#define PG8_LDA(dst, b, h) do { _Pragma("unroll") for (int m = 0; m < 4; ++m) _Pragma("unroll") for (int k = 0; k < 2; ++k) dst[m][k] = *(const LAS bf16x8*)(lds + PG8_SA(b, h) + aoff + m * 2048 + k * 1024); } while (0)
#define PG8_LDB(dst, b, h) do { _Pragma("unroll") for (int n = 0; n < 2; ++n) _Pragma("unroll") for (int k = 0; k < 2; ++k) dst[n][k] = *(const LAS bf16x8*)(lds + PG8_SB(b, h) + boff + n * 2048 + k * 1024); } while (0)
#define PG8_MMA(ai, bj, At, Bt) do { __builtin_amdgcn_s_setprio(1); _Pragma("unroll") for (int m = 0; m < 4; ++m) _Pragma("unroll") for (int n = 0; n < 2; ++n) _Pragma("unroll") for (int k = 0; k < 2; ++k) \
        acc[ai][bj][m][n] = __builtin_amdgcn_mfma_f32_16x16x32_bf16(Bt[n][k], At[m][k], acc[ai][bj][m][n], 0, 0, 0); __builtin_amdgcn_s_setprio(0); } while (0)
#define PG8_WAIT_V(n) asm volatile("s_waitcnt vmcnt(" #n ")" ::: "memory")
#define PG8_WAIT_L(n) asm volatile("s_waitcnt lgkmcnt(" #n ")" ::: "memory")
#define PG8_BAR __builtin_amdgcn_s_barrier()
#define PG8_SCHED __builtin_amdgcn_sched_barrier(0)
    Unit cur, nxt; int ui = 0;
    if (!S.next(0, cur)) return;
    f32x4 acc[2][2][4][2];
#pragma unroll
    for (int a = 0; a < 2; ++a)
#pragma unroll
        for (int b = 0; b < 2; ++b)
#pragma unroll
            for (int m = 0; m < 4; ++m)
#pragma unroll
                for (int n = 0; n < 2; ++n) acc[a][b][m][n] = (f32x4){0.f, 0.f, 0.f, 0.f};
    bf16x8 At[4][2], B0[2][2], B1[2][2];
    const char* cA = (const char*)(g.A + MP.a_off(cur)); const char* cB = (const char*)(g.Bt + MP.b_off(cur));
    PG8_STAGE(PG8_SB(0, 0), cB, voffB); PG8_STAGE(PG8_SB(0, 1), cB + hstepB, voffB); PG8_STAGE(PG8_SA(0, 0), cA, voffA); PG8_STAGE(PG8_SA(0, 1), cA + hstepA, voffA);
    if (wr == 1) PG8_BAR;
    PG8_WAIT_V(2); PG8_BAR;
    PG8_STAGE(PG8_SB(1, 0), cB + kstep, voffB); PG8_STAGE(PG8_SA(1, 0), cA + kstep, voffA); PG8_STAGE(PG8_SB(1, 1), cB + hstepB + kstep, voffB);
    PG8_WAIT_V(6); PG8_BAR;
    for (;;) {
        const bool has_next = S.next(ui + 1, nxt);
        const char* nA = has_next ? (const char*)(g.A + MP.a_off(nxt)) : cA; const char* nB = has_next ? (const char*)(g.Bt + MP.b_off(nxt)) : cB;
        for (int t = 0; t < nt; t += 2) {
            const bool last = (t == nt - 2);
            const char* a1 = cA + (size_t)(t + 1) * kstep;
            const char* a2 = last ? nA : cA + (size_t)(t + 2) * kstep; const char* b2 = last ? nB : cB + (size_t)(t + 2) * kstep;
            const char* a3 = a2 + kstep; const char* b3 = b2 + kstep;
            PG8_LDB(B0, 0, 0); PG8_LDB(B1, 0, 1); PG8_SCHED; PG8_LDA(At, 0, 0); PG8_STAGE(PG8_SA(1, 1), a1 + hstepA, voffA);
            PG8_WAIT_V(8); PG8_WAIT_L(0); PG8_BAR; PG8_MMA(0, 0, At, B0); PG8_MMA(0, 1, At, B1); PG8_BAR; PG8_SCHED;
            PG8_LDA(At, 0, 1); PG8_STAGE(PG8_SB(0, 0), b2, voffB); PG8_STAGE(PG8_SB(0, 1), b2 + hstepB, voffB); PG8_STAGE(PG8_SA(0, 0), a2, voffA);
            PG8_WAIT_V(8); PG8_WAIT_L(0); PG8_BAR; PG8_MMA(1, 0, At, B0); PG8_MMA(1, 1, At, B1); PG8_BAR; PG8_SCHED;
            PG8_LDB(B0, 1, 0); PG8_LDB(B1, 1, 1); PG8_SCHED; PG8_LDA(At, 1, 0); PG8_STAGE(PG8_SA(0, 1), a2 + hstepA, voffA);
            PG8_WAIT_V(8); PG8_WAIT_L(0); PG8_BAR; PG8_MMA(0, 0, At, B0); PG8_MMA(0, 1, At, B1); PG8_BAR; PG8_SCHED;
            PG8_LDA(At, 1, 1); PG8_STAGE(PG8_SB(1, 0), b3, voffB); PG8_STAGE(PG8_SB(1, 1), b3 + hstepB, voffB); PG8_STAGE(PG8_SA(1, 0), a3, voffA);
            PG8_WAIT_V(8); PG8_WAIT_L(0); PG8_BAR; PG8_MMA(1, 0, At, B0); PG8_MMA(1, 1, At, B1); PG8_BAR; PG8_SCHED;
        }
        if (wr == 0) PG8_BAR;
        E(acc, cur, wr, wc, fr, fq);
        if (!has_next) break;
#pragma unroll
        for (int a = 0; a < 2; ++a)
#pragma unroll
            for (int b = 0; b < 2; ++b)
#pragma unroll
                for (int m = 0; m < 4; ++m)
#pragma unroll
                    for (int n = 0; n < 2; ++n) acc[a][b][m][n] = (f32x4){0.f, 0.f, 0.f, 0.f};
        cur = nxt; cA = nA; cB = nB; ++ui;
        if (wr == 1) PG8_BAR;
    }
    PG8_WAIT_V(0);
    PG8_BAR;
#undef PG8_SA
#undef PG8_SB
#undef PG8_STAGE
#undef PG8_LDA
#undef PG8_LDB
#undef PG8_MMA
#undef PG8_WAIT_V
#undef PG8_WAIT_L
#undef PG8_BAR
#undef PG8_SCHED
}

template <int ldc, int tiles_per_dst, int silu_dst> struct EpiSplit {
    static constexpr bool PERM = true;
    bf16_t *d0, *d1, *d2, *d3;
    __device__ __forceinline__ void operator()(const f32x4 (&acc)[2][2][4][2], const Unit& u, int wr, int wc, int fr, int fq) const {
        const int di = u.pn / tiles_per_dst, ct = u.pn - di * tiles_per_dst;
        bf16_t* base = di == 0 ? d0 : di == 1 ? d1 : di == 2 ? d2 : d3; const bool act = (di == silu_dst);
        const int row0 = u.pm * BM + wr * 64 + fr, col0 = ct * BM + wc * 32 + 8 * fq;
#pragma unroll
        for (int ai = 0; ai < 2; ++ai)
#pragma unroll
            for (int m = 0; m < 4; ++m) { bf16_t* rowp = base + (size_t)(row0 + ai * HALF + m * 16) * ldc + col0;
#pragma unroll
                for (int bj = 0; bj < 2; ++bj) { f32x4 v0 = acc[ai][bj][m][0], v1 = acc[ai][bj][m][1];
                    if (act) { v0 = (f32x4){silu_f(v0[0]), silu_f(v0[1]), silu_f(v0[2]), silu_f(v0[3])}; v1 = (f32x4){silu_f(v1[0]), silu_f(v1[1]), silu_f(v1[2]), silu_f(v1[3])}; }
                    u32x4 w; w.x = cvt_pk_bf16(v0[0], v0[1]); w.y = cvt_pk_bf16(v0[2], v0[3]); w.z = cvt_pk_bf16(v1[0], v1[1]); w.w = cvt_pk_bf16(v1[2], v1[3]);
                    *(u32x4*)(rowp + bj * HALF) = w; } }
    }
};
struct EpiGate {
    static constexpr bool PERM = true; static constexpr int ldc = DI;
    bf16_t* Y; const bf16_t* SZ; const float* scale;
    __device__ __forceinline__ void operator()(const f32x4 (&acc)[2][2][4][2], const Unit& u, int wr, int wc, int fr, int fq) const {
        const int row0 = u.pm * BM + wr * 64 + fr, col0 = u.pn * BM + wc * 32 + 8 * fq;
        f32x4 sc[2][2];
#pragma unroll
        for (int bj = 0; bj < 2; ++bj) { sc[bj][0] = *(const f32x4*)(scale + col0 + bj * HALF); sc[bj][1] = *(const f32x4*)(scale + col0 + bj * HALF + 4); }
#pragma unroll
        for (int ai = 0; ai < 2; ++ai)
#pragma unroll
            for (int m = 0; m < 4; ++m) { const size_t off = (size_t)(row0 + ai * HALF + m * 16) * ldc + col0;
#pragma unroll
                for (int bj = 0; bj < 2; ++bj) { const u32x4 z = *(const u32x4*)(SZ + off + bj * HALF);
                    const f32x4 v0 = acc[ai][bj][m][0] * sc[bj][0], v1 = acc[ai][bj][m][1] * sc[bj][1];
                    u32x4 w; w.x = cvt_pk_bf16(v0[0] * bf_lo(z.x), v0[1] * bf_hi(z.x)); w.y = cvt_pk_bf16(v0[2] * bf_lo(z.y), v0[3] * bf_hi(z.y));
                    w.z = cvt_pk_bf16(v1[0] * bf_lo(z.z), v1[1] * bf_hi(z.z)); w.w = cvt_pk_bf16(v1[2] * bf_lo(z.w), v1[3] * bf_hi(z.w));
                    *(u32x4*)(Y + off + bj * HALF) = w; } }
    }
};
struct EpiRes {
    static constexpr bool PERM = false; static constexpr int ldc = D;
    const float* base; float* out;
    __device__ __forceinline__ void operator()(const f32x4 (&acc)[2][2][4][2], const Unit& u, int wr, int wc, int fr, int fq) const {
        const int row0 = u.pm * BM + wr * 64 + fr, col0 = u.pn * BM + wc * 32 + 4 * fq;
#pragma unroll
        for (int ai = 0; ai < 2; ++ai)
#pragma unroll
            for (int m = 0; m < 4; ++m) { const size_t off = (size_t)(row0 + ai * HALF + m * 16) * ldc + col0;
#pragma unroll
                for (int bj = 0; bj < 2; ++bj)
#pragma unroll
                    for (int n = 0; n < 2; ++n) { const f32x4 b = *(const f32x4*)(base + off + bj * HALF + n * 16); *(f32x4*)(out + off + bj * HALF + n * 16) = b + acc[ai][bj][m][n]; } }
    }
};
template <int lda, int ldb> struct MapPlain { __device__ __forceinline__ size_t a_off(const Unit& u) const { return (size_t)u.pm * BM * lda; } __device__ __forceinline__ size_t b_off(const Unit& u) const { return (size_t)u.pn * BM * ldb; } };
struct MapPool { __device__ __forceinline__ size_t a_off(const Unit& u) const { return (size_t)u.pm * BM * DI + (size_t)(u.pn >> 1) * 512; } __device__ __forceinline__ size_t b_off(const Unit& u) const { return (size_t)u.pn * BM * 512; } };
struct MapQkvz { int g; __device__ __forceinline__ size_t a_off(const Unit& u) const { return (size_t)u.pm * BM * D; } __device__ __forceinline__ size_t b_off(const Unit& u) const { return (size_t)((u.pn >> 1) * DI + g * GW + (u.pn & 1) * BM) * D; } };
}

#define XB_TMO      128
#define XB_XCNT(j)  (256  + 64 * (j))
#define XB_XSUB(j)  (1280 + 64 * (j))
#define XB_XGEN(j)  (2304 + 64 * (j))
#define XB_TOP      3328
#define XB_TOPGEN   3392
#define XCD_BAR_WORDS 3456
#define XB_SPIN_CAP (1u << 18)
__device__ __forceinline__ unsigned xb_ld(unsigned* p)              { return __hip_atomic_load(p, __ATOMIC_RELAXED, __HIP_MEMORY_SCOPE_AGENT); }
__device__ __forceinline__ unsigned xb_add(unsigned* p, unsigned v) { return __hip_atomic_fetch_add(p, v, __ATOMIC_RELAXED, __HIP_MEMORY_SCOPE_AGENT); }
__device__ __forceinline__ unsigned xb_xcc_id() { return (unsigned)__builtin_amdgcn_s_getreg((3 << 11) | 20) & 0xFu; }
#define XB_SPIN(cond, bar) do { unsigned _sp = 0; while (cond) { __builtin_amdgcn_s_sleep(1); \
    if ((++_sp & 255u) == 0u) { if (xb_ld(&(bar)[XB_TMO])) break; if (_sp > XB_SPIN_CAP) { atomicAdd(&(bar)[XB_TMO], 1u); break; } } } } while (0)
struct XcdBarrier { unsigned* bar; unsigned x; volatile LAS unsigned* st; };
__device__ __forceinline__ XcdBarrier xcd_barrier_post(unsigned* bar, volatile LAS unsigned* st) {
    XcdBarrier b; b.bar = bar; b.x = xb_xcc_id(); b.st = st;
    if (threadIdx.x == 0) (void)xb_add(&bar[XB_XCNT(b.x)], 1u);
    return b;
}
__device__ __forceinline__ void xcd_barrier_complete(unsigned* bar, unsigned x, unsigned& nloc, unsigned& nx) {
    const unsigned G = gridDim.x * gridDim.y * gridDim.z;
    unsigned sum, cnt, mine, sp = 0u;
    for (;;) {
        sum = 0u; cnt = 0u; mine = 0u;
#pragma unroll
        for (unsigned j = 0; j < 16; ++j) { const unsigned c = xb_ld(&bar[XB_XCNT(j)]); sum += c; cnt += (c > 0u) ? 1u : 0u; mine = (j == x) ? c : mine; }
        if (sum == G) break;
        __builtin_amdgcn_s_sleep(1);
        if ((++sp & 255u) == 0u) { if (xb_ld(&bar[XB_TMO])) break; if (sp > XB_SPIN_CAP) { atomicAdd(&bar[XB_TMO], 1u); break; } }
    }
    nloc = mine > 0u ? mine : 1u; nx = cnt > 0u ? cnt : 1u;
}
__device__ __forceinline__ void xcd_barrier(const XcdBarrier& b) {
    asm volatile("s_waitcnt vmcnt(0)" ::: "memory");
    __syncthreads();
    if (threadIdx.x == 0) {
        unsigned* bar = b.bar;
        __builtin_amdgcn_s_waitcnt(0);
        unsigned nloc = b.st[0], nx = b.st[1];
        if (nloc == 0u) { xcd_barrier_complete(bar, b.x, nloc, nx); b.st[0] = nloc; b.st[1] = nx; }
        const unsigned old = xb_add(&bar[XB_XSUB(b.x)], 1u);
        const unsigned gen = old / nloc;
        if (old + 1u == (gen + 1u) * nloc) {
            __builtin_amdgcn_fence(__ATOMIC_RELEASE, "agent");
            asm volatile("s_waitcnt vmcnt(0)" ::: "memory");
            const unsigned og = xb_add(&bar[XB_TOP], 1u);
            const unsigned tg = og / nx;
            if (og + 1u == (tg + 1u) * nx) xb_add(&bar[XB_TOPGEN], 1u);
            else XB_SPIN(xb_ld(&bar[XB_TOPGEN]) == tg, bar);
            __builtin_amdgcn_fence(__ATOMIC_ACQUIRE, "agent");
            xb_add(&bar[XB_XGEN(b.x)], 1u);
            asm volatile("s_waitcnt vmcnt(0)" ::: "memory");
        } else {
            XB_SPIN(xb_ld(&bar[XB_XGEN(b.x)]) == gen, bar);
            __builtin_amdgcn_fence(__ATOMIC_ACQUIRE, "agent");
            asm volatile("s_waitcnt vmcnt(0)" ::: "memory");
        }
    }
    __syncthreads();
}

struct Args { const float* in[11]; float* out; unsigned char* ws; int ph_lo, ph_hi, coop, pad; };

__device__ __forceinline__ void transpose_item(const float* W, int K, int N, bf16_t* WT, LAS float* scr, int item, int lane) {
    const int nblk = N / 32, kb = item / nblk, nb = item % nblk, k0 = 64 * kb, n0 = 32 * nb;
#pragma unroll 8
    for (int i = 0; i < 32; ++i) { const int kk = 2 * i + (lane >> 5); scr[kk * 33 + (lane & 31)] = W[(size_t)(k0 + kk) * N + n0 + (lane & 31)]; }
    asm volatile("s_waitcnt lgkmcnt(0)" ::: "memory");
    const int c = lane & 7;
#pragma unroll
    for (int j = 0; j < 4; ++j) { const int n = (lane >> 3) + 8 * j; const LAS float* s = scr + (8 * c) * 33 + n;
        u32x4 o; o.x = cvt_pk_bf16(s[0 * 33], s[1 * 33]); o.y = cvt_pk_bf16(s[2 * 33], s[3 * 33]); o.z = cvt_pk_bf16(s[4 * 33], s[5 * 33]); o.w = cvt_pk_bf16(s[6 * 33], s[7 * 33]);
        *(u32x4*)(WT + (size_t)(n0 + n) * K + k0 + 8 * c) = o; }
    asm volatile("s_waitcnt lgkmcnt(0)" ::: "memory");
}
__device__ __forceinline__ void rms_row(const float* xrow, const float* gain, bf16_t* orow, int lane) {
    const f32x4* xr = (const f32x4*)xrow + lane; const f32x4* gr = (const f32x4*)gain + lane;
    f32x4 v[4]; float s = 0.f;
#pragma unroll
    for (int j = 0; j < 4; ++j) { v[j] = xr[64 * j]; s += (v[j].x * v[j].x + v[j].y * v[j].y) + (v[j].z * v[j].z + v[j].w * v[j].w); }
    const float rstd = 1.0f / sqrtf(wave_sum(s) * (1.f / D) + EPS);
    u32x2* o8 = (u32x2*)orow + lane;
#pragma unroll
    for (int j = 0; j < 4; ++j) { const f32x4 gg = gr[64 * j]; u32x2 w; w.x = cvt_pk_bf16(v[j].x * rstd * gg.x, v[j].y * rstd * gg.y); w.y = cvt_pk_bf16(v[j].z * rstd * gg.z, v[j].w * rstd * gg.w); o8[64 * j] = w; }
}
__device__ __forceinline__ void rope_entry(int idx, f32x2* tab) {
    const int pos = idx >> 6, i = idx & 63;
    const float inv = (float)exp2(-(double)(2 * i) * (13.287712379549449 / 128.0));
    const float angf = (float)pos * inv;
    const double a = (double)angf; const double q = rint(a * 0.6366197723675814); const double r = a - q * 1.5707963267948966;
    const double r2 = r * r;
    double sn = r * (1.0 - r2 / 6.0 * (1.0 - r2 / 20.0 * (1.0 - r2 / 42.0 * (1.0 - r2 / 72.0 * (1.0 - r2 / 110.0 * (1.0 - r2 / 156.0))))));
    double cs = 1.0 - r2 / 2.0 * (1.0 - r2 / 12.0 * (1.0 - r2 / 30.0 * (1.0 - r2 / 56.0 * (1.0 - r2 / 90.0 * (1.0 - r2 / 132.0)))));
    const int qi = ((int)q) & 3;
    double c2, s2;
    if (qi == 0) { c2 = cs; s2 = sn; } else if (qi == 1) { c2 = -sn; s2 = cs; } else if (qi == 2) { c2 = -cs; s2 = -sn; } else { c2 = sn; s2 = -cs; }
    tab[idx] = (f32x2){(float)c2, (float)s2};
}

__global__ void __launch_bounds__(NTHREADS, 2) mega_fwd(Args args) {
    extern __shared__ __attribute__((aligned(16))) unsigned char lds_raw[];
    LAS unsigned char* lds = (LAS unsigned char*)lds_raw;
    cg::grid_group grid = cg::this_grid();
    const int G = gridDim.x, bx = blockIdx.x;
    volatile LAS unsigned* bst = (volatile LAS unsigned*)(lds + LDS_BYTES - 16);
    if (threadIdx.x < 4) bst[threadIdx.x] = 0u;
    __syncthreads();
    XcdBarrier xbar; xbar.bar = (unsigned*)(args.ws + WS_BAR); xbar.x = 0; xbar.st = bst;
    if (args.coop) xbar = xcd_barrier_post((unsigned*)(args.ws + WS_BAR), bst);
    unsigned char* ws = args.ws;
#define XIN (args.in[0])
#define norm0 (args.in[1])
#define w_in0 (args.in[2])
#define w_pool0 (args.in[3])
#define pool_scale0 (args.in[4])
#define w_out0 (args.in[5])
#define norm1 (args.in[6])
#define w_in1 (args.in[7])
#define q_norm1 (args.in[8])
#define k_norm1 (args.in[9])
#define w_out1 (args.in[10])
    float* out = args.out;
#define WIN0 ((bf16_t*)(ws + WS_WIN0))
#define WP ((bf16_t*)(ws + WS_WP))
#define WOUT0 ((bf16_t*)(ws + WS_WOUT0))
#define WIN1 ((bf16_t*)(ws + WS_WIN1))
#define WOUT1 ((bf16_t*)(ws + WS_WOUT1))
#define H0 ((bf16_t*)(ws + WS_H0))
#define POOLED ((bf16_t*)(ws + WS_POOLED))
#define U ((bf16_t*)(ws + WS_U))
#define SZ0 ((bf16_t*)(ws + WS_SZ0))
#define H1 ((bf16_t*)(ws + WS_H1))
#define QG ((bf16_t*)(ws + WS_QG))
#define KG ((bf16_t*)(ws + WS_KG))
#define VG ((bf16_t*)(ws + WS_VG))
#define SZG ((bf16_t*)(ws + WS_SZG))
#define OPART ((bf16_t*)(ws + WS_OPART))
#define AT ((bf16_t*)(ws + WS_A))
#define KMEAN ((float*)(ws + WS_KMEAN))
#define SEL ((unsigned*)(ws + WS_SEL))
#define LPART ((float*)(ws + WS_LPART))
#define TAB ((f32x2*)(ws + WS_TAB))
#define LIST ((unsigned short*)(ws + WS_LIST))
#define CNT ((unsigned*)(ws + WS_CTL))
    const int lo = args.ph_lo, hi = args.ph_hi;
#define IN(k) (lo <= (k) && (k) < hi)
#define SYNC(k) do { if (IN(k) && IN((k) + 1) && args.coop) { if ((k) == 0) grid.sync(); else xcd_barrier(xbar); } } while (0)
    {
        if (IN(0) && (PH_MASK & 1)) {
            int tid = threadIdx.x; asm volatile("" : "+v"(tid)); const int lane = tid & 63, wave = __builtin_amdgcn_readfirstlane(tid >> 6); (void)lane; (void)wave;
            LAS float* scr = (LAS float*)(lds + wave * 16384);
            const int gw = bx * 8 + wave, NGW = G * 8;
            constexpr int I0 = (D / 64) * (2 * DI / 32), IP = (512 / 64) * (512 / 32), I1 = (DI / 64) * (D / 32), I2 = (D / 64) * (4 * DI / 32), I3 = I1;
            constexpr int NITEMS = I0 + 4 * IP + I1 + I2 + I3;
            for (int it = gw; it < NITEMS; it += NGW) {
                int r = it;
                if (r < I0) { transpose_item(w_in0, D, 2 * DI, WIN0, scr, r, lane); continue; } r -= I0;
                if (r < 4 * IP) { const int gp = r / IP; transpose_item(w_pool0 + (size_t)gp * 512 * 512, 512, 512, WP + (size_t)gp * 512 * 512, scr, r - gp * IP, lane); continue; } r -= 4 * IP;
                if (r < I1) { transpose_item(w_out0, DI, D, WOUT0, scr, r, lane); continue; } r -= I1;
                if (r < I2) { transpose_item(w_in1, D, 4 * DI, WIN1, scr, r, lane); continue; } r -= I2;
                transpose_item(w_out1, DI, D, WOUT1, scr, r, lane);
            }
            for (int idx = bx * NTHREADS + tid; idx < SEQ * 64; idx += G * NTHREADS) rope_entry(idx, TAB);
            for (int m = gw; m < M; m += NGW) rms_row(XIN + (size_t)m * D, norm0, H0 + (size_t)m * D, lane);
        }
        SYNC(0);
        if (IN(1) && (PH_MASK & 2)) {
            int tid = threadIdx.x; asm volatile("" : "+v"(tid)); const int lane = tid & 63, wave = __builtin_amdgcn_readfirstlane(tid >> 6); (void)lane; (void)wave;
            pg8::Gemm<D, D, D> g{H0, WIN0}; pg8::StaticOrder S; S.init(M, 2 * DI, G, bx);
            pg8::EpiSplit<DI, 8, 1> E{U, SZ0, U, U}; pg8::MapPlain<D, D> MP;
            pg8::gemm_phase(lds, g, S, MP, E);
        }
        SYNC(1);
        if (IN(2) && (PH_MASK & 4)) {
            int tid = threadIdx.x; asm volatile("" : "+v"(tid)); const int lane = tid & 63, wave = __builtin_amdgcn_readfirstlane(tid >> 6); (void)lane; (void)wave;
            const int cgp = tid & 255, hh = tid >> 8, col = cgp * 8, w = 2 << (cgp >> 6);
            for (int unit = bx; unit < M / 64; unit += G) {
                const int r0 = unit * 64 + hh * 32, p0 = r0 & (SEQ - 1);
                float sum[8];
#pragma unroll
                for (int e = 0; e < 8; ++e) sum[e] = 0.f;
                for (int i = 1; i < w; ++i) { if (p0 - i >= 0) { const u32x4 v = *(const u32x4*)(U + (size_t)(r0 - i) * DI + col);
                    sum[0] += bf_lo(v.x); sum[1] += bf_hi(v.x); sum[2] += bf_lo(v.y); sum[3] += bf_hi(v.y); sum[4] += bf_lo(v.z); sum[5] += bf_hi(v.z); sum[6] += bf_lo(v.w); sum[7] += bf_hi(v.w); } }
                for (int t = 0; t < 32; ++t) {
                    const int p = p0 + t; const u32x4 v = *(const u32x4*)(U + (size_t)(r0 + t) * DI + col);
                    float c[8] = {bf_lo(v.x), bf_hi(v.x), bf_lo(v.y), bf_hi(v.y), bf_lo(v.z), bf_hi(v.z), bf_lo(v.w), bf_hi(v.w)};
                    const float rc = 1.0f / (float)((p + 1) < w ? (p + 1) : w);
                    float o[8];
#pragma unroll
                    for (int e = 0; e < 8; ++e) { sum[e] += c[e]; o[e] = sum[e] * rc - c[e]; }
                    u32x4 wv; wv.x = cvt_pk_bf16(o[0], o[1]); wv.y = cvt_pk_bf16(o[2], o[3]); wv.z = cvt_pk_bf16(o[4], o[5]); wv.w = cvt_pk_bf16(o[6], o[7]);
                    *(u32x4*)(POOLED + (size_t)(r0 + t) * DI + col) = wv;
                    if (p - w + 1 >= 0) { const u32x4 q = *(const u32x4*)(U + (size_t)(r0 + t - w + 1) * DI + col);
                        sum[0] -= bf_lo(q.x); sum[1] -= bf_hi(q.x); sum[2] -= bf_lo(q.y); sum[3] -= bf_hi(q.y); sum[4] -= bf_lo(q.z); sum[5] -= bf_hi(q.z); sum[6] -= bf_lo(q.w); sum[7] -= bf_hi(q.w); }
                }
            }
        }
        SYNC(2);
        if (IN(3) && (PH_MASK & 8)) {
            int tid = threadIdx.x; asm volatile("" : "+v"(tid)); const int lane = tid & 63, wave = __builtin_amdgcn_readfirstlane(tid >> 6); (void)lane; (void)wave;
            pg8::Gemm<DI, 512, 512> g{POOLED, WP}; pg8::StaticOrder S; S.init(M, DI, G, bx);
            pg8::EpiGate E{U, SZ0, pool_scale0}; pg8::MapPool MP;
            pg8::gemm_phase(lds, g, S, MP, E);
        }
        SYNC(3);
        if (IN(4) && (PH_MASK & 16)) {
            int tid = threadIdx.x; asm volatile("" : "+v"(tid)); const int lane = tid & 63, wave = __builtin_amdgcn_readfirstlane(tid >> 6); (void)lane; (void)wave;
            pg8::Gemm<DI, DI, DI> g{U, WOUT0}; pg8::StaticOrder S; S.init(M, D, G, bx);
            pg8::EpiRes E{XIN, out}; pg8::MapPlain<DI, DI> MP;
            pg8::gemm_phase(lds, g, S, MP, E);
        }
        SYNC(4);
        if (IN(5) && (PH_MASK & 32)) {
            int tid = threadIdx.x; asm volatile("" : "+v"(tid)); const int lane = tid & 63, wave = __builtin_amdgcn_readfirstlane(tid >> 6); (void)lane; (void)wave;
            const int gw = bx * 8 + wave, NGW = G * 8;
            for (int m = gw; m < M; m += NGW) rms_row(out + (size_t)m * D, norm1, H1 + (size_t)m * D, lane);
        }
        SYNC(5);
#pragma unroll
        for (int g = 0; g < NG; ++g) {
            const int pb = 6 + 5 * g;
            if (IN(pb) && (PH_MASK & 64)) {
            int tid = threadIdx.x; asm volatile("" : "+v"(tid)); const int lane = tid & 63, wave = __builtin_amdgcn_readfirstlane(tid >> 6); (void)lane; (void)wave;
                pg8::Gemm<D, D, D> gm{H1, WIN1}; pg8::StaticOrder S; S.init(M, 4 * GW, G, bx);
                pg8::EpiSplit<GW, 2, 3> E{QG, KG, VG, SZG}; pg8::MapQkvz MP{g};
                pg8::gemm_phase(lds, gm, S, MP, E);
            }
            SYNC(pb);
            if (IN(pb + 1) && (PH_MASK & 128)) {
            int tid = threadIdx.x; asm volatile("" : "+v"(tid)); const int lane = tid & 63, wave = __builtin_amdgcn_readfirstlane(tid >> 6); (void)lane; (void)wave;
                LAS float* wsum = (LAS float*)lds;
                const int lp = lane & 31, half = lane >> 5;
                for (int unit = bx; unit < 8 * NB; unit += G) {
                    const int bh = unit >> 5, n = unit & 31, b = bh >> 2, hl = bh & 3;
                    const float gq0 = q_norm1[2 * lp], gq1 = q_norm1[2 * lp + 1], gq2 = q_norm1[64 + 2 * lp], gq3 = q_norm1[65 + 2 * lp];
                    const float gk0 = k_norm1[2 * lp], gk1 = k_norm1[2 * lp + 1], gk2 = k_norm1[64 + 2 * lp], gk3 = k_norm1[65 + 2 * lp];
                    float ks0 = 0.f, ks1 = 0.f, ks2 = 0.f, ks3 = 0.f;
                    for (int it = 0; it < 16; ++it) {
                        const int r = wave * 32 + it * 2 + half, pos = n * BLK + r;
                        const size_t off = (size_t)(b * SEQ + pos) * GW + hl * HD + 2 * lp;
                        const f32x2 cs0 = TAB[pos * 64 + 2 * lp], cs1 = TAB[pos * 64 + 2 * lp + 1];
                        {
                            const unsigned a = *(const unsigned*)(KG + off), c = *(const unsigned*)(KG + off + 64);
                            float x0 = bf_lo(a), x1 = bf_hi(a), x2 = bf_lo(c), x3 = bf_hi(c);
                            float ss = (x0 * x0 + x1 * x1) + (x2 * x2 + x3 * x3);
#pragma unroll
                            for (int o = 1; o < 32; o <<= 1) ss += __shfl_xor(ss, o);
                            const float rstd = 1.0f / sqrtf(ss * (1.f / HD) + EPS);
                            x0 *= rstd * gk0; x1 *= rstd * gk1; x2 *= rstd * gk2; x3 *= rstd * gk3;
                            const float o0 = x0 * cs0.x - x2 * cs0.y, o2 = x2 * cs0.x + x0 * cs0.y, o1 = x1 * cs1.x - x3 * cs1.y, o3 = x3 * cs1.x + x1 * cs1.y;
                            ks0 += o0; ks1 += o1; ks2 += o2; ks3 += o3;
                            *(unsigned*)(KG + off) = cvt_pk_bf16(o0, o1); *(unsigned*)(KG + off + 64) = cvt_pk_bf16(o2, o3);
                        }
                        {
                            const unsigned a = *(const unsigned*)(QG + off), c = *(const unsigned*)(QG + off + 64);
                            float x0 = bf_lo(a), x1 = bf_hi(a), x2 = bf_lo(c), x3 = bf_hi(c);
                            float ss = (x0 * x0 + x1 * x1) + (x2 * x2 + x3 * x3);
#pragma unroll
                            for (int o = 1; o < 32; o <<= 1) ss += __shfl_xor(ss, o);
                            const float rstd = QSCALE / sqrtf(ss * (1.f / HD) + EPS);
                            x0 *= rstd * gq0; x1 *= rstd * gq1; x2 *= rstd * gq2; x3 *= rstd * gq3;
                            const float o0 = x0 * cs0.x - x2 * cs0.y, o2 = x2 * cs0.x + x0 * cs0.y, o1 = x1 * cs1.x - x3 * cs1.y, o3 = x3 * cs1.x + x1 * cs1.y;
                            *(unsigned*)(QG + off) = cvt_pk_bf16(o0, o1); *(unsigned*)(QG + off + 64) = cvt_pk_bf16(o2, o3);
                        }
                    }
                    ks0 += __shfl_xor(ks0, 32); ks1 += __shfl_xor(ks1, 32); ks2 += __shfl_xor(ks2, 32); ks3 += __shfl_xor(ks3, 32);
                    if (half == 0) { wsum[wave * 128 + 2 * lp] = ks0; wsum[wave * 128 + 2 * lp + 1] = ks1; wsum[wave * 128 + 64 + 2 * lp] = ks2; wsum[wave * 128 + 65 + 2 * lp] = ks3; }
                    __syncthreads();
                    if (tid < 128) { float s = 0.f;
#pragma unroll
                        for (int w8 = 0; w8 < 8; ++w8) s += wsum[w8 * 128 + tid];
                        KMEAN[((size_t)(g * 8 + bh) * NB + n) * HD + tid] = s * (1.f / BLK); }
                    __syncthreads();
                }
            }
            SYNC(pb + 1);
            if (IN(pb + 2) && (PH_MASK & 256)) {
            int tid = threadIdx.x; asm volatile("" : "+v"(tid)); const int lane = tid & 63, wave = __builtin_amdgcn_readfirstlane(tid >> 6); (void)lane; (void)wave;
                LAS unsigned char* qt = lds;
                LAS float* km = (LAS float*)(lds + 256 * 272);
                LAS float* mv = (LAS float*)(lds + 256 * 272 + 16384);
                LAS int* mi = (LAS int*)(lds + 256 * 272 + 16384 + 3072);
                for (int unit = bx; unit < 8 * NB; unit += G) {
                    const int bh = unit >> 5, qb = unit & 31, b = bh >> 2, hl = bh & 3;
                    const int qi = tid & 255, hf = tid >> 8;
                    const int s = qb * BLK + qi; const size_t mrow = (size_t)b * SEQ + s;
                    if (qb > 0) {
                        for (int c = tid; c < 256 * 16; c += NTHREADS) { const int r = c >> 4, cc = c & 15;
                            *(LAS u32x4*)(qt + r * 272 + cc * 16) = *(const u32x4*)(QG + ((size_t)b * SEQ + qb * BLK + r) * GW + hl * HD + cc * 8); }
                        for (int c = tid; c < qb * 32; c += NTHREADS) *(LAS f32x4*)(km + c * 4) = *(const f32x4*)(KMEAN + (size_t)(g * 8 + bh) * NB * HD + c * 4);
                        __syncthreads();
                        float v0 = -INFINITY, v1 = -INFINITY, v2 = -INFINITY; int i0 = 255, i1 = 255, i2 = 255;
                        for (int n = hf; n < qb; n += 2) {
                            float acc = 0.f;
#pragma unroll 4
                            for (int c = 0; c < 16; ++c) { const u32x4 qv = *(const LAS u32x4*)(qt + qi * 272 + c * 16); const f32x4 ka = *(const LAS f32x4*)(km + n * 128 + c * 8), kb = *(const LAS f32x4*)(km + n * 128 + c * 8 + 4);
                                acc += bf_lo(qv.x) * ka.x + bf_hi(qv.x) * ka.y + bf_lo(qv.y) * ka.z + bf_hi(qv.y) * ka.w + bf_lo(qv.z) * kb.x + bf_hi(qv.z) * kb.y + bf_lo(qv.w) * kb.z + bf_hi(qv.w) * kb.w; }
                            if (acc > v0) { v2 = v1; i2 = i1; v1 = v0; i1 = i0; v0 = acc; i0 = n; }
                            else if (acc > v1) { v2 = v1; i2 = i1; v1 = acc; i1 = n; }
                            else if (acc > v2) { v2 = acc; i2 = n; }
                        }
                        if (hf == 1) { mv[qi * 3] = v0; mv[qi * 3 + 1] = v1; mv[qi * 3 + 2] = v2; mi[qi * 3] = i0; mi[qi * 3 + 1] = i1; mi[qi * 3 + 2] = i2; }
                        __syncthreads();
                        if (hf == 0) {
#pragma unroll
                            for (int e = 0; e < 3; ++e) { const float acc = mv[qi * 3 + e]; const int n = mi[qi * 3 + e];
                                if (n < 255) {
                                    const bool g0 = acc > v0 || (acc == v0 && n < i0), g1 = acc > v1 || (acc == v1 && n < i1), g2 = acc > v2 || (acc == v2 && n < i2);
                                    if (g0) { v2 = v1; i2 = i1; v1 = v0; i1 = i0; v0 = acc; i0 = n; }
                                    else if (g1) { v2 = v1; i2 = i1; v1 = acc; i1 = n; }
                                    else if (g2) { v2 = acc; i2 = n; }
                                } }
                            SEL[mrow * NH + g * HG + hl] = (unsigned)i0 | ((unsigned)i1 << 8) | ((unsigned)i2 << 16);
                            const int sl[3] = {i0, i1, i2};
#pragma unroll
                            for (int e = 0; e < 3; ++e) if (sl[e] < 255) { const int li = bh * NB + sl[e]; const unsigned pos = atomicAdd(&CNT[g * 256 + li], 1u); LIST[(size_t)li * SEQ + pos] = (unsigned short)(s | (e << 13)); }
                        }
                        __syncthreads();
                    } else if (hf == 0) {
                        SEL[mrow * NH + g * HG + hl] = 0x00ffffffu;
                    }
                }
            }
            SYNC(pb + 2);
            if (IN(pb + 3) && (PH_MASK & 512)) {
            int tid = threadIdx.x; asm volatile("" : "+v"(tid)); const int lane = tid & 63, wave = __builtin_amdgcn_readfirstlane(tid >> 6); (void)lane; (void)wave;
                LAS unsigned char* Ks = lds;
                LAS unsigned char* Vt = lds + 256 * 272;
                LAS int* pre = (LAS int*)(lds + 256 * 272 + 128 * 528);
                LAS float* red = (LAS float*)(lds + 256 * 272 + 128 * 528 + 2048);
                {
                    float mq = 0.f, mk = 0.f;
                    if (tid < 128) { mq = fabsf(q_norm1[tid]); mk = fabsf(k_norm1[tid]); }
#pragma unroll
                    for (int o = 1; o < 64; o <<= 1) { mq = fmaxf(mq, __shfl_xor(mq, o)); mk = fmaxf(mk, __shfl_xor(mk, o)); }
                    if (lane == 0) { red[wave * 2] = mq; red[wave * 2 + 1] = mk; }
                    if (tid < 256) pre[tid + 1] = 1 + (int)((CNT[g * 256 + tid] + 255u) >> 8);
                    if (tid == 0) pre[0] = 0;
                    __syncthreads();
                    if (tid == 0) { int a = 0; for (int i = 1; i <= 256; ++i) { a += pre[i]; pre[i] = a; } }
                    __syncthreads();
                }
                const float MSH = 128.0f * QSCALE * fmaxf(red[0], red[2]) * fmaxf(red[1], red[3]) * 1.02f;
                const int total = pre[256];
                const int fr = lane & 15, fq = lane >> 4;
#pragma unroll 1
                for (int item = bx; item < total; item += G) {
                    int loi = 0, hii = 256;
                    while (hii - loi > 1) { const int mid = (loi + hii) >> 1; if (pre[mid] <= item) loi = mid; else hii = mid; }
                    const int li = loi, c = item - pre[li], bh = li >> 5, n = li & 31, b = bh >> 2, hl = bh & 3;
                    const int cnt = (int)CNT[g * 256 + li];
                    const size_t rowbase = (size_t)b * SEQ;
                    __syncthreads();
                    for (int cc = tid; cc < 256 * 16; cc += NTHREADS) { const int r = cc >> 4, c16 = cc & 15;
                        *(LAS u32x4*)(Ks + r * 272 + c16 * 16) = *(const u32x4*)(KG + (rowbase + n * BLK + r) * GW + hl * HD + c16 * 8); }
                    for (int task = tid; task < 1024; task += NTHREADS) {
                        const int a = (task & 15) | ((task >> 5) & 3) << 4, cch = ((task >> 4) & 1) | ((task >> 7) << 1);
                        u32x4 v[4];
#pragma unroll
                        for (int kk = 0; kk < 4; ++kk) v[kk] = *(const u32x4*)(VG + (rowbase + n * BLK + a * 4 + kk) * GW + hl * HD + cch * 8);
#pragma unroll
                        for (int e = 0; e < 4; ++e) {
                            const unsigned w0 = e == 0 ? v[0].x : e == 1 ? v[0].y : e == 2 ? v[0].z : v[0].w, w1 = e == 0 ? v[1].x : e == 1 ? v[1].y : e == 2 ? v[1].z : v[1].w;
                            const unsigned w2 = e == 0 ? v[2].x : e == 1 ? v[2].y : e == 2 ? v[2].z : v[2].w, w3 = e == 0 ? v[3].x : e == 1 ? v[3].y : e == 2 ? v[3].z : v[3].w;
                            u32x2 lo2, hi2;
                            lo2.x = (w0 & 0xffffu) | (w1 << 16); lo2.y = (w2 & 0xffffu) | (w3 << 16);
                            hi2.x = (w0 >> 16) | (w1 & 0xffff0000u); hi2.y = (w2 >> 16) | (w3 & 0xffff0000u);
                            *(LAS u32x2*)(Vt + (cch * 8 + 2 * e) * 528 + a * 8) = lo2;
                            *(LAS u32x2*)(Vt + (cch * 8 + 2 * e + 1) * 528 + a * 8) = hi2;
                        }
                    }
                    int qpos[2], qslot[2]; bool qok[2];
                    bf16x8 qf[2][4];
#pragma unroll
                    for (int t = 0; t < 2; ++t) {
                        const int ridx = wave * 32 + t * 16 + fr;
                        if (c == 0) { qpos[t] = n * BLK + ridx; qslot[t] = 3; qok[t] = true; }
                        else { const int lidx = (c - 1) * 256 + ridx; qok[t] = lidx < cnt; const unsigned e = LIST[(size_t)li * SEQ + (qok[t] ? lidx : 0)]; qpos[t] = e & 8191; qslot[t] = e >> 13; }
                        const bf16_t* qp = QG + (rowbase + qpos[t]) * GW + hl * HD + fq * 8;
#pragma unroll
                        for (int ks = 0; ks < 4; ++ks) qf[t][ks] = *(const bf16x8*)(qp + ks * 32);
                    }
                    __syncthreads();
                    f32x4 oacc[2][8]; float lsum[2] = {0.f, 0.f};
#pragma unroll
                    for (int t = 0; t < 2; ++t)
#pragma unroll
                        for (int dt = 0; dt < 8; ++dt) oacc[t][dt] = (f32x4){0.f, 0.f, 0.f, 0.f};
                    const int qrel0 = qpos[0] - n * BLK, qrel1 = qpos[1] - n * BLK;
#pragma unroll 1
                    for (int kg = 0; kg < 8; ++kg) {
                        f32x4 sacc[2][2];
#pragma unroll
                        for (int kt = 0; kt < 2; ++kt) { sacc[kt][0] = (f32x4){0.f, 0.f, 0.f, 0.f}; sacc[kt][1] = (f32x4){0.f, 0.f, 0.f, 0.f};
#pragma unroll
                            for (int ks = 0; ks < 4; ++ks) { const bf16x8 kf = *(const LAS bf16x8*)(Ks + (kg * 32 + kt * 16 + fr) * 272 + ks * 64 + fq * 16);
                                sacc[kt][0] = __builtin_amdgcn_mfma_f32_16x16x32_bf16(kf, qf[0][ks], sacc[kt][0], 0, 0, 0);
                                sacc[kt][1] = __builtin_amdgcn_mfma_f32_16x16x32_bf16(kf, qf[1][ks], sacc[kt][1], 0, 0, 0); } }
                        bf16x8 pb[2];
#pragma unroll
                        for (int t = 0; t < 2; ++t) {
                            float p[8];
#pragma unroll
                            for (int kt = 0; kt < 2; ++kt)
#pragma unroll
                                for (int j = 0; j < 4; ++j) { float pv = __builtin_amdgcn_exp2f(sacc[kt][t][j] - MSH);
                                    if (c == 0) { const int key = kg * 32 + kt * 16 + fq * 4 + j; if (key > (t == 0 ? qrel0 : qrel1)) pv = 0.f; }
                                    p[kt * 4 + j] = pv; lsum[t] += pv; }
                            u32x4 w; w.x = cvt_pk_bf16(p[0], p[1]); w.y = cvt_pk_bf16(p[2], p[3]); w.z = cvt_pk_bf16(p[4], p[5]); w.w = cvt_pk_bf16(p[6], p[7]);
                            pb[t] = __builtin_bit_cast(bf16x8, w);
                        }
#pragma unroll
                        for (int dt = 0; dt < 8; ++dt) {
                            const u32x2 va = *(const LAS u32x2*)(Vt + (dt * 16 + fr) * 528 + kg * 64 + fq * 8), vb = *(const LAS u32x2*)(Vt + (dt * 16 + fr) * 528 + kg * 64 + 32 + fq * 8);
                            u32x4 vv; vv.x = va.x; vv.y = va.y; vv.z = vb.x; vv.w = vb.y; const bf16x8 vf = __builtin_bit_cast(bf16x8, vv);
                            oacc[0][dt] = __builtin_amdgcn_mfma_f32_16x16x32_bf16(vf, pb[0], oacc[0][dt], 0, 0, 0);
                            oacc[1][dt] = __builtin_amdgcn_mfma_f32_16x16x32_bf16(vf, pb[1], oacc[1][dt], 0, 0, 0);
                        }
                    }
#pragma unroll
                    for (int t = 0; t < 2; ++t) {
                        float l = lsum[t]; l += __shfl_xor(l, 16); l += __shfl_xor(l, 32);
                        if (qok[t]) {
                            const size_t pair = (rowbase + qpos[t]) * HG + hl;
                            bf16_t* op = OPART + (pair * 4 + qslot[t]) * HD + fq * 4;
#pragma unroll
                            for (int dt = 0; dt < 8; ++dt) { u32x2 w; w.x = cvt_pk_bf16(oacc[t][dt][0], oacc[t][dt][1]); w.y = cvt_pk_bf16(oacc[t][dt][2], oacc[t][dt][3]); *(u32x2*)(op + dt * 16) = w; }
                            if (fq == 0) LPART[pair * 4 + qslot[t]] = l;
                        }
                    }
                }
            }
            SYNC(pb + 3);
            if (IN(pb + 4) && (PH_MASK & 1024)) {
            int tid = threadIdx.x; asm volatile("" : "+v"(tid)); const int lane = tid & 63, wave = __builtin_amdgcn_readfirstlane(tid >> 6); (void)lane; (void)wave;
                for (int idx = bx * NTHREADS + tid; idx < M * HG * 16; idx += G * NTHREADS) {
                    const int pair = idx >> 4, ch = idx & 15, m = pair >> 2, hl = pair & 3;
                    const unsigned sel = SEL[(size_t)m * NH + g * HG + hl];
                    float o[8]; float l = LPART[(size_t)pair * 4 + 3];
                    { const u32x4 v = *(const u32x4*)(OPART + ((size_t)pair * 4 + 3) * HD + ch * 8);
                      o[0] = bf_lo(v.x); o[1] = bf_hi(v.x); o[2] = bf_lo(v.y); o[3] = bf_hi(v.y); o[4] = bf_lo(v.z); o[5] = bf_hi(v.z); o[6] = bf_lo(v.w); o[7] = bf_hi(v.w); }
#pragma unroll
                    for (int e = 0; e < 3; ++e) if (((sel >> (8 * e)) & 0xffu) != 0xffu) {
                        const u32x4 v = *(const u32x4*)(OPART + ((size_t)pair * 4 + e) * HD + ch * 8); l += LPART[(size_t)pair * 4 + e];
                        o[0] += bf_lo(v.x); o[1] += bf_hi(v.x); o[2] += bf_lo(v.y); o[3] += bf_hi(v.y); o[4] += bf_lo(v.z); o[5] += bf_hi(v.z); o[6] += bf_lo(v.w); o[7] += bf_hi(v.w); }
                    const float rl = 1.0f / l;
                    const u32x4 z = *(const u32x4*)(SZG + (size_t)m * GW + hl * HD + ch * 8);
                    u32x4 w; w.x = cvt_pk_bf16(o[0] * rl * bf_lo(z.x), o[1] * rl * bf_hi(z.x)); w.y = cvt_pk_bf16(o[2] * rl * bf_lo(z.y), o[3] * rl * bf_hi(z.y));
                    w.z = cvt_pk_bf16(o[4] * rl * bf_lo(z.z), o[5] * rl * bf_hi(z.z)); w.w = cvt_pk_bf16(o[6] * rl * bf_lo(z.w), o[7] * rl * bf_hi(z.w));
                    *(u32x4*)(AT + (size_t)m * DI + g * GW + hl * HD + ch * 8) = w;
                }
            }
            SYNC(pb + 4);
        }
        if (IN(6 + 5 * NG) && (PH_MASK & 2048)) {
            int tid = threadIdx.x; asm volatile("" : "+v"(tid)); const int lane = tid & 63, wave = __builtin_amdgcn_readfirstlane(tid >> 6); (void)lane; (void)wave;
            pg8::Gemm<DI, DI, DI> gm{AT, WOUT1}; pg8::StaticOrder S; S.init(M, D, G, bx);
            pg8::EpiRes E{out, out}; pg8::MapPlain<DI, DI> MP;
            pg8::gemm_phase(lds, gm, S, MP, E);
        }
    }
}

constexpr int NPHASES = 6 + 5 * NG + 1;

extern "C" void kernel_launch(void* const* d_in, const int* in_sizes, int n_in, void* d_out, int out_size, void* d_ws, size_t ws_size, hipStream_t stream) {
    static int grid = 0;
    if (grid == 0) {
        int dev = 0, cus = 0, per_cu = 0;
        hipGetDevice(&dev);
        hipDeviceGetAttribute(&cus, hipDeviceAttributeMultiprocessorCount, dev);
        hipFuncSetAttribute((const void*)mega_fwd, hipFuncAttributeMaxDynamicSharedMemorySize, LDS_BYTES);
        hipOccupancyMaxActiveBlocksPerMultiprocessor(&per_cu, (const void*)mega_fwd, NTHREADS, LDS_BYTES);
        if (per_cu < 1) { fprintf(stderr, "kernel_launch: occupancy query says %d blocks per CU\n", per_cu); per_cu = 1; }
        grid = cus;
        if (ws_size < WS_END) fprintf(stderr, "kernel_launch: workspace too small: %zu < %zu\n", ws_size, (size_t)WS_END);
    }
    hipMemsetAsync((char*)d_ws + WS_CTL, 0, CTL_BYTES, stream);
    Args a{};
    for (int i = 0; i < 11; ++i) a.in[i] = (const float*)d_in[i];
    a.out = (float*)d_out; a.ws = (unsigned char*)d_ws; a.pad = 0;
#if defined(MK_PER_PHASE)
    for (int ph = 0; ph < NPHASES; ++ph) { a.ph_lo = ph; a.ph_hi = ph + 1; a.coop = 0; hipLaunchKernelGGL(mega_fwd, dim3(grid), dim3(NTHREADS), LDS_BYTES, stream, a); }
#else
    a.ph_lo = 0; a.ph_hi = NPHASES; a.coop = 1;
    void* kargs[] = {&a};
    hipError_t e = hipLaunchCooperativeKernel((const void*)mega_fwd, dim3(grid), dim3(NTHREADS), kargs, LDS_BYTES, stream);
    if (e != hipSuccess) fprintf(stderr, "cooperative launch failed: %s (grid %d)\n", hipGetErrorString(e), grid);
#endif
}
```

```cpp
#include <hip/hip_runtime.h>
#include <hip/hip_cooperative_groups.h>
#include <cstdio>
#include <cstdint>
namespace cg = cooperative_groups;

#define LAS __attribute__((address_space(3)))
typedef unsigned short bf16_t;
typedef short bf16x8 __attribute__((ext_vector_type(8)));
typedef float f32x4 __attribute__((ext_vector_type(4)));
typedef float f32x2 __attribute__((ext_vector_type(2)));
typedef unsigned u32x4 __attribute__((ext_vector_type(4)));
typedef unsigned u32x2 __attribute__((ext_vector_type(2)));

constexpr int SEQ = 8192, NBATCH = 2, M = NBATCH * SEQ, D = 1024, DI = 2048, NH = 16, HD = 128, BLK = 256, NB = SEQ / BLK;
constexpr int NG = 4, HG = NH / NG, GW = HG * HD;
constexpr float EPS = 1e-6f;
constexpr float QSCALE = 0.08838834764831845f * 1.4426950408889634f;

constexpr size_t MiB = 1u << 20;
constexpr size_t WS_CTL = 0, CTL_BYTES = 65536;
constexpr size_t WS_BAR = 8192;
constexpr size_t WS_KMEAN = 1 * MiB;
constexpr size_t WS_SEL = 2 * MiB;
constexpr size_t WS_LPART = 3 * MiB;
constexpr size_t WS_TAB = 4 * MiB;
constexpr size_t WS_WIN1 = 8 * MiB, WS_WOUT1 = 24 * MiB;
constexpr size_t WS_LIST = 28 * MiB;
constexpr size_t WS_WIN0 = 28 * MiB, WS_WP = 36 * MiB, WS_WOUT0 = 38 * MiB;
constexpr size_t WS_H0 = 42 * MiB, WS_POOLED = 42 * MiB, WS_U = 106 * MiB, WS_SZ0 = 170 * MiB;
constexpr size_t WS_H1 = 32 * MiB, WS_QG = 64 * MiB, WS_KG = 80 * MiB, WS_VG = 96 * MiB, WS_SZG = 112 * MiB;
constexpr size_t WS_OPART = 128 * MiB, WS_A = 192 * MiB, WS_END = 256 * MiB;

constexpr int LDS_BYTES = 140 * 1024;
constexpr int NTHREADS = 512;
#ifndef PH_MASK
#define PH_MASK 0xfff
#endif

__device__ __forceinline__ unsigned cvt_pk_bf16(float lo, float hi) { unsigned r; asm volatile("v_cvt_pk_bf16_f32 %0, %1, %2" : "=v"(r) : "v"(lo), "v"(hi)); return r; }
__device__ __forceinline__ float bf_lo(unsigned u) { return __uint_as_float(u << 16); }
__device__ __forceinline__ float bf_hi(unsigned u) { return __uint_as_float(u & 0xffff0000u); }
__device__ __forceinline__ float silu_f(float z) { return z * __builtin_amdgcn_rcpf(1.0f + __builtin_amdgcn_exp2f(-1.4426950408889634f * z)); }
__device__ __forceinline__ float wave_sum(float v) {
#pragma unroll
    for (int o = 1; o < 64; o <<= 1) v += __shfl_xor(v, o);
    return v;
}

namespace pg8 {
constexpr int BM = 256, BK = 64, HALF = 128, HTB = HALF * BK * 2, STAGE_BYTES = 8 * HTB, NXCD = 8, WGM = 8;
__host__ __device__ __forceinline__ int lds_byte(int r, int c) { const int st = (r >> 4) * 2 + (c >> 5), rr = r & 15, cc = c & 31, ob = rr * 64 + cc * 2; return st * 1024 + (ob ^ (((ob >> 9) & 1) << 5)); }
__host__ __device__ __forceinline__ void stage_rc(int b, int& R, int& C) { const int st = b / 1024, sb = b % 1024, swz = sb ^ (((sb >> 9) & 1) << 5); R = (st >> 1) * 16 + swz / 64; C = (st & 1) * 32 + (swz % 64) / 2; }
__host__ __device__ __forceinline__ int perm32(int rho) { const int n = rho >> 4, i = rho & 15; return 8 * (i >> 2) + 4 * n + (i & 3); }

struct Unit { int pm, pn; };
template <int LDA_, int LDB_, int K_> struct Gemm { const bf16_t* A; const bf16_t* Bt; static constexpr int lda = LDA_, ldb = LDB_, K = K_; };
struct StaticOrder {
    int nM, nN, nwg, G, c;
    __device__ void init(int M_, int N_, int G_, int c_) { nM = M_ / BM; nN = N_ / BM; nwg = nM * nN; G = G_; c = c_; }
    __device__ bool next(int i, Unit& u) const {
        const long L = (long)i * G + c; if (L >= nwg) return false;
        int wgid = (int)L; { const int q = nwg / NXCD, r = nwg % NXCD, xcd = wgid % NXCD, off = wgid / NXCD; wgid = (xcd < r ? xcd * (q + 1) : r * (q + 1) + (xcd - r) * q) + off; }
        const int nig = WGM * nN, gid = wgid / nig, fm = gid * WGM, gsz = (nM - fm) < WGM ? (nM - fm) : WGM;
        u.pm = fm + ((wgid % nig) % gsz); u.pn = (wgid % nig) / gsz; return true;
    }
};
template <class Epi, class Map, class GemmT>
__device__ __forceinline__ void gemm_phase(LAS unsigned char* lds, const GemmT g, const StaticOrder& S, const Map& MP, const Epi& E) {
    int tid_ = threadIdx.x; asm volatile("" : "+v"(tid_));
    const int tid = tid_, wid = __builtin_amdgcn_readfirstlane(tid >> 6), lane = tid & 63, wr = wid >> 2, wc = wid & 3, fr = lane & 15, fq = lane >> 4;
    constexpr int K = GemmT::K, nt = K / BK;
    unsigned voffA[2], voffB[2];
#pragma unroll
    for (int i = 0; i < 2; ++i) { int R, C; stage_rc(tid * 16 + i * 8192, R, C); const int Rb = Epi::PERM ? ((R & ~31) + perm32(R & 31)) : R;
        voffA[i] = (unsigned)(R * GemmT::lda + C) * 2u; voffB[i] = (unsigned)(Rb * GemmT::ldb + C) * 2u; }
    constexpr size_t kstep = (size_t)(BK * 2);
    constexpr size_t hstepA = (size_t)HALF * GemmT::lda * 2, hstepB = (size_t)HALF * GemmT::ldb * 2;
    const unsigned ldsw = (unsigned)wid * 1024u;
    const int aoff = lds_byte(wr * 64 + fr, fq * 8), boff = lds_byte(wc * 32 + fr, fq * 8);
#define PG8_SA(b, h) (((b) * 2 + (h)) * HTB)
#define PG8_SB(b, h) ((4 + (b) * 2 + (h)) * HTB)
#define PG8_STAGE(bufoff, gbase, voff) do { _Pragma("unroll") for (int _i = 0; _i < 2; ++_i) \
        __builtin_amdgcn_global_load_lds((const unsigned*)((const char*)(gbase) + (voff)[_i]), (LAS unsigned*)(lds + (bufoff) + ldsw + _i * 8192), 16, 0, 0); } while (0)
#define PG8_LDA(dst, b, h) do { _Pragma("unroll") for (int m = 0; m < 4; ++m) _Pragma("unroll") for (int k = 0; k < 2; ++k) dst[m][k] = *(const LAS bf16x8*)(lds + PG8_SA(b, h) + aoff + m * 2048 + k * 1024); } while (0)
#define PG8_LDB(dst, b, h) do { _Pragma("unroll") for (int n = 0; n < 2; ++n) _Pragma("unroll") for (int k = 0; k < 2; ++k) dst[n][k] = *(const LAS bf16x8*)(lds + PG8_SB(b, h) + boff + n * 2048 + k * 1024); } while (0)
#define PG8_MMA(ai, bj, At, Bt) do { __builtin_amdgcn_s_setprio(1); _Pragma("unroll") for (int m = 0; m < 4; ++m) _Pragma("unroll") for (int n = 0; n < 2; ++n) _Pragma("unroll") for (int k = 0; k < 2; ++k) \
        acc[ai][bj][m][n] = __builtin_amdgcn_mfma_f32_16x16x32_bf16(Bt[n][k], At[m][k], acc[ai][bj][m][n], 0, 0, 0); __builtin_amdgcn_s_setprio(0); } while (0)
#define PG8_WAIT_V(n) asm volatile("s_waitcnt vmcnt(" #n ")" ::: "memory")
#define PG8_WAIT_L(n) asm volatile("s_waitcnt lgkmcnt(" #n ")" ::: "memory")
#define PG8_BAR __builtin_amdgcn_s_barrier()
#define PG8_SCHED __builtin_amdgcn_sched_barrier(0)
    Unit cur, nxt; int ui = 0;
    if (!S.next(0, cur)) return;
    f32x4 acc[2][2][4][2];
#pragma unroll
    for (int a = 0; a < 2; ++a)
#pragma unroll
        for (int b = 0; b < 2; ++b)
#pragma unroll
            for (int m = 0; m < 4; ++m)
#pragma unroll
                for (int n = 0; n < 2; ++n) acc[a][b][m][n] = (f32x4){0.f, 0.f, 0.f, 0.f};
    bf16x8 At[4][2], B0[2][2], B1[2][2];
    const char* cA = (const char*)(g.A + MP.a_off(cur)); const char* cB = (const char*)(g.Bt + MP.b_off(cur));
    PG8_STAGE(PG8_SB(0, 0), cB, voffB); PG8_STAGE(PG8_SB(0, 1), cB + hstepB, voffB); PG8_STAGE(PG8_SA(0, 0), cA, voffA); PG8_STAGE(PG8_SA(0, 1), cA + hstepA, voffA);
    if (wr == 1) PG8_BAR;
    PG8_WAIT_V(2); PG8_BAR;
    PG8_STAGE(PG8_SB(1, 0), cB + kstep, voffB); PG8_STAGE(PG8_SA(1, 0), cA + kstep, voffA); PG8_STAGE(PG8_SB(1, 1), cB + hstepB + kstep, voffB);
    PG8_WAIT_V(6); PG8_BAR;
    for (;;) {
        const bool has_next = S.next(ui + 1, nxt);
        const char* nA = has_next ? (const char*)(g.A + MP.a_off(nxt)) : cA; const char* nB = has_next ? (const char*)(g.Bt + MP.b_off(nxt)) : cB;
        for (int t = 0; t < nt; t += 2) {
            const bool last = (t == nt - 2);
            const char* a1 = cA + (size_t)(t + 1) * kstep;
            const char* a2 = last ? nA : cA + (size_t)(t + 2) * kstep; const char* b2 = last ? nB : cB + (size_t)(t + 2) * kstep;
            const char* a3 = a2 + kstep; const char* b3 = b2 + kstep;
            PG8_LDB(B0, 0, 0); PG8_LDB(B1, 0, 1); PG8_SCHED; PG8_LDA(At, 0, 0); PG8_STAGE(PG8_SA(1, 1), a1 + hstepA, voffA);
            PG8_WAIT_V(8); PG8_WAIT_L(0); PG8_BAR; PG8_MMA(0, 0, At, B0); PG8_MMA(0, 1, At, B1); PG8_BAR; PG8_SCHED;
            PG8_LDA(At, 0, 1); PG8_STAGE(PG8_SB(0, 0), b2, voffB); PG8_STAGE(PG8_SB(0, 1), b2 + hstepB, voffB); PG8_STAGE(PG8_SA(0, 0), a2, voffA);
            PG8_WAIT_V(8); PG8_WAIT_L(0); PG8_BAR; PG8_MMA(1, 0, At, B0); PG8_MMA(1, 1, At, B1); PG8_BAR; PG8_SCHED;
            PG8_LDB(B0, 1, 0); PG8_LDB(B1, 1, 1); PG8_SCHED; PG8_LDA(At, 1, 0); PG8_STAGE(PG8_SA(0, 1), a2 + hstepA, voffA);
            PG8_WAIT_V(8); PG8_WAIT_L(0); PG8_BAR; PG8_MMA(0, 0, At, B0); PG8_MMA(0, 1, At, B1); PG8_BAR; PG8_SCHED;
            PG8_LDA(At, 1, 1); PG8_STAGE(PG8_SB(1, 0), b3, voffB); PG8_STAGE(PG8_SB(1, 1), b3 + hstepB, voffB); PG8_STAGE(PG8_SA(1, 0), a3, voffA);
            PG8_WAIT_V(8); PG8_WAIT_L(0); PG8_BAR; PG8_MMA(1, 0, At, B0); PG8_MMA(1, 1, At, B1); PG8_BAR; PG8_SCHED;
        }
        if (wr == 0) PG8_BAR;
        E(acc, cur, wr, wc, fr, fq);
        if (!has_next) break;
#pragma unroll
        for (int a = 0; a < 2; ++a)
#pragma unroll
            for (int b = 0; b < 2; ++b)
#pragma unroll
                for (int m = 0; m < 4; ++m)
#pragma unroll
                    for (int n = 0; n < 2; ++n) acc[a][b][m][n] = (f32x4){0.f, 0.f, 0.f, 0.f};
        cur = nxt; cA = nA; cB = nB; ++ui;
        if (wr == 1) PG8_BAR;
    }
    PG8_WAIT_V(0);
    PG8_BAR;
#undef PG8_SA
#undef PG8_SB
#undef PG8_STAGE
#undef PG8_LDA
#undef PG8_LDB
#undef PG8_MMA
#undef PG8_WAIT_V
#undef PG8_WAIT_L
#undef PG8_BAR
#undef PG8_SCHED
}

template <int ldc, int tiles_per_dst, int silu_dst> struct EpiSplit {
    static constexpr bool PERM = true;
    bf16_t *d0, *d1, *d2, *d3;
    __device__ __forceinline__ void operator()(const f32x4 (&acc)[2][2][4][2], const Unit& u, int wr, int wc, int fr, int fq) const {
        const int di = u.pn / tiles_per_dst, ct = u.pn - di * tiles_per_dst;
        bf16_t* base = di == 0 ? d0 : di == 1 ? d1 : di == 2 ? d2 : d3; const bool act = (di == silu_dst);
        const int row0 = u.pm * BM + wr * 64 + fr, col0 = ct * BM + wc * 32 + 8 * fq;
#pragma unroll
        for (int ai = 0; ai < 2; ++ai)
#pragma unroll
            for (int m = 0; m < 4; ++m) { bf16_t* rowp = base + (size_t)(row0 + ai * HALF + m * 16) * ldc + col0;
#pragma unroll
                for (int bj = 0; bj < 2; ++bj) { f32x4 v0 = acc[ai][bj][m][0], v1 = acc[ai][bj][m][1];
                    if (act) { v0 = (f32x4){silu_f(v0[0]), silu_f(v0[1]), silu_f(v0[2]), silu_f(v0[3])}; v1 = (f32x4){silu_f(v1[0]), silu_f(v1[1]), silu_f(v1[2]), silu_f(v1[3])}; }
                    u32x4 w; w.x = cvt_pk_bf16(v0[0], v0[1]); w.y = cvt_pk_bf16(v0[2], v0[3]); w.z = cvt_pk_bf16(v1[0], v1[1]); w.w = cvt_pk_bf16(v1[2], v1[3]);
                    *(u32x4*)(rowp + bj * HALF) = w; } }
    }
};
struct EpiGate {
    static constexpr bool PERM = true; static constexpr int ldc = DI;
    bf16_t* Y; const bf16_t* SZ; const float* scale;
    __device__ __forceinline__ void operator()(const f32x4 (&acc)[2][2][4][2], const Unit& u, int wr, int wc, int fr, int fq) const {
        const int row0 = u.pm * BM + wr * 64 + fr, col0 = u.pn * BM + wc * 32 + 8 * fq;
        f32x4 sc[2][2];
#pragma unroll
        for (int bj = 0; bj < 2; ++bj) { sc[bj][0] = *(const f32x4*)(scale + col0 + bj * HALF); sc[bj][1] = *(const f32x4*)(scale + col0 + bj * HALF + 4); }
#pragma unroll
        for (int ai = 0; ai < 2; ++ai)
#pragma unroll
            for (int m = 0; m < 4; ++m) { const size_t off = (size_t)(row0 + ai * HALF + m * 16) * ldc + col0;
#pragma unroll
                for (int bj = 0; bj < 2; ++bj) { const u32x4 z = *(const u32x4*)(SZ + off + bj * HALF);
                    const f32x4 v0 = acc[ai][bj][m][0] * sc[bj][0], v1 = acc[ai][bj][m][1] * sc[bj][1];
                    u32x4 w; w.x = cvt_pk_bf16(v0[0] * bf_lo(z.x), v0[1] * bf_hi(z.x)); w.y = cvt_pk_bf16(v0[2] * bf_lo(z.y), v0[3] * bf_hi(z.y));
                    w.z = cvt_pk_bf16(v1[0] * bf_lo(z.z), v1[1] * bf_hi(z.z)); w.w = cvt_pk_bf16(v1[2] * bf_lo(z.w), v1[3] * bf_hi(z.w));
                    *(u32x4*)(Y + off + bj * HALF) = w; } }
    }
};
struct EpiRes {
    static constexpr bool PERM = false; static constexpr int ldc = D;
    const float* base; float* out;
    __device__ __forceinline__ void operator()(const f32x4 (&acc)[2][2][4][2], const Unit& u, int wr, int wc, int fr, int fq) const {
        const int row0 = u.pm * BM + wr * 64 + fr, col0 = u.pn * BM + wc * 32 + 4 * fq;
#pragma unroll
        for (int ai = 0; ai < 2; ++ai)
#pragma unroll
            for (int m = 0; m < 4; ++m) { const size_t off = (size_t)(row0 + ai * HALF + m * 16) * ldc + col0;
#pragma unroll
                for (int bj = 0; bj < 2; ++bj)
#pragma unroll
                    for (int n = 0; n < 2; ++n) { const f32x4 b = *(const f32x4*)(base + off + bj * HALF + n * 16); *(f32x4*)(out + off + bj * HALF + n * 16) = b + acc[ai][bj][m][n]; } }
    }
};
template <int lda, int ldb> struct MapPlain { __device__ __forceinline__ size_t a_off(const Unit& u) const { return (size_t)u.pm * BM * lda; } __device__ __forceinline__ size_t b_off(const Unit& u) const { return (size_t)u.pn * BM * ldb; } };
struct MapPool { __device__ __forceinline__ size_t a_off(const Unit& u) const { return (size_t)u.pm * BM * DI + (size_t)(u.pn >> 1) * 512; } __device__ __forceinline__ size_t b_off(const Unit& u) const { return (size_t)u.pn * BM * 512; } };
struct MapQkvz { int g; __device__ __forceinline__ size_t a_off(const Unit& u) const { return (size_t)u.pm * BM * D; } __device__ __forceinline__ size_t b_off(const Unit& u) const { return (size_t)((u.pn >> 1) * DI + g * GW + (u.pn & 1) * BM) * D; } };
}

#define XB_TMO      128
#define XB_XCNT(j)  (256  + 64 * (j))
#define XB_XSUB(j)  (1280 + 64 * (j))
#define XB_XGEN(j)  (2304 + 64 * (j))
#define XB_TOP      3328
#define XB_TOPGEN   3392
#define XCD_BAR_WORDS 3456
#define XB_SPIN_CAP (1u << 18)
__device__ __forceinline__ unsigned xb_ld(unsigned* p)              { return __hip_atomic_load(p, __ATOMIC_RELAXED, __HIP_MEMORY_SCOPE_AGENT); }
__device__ __forceinline__ unsigned xb_add(unsigned* p, unsigned v) { return __hip_atomic_fetch_add(p, v, __ATOMIC_RELAXED, __HIP_MEMORY_SCOPE_AGENT); }
__device__ __forceinline__ unsigned xb_xcc_id() { return (unsigned)__builtin_amdgcn_s_getreg((3 << 11) | 20) & 0xFu; }
#define XB_SPIN(cond, bar) do { unsigned _sp = 0; while (cond) { __builtin_amdgcn_s_sleep(1); \
    if ((++_sp & 255u) == 0u) { if (xb_ld(&(bar)[XB_TMO])) break; if (_sp > XB_SPIN_CAP) { atomicAdd(&(bar)[XB_TMO], 1u); break; } } } } while (0)
struct XcdBarrier { unsigned* bar; unsigned x; volatile LAS unsigned* st; };
__device__ __forceinline__ XcdBarrier xcd_barrier_post(unsigned* bar, volatile LAS unsigned* st) {
    XcdBarrier b; b.bar = bar; b.x = xb_xcc_id(); b.st = st;
    if (threadIdx.x == 0) (void)xb_add(&bar[XB_XCNT(b.x)], 1u);
    return b;
}
__device__ __forceinline__ void xcd_barrier_complete(unsigned* bar, unsigned x, unsigned& nloc, unsigned& nx) {
    const unsigned G = gridDim.x * gridDim.y * gridDim.z;
    unsigned sum, cnt, mine, sp = 0u;
    for (;;) {
        sum = 0u; cnt = 0u; mine = 0u;
#pragma unroll
        for (unsigned j = 0; j < 16; ++j) { const unsigned c = xb_ld(&bar[XB_XCNT(j)]); sum += c; cnt += (c > 0u) ? 1u : 0u; mine = (j == x) ? c : mine; }
        if (sum == G) break;
        __builtin_amdgcn_s_sleep(1);
        if ((++sp & 255u) == 0u) { if (xb_ld(&bar[XB_TMO])) break; if (sp > XB_SPIN_CAP) { atomicAdd(&bar[XB_TMO], 1u); break; } }
    }
    nloc = mine > 0u ? mine : 1u; nx = cnt > 0u ? cnt : 1u;
}
__device__ __forceinline__ void xcd_barrier(const XcdBarrier& b) {
    asm volatile("s_waitcnt vmcnt(0)" ::: "memory");
    __syncthreads();
    if (threadIdx.x == 0) {
        unsigned* bar = b.bar;
        __builtin_amdgcn_s_waitcnt(0);
        unsigned nloc = b.st[0], nx = b.st[1];
        if (nloc == 0u) { xcd_barrier_complete(bar, b.x, nloc, nx); b.st[0] = nloc; b.st[1] = nx; }
        const unsigned old = xb_add(&bar[XB_XSUB(b.x)], 1u);
        const unsigned gen = old / nloc;
        if (old + 1u == (gen + 1u) * nloc) {
            __builtin_amdgcn_fence(__ATOMIC_RELEASE, "agent");
            asm volatile("s_waitcnt vmcnt(0)" ::: "memory");
            const unsigned og = xb_add(&bar[XB_TOP], 1u);
            const unsigned tg = og / nx;
            if (og + 1u == (tg + 1u) * nx) xb_add(&bar[XB_TOPGEN], 1u);
            else XB_SPIN(xb_ld(&bar[XB_TOPGEN]) == tg, bar);
            __builtin_amdgcn_fence(__ATOMIC_ACQUIRE, "agent");
            xb_add(&bar[XB_XGEN(b.x)], 1u);
            asm volatile("s_waitcnt vmcnt(0)" ::: "memory");
        } else {
            XB_SPIN(xb_ld(&bar[XB_XGEN(b.x)]) == gen, bar);
            __builtin_amdgcn_fence(__ATOMIC_ACQUIRE, "agent");
            asm volatile("s_waitcnt vmcnt(0)" ::: "memory");
        }
    }
    __syncthreads();
}

struct Args { const float* in[11]; float* out; unsigned char* ws; int ph_lo, ph_hi, coop, pad; };

__device__ __forceinline__ void transpose_item(const float* W, int K, int N, bf16_t* WT, LAS float* scr, int item, int lane) {
    const int nblk = N / 32, kb = item / nblk, nb = item % nblk, k0 = 64 * kb, n0 = 32 * nb;
#pragma unroll 8
    for (int i = 0; i < 32; ++i) { const int kk = 2 * i + (lane >> 5); scr[kk * 33 + (lane & 31)] = W[(size_t)(k0 + kk) * N + n0 + (lane & 31)]; }
    asm volatile("s_waitcnt lgkmcnt(0)" ::: "memory");
    const int c = lane & 7;
#pragma unroll
    for (int j = 0; j < 4; ++j) { const int n = (lane >> 3) + 8 * j; const LAS float* s = scr + (8 * c) * 33 + n;
        u32x4 o; o.x = cvt_pk_bf16(s[0 * 33], s[1 * 33]); o.y = cvt_pk_bf16(s[2 * 33], s[3 * 33]); o.z = cvt_pk_bf16(s[4 * 33], s[5 * 33]); o.w = cvt_pk_bf16(s[6 * 33], s[7 * 33]);
        *(u32x4*)(WT + (size_t)(n0 + n) * K + k0 + 8 * c) = o; }
    asm volatile("s_waitcnt lgkmcnt(0)" ::: "memory");
}
__device__ __forceinline__ void rms_row(const float* xrow, const float* gain, bf16_t* orow, int lane) {
    const f32x4* xr = (const f32x4*)xrow + lane; const f32x4* gr = (const f32x4*)gain + lane;
    f32x4 v[4]; float s = 0.f;
#pragma unroll
    for (int j = 0; j < 4; ++j) { v[j] = xr[64 * j]; s += (v[j].x * v[j].x + v[j].y * v[j].y) + (v[j].z * v[j].z + v[j].w * v[j].w); }
    const float rstd = 1.0f / sqrtf(wave_sum(s) * (1.f / D) + EPS);
    u32x2* o8 = (u32x2*)orow + lane;
#pragma unroll
    for (int j = 0; j < 4; ++j) { const f32x4 gg = gr[64 * j]; u32x2 w; w.x = cvt_pk_bf16(v[j].x * rstd * gg.x, v[j].y * rstd * gg.y); w.y = cvt_pk_bf16(v[j].z * rstd * gg.z, v[j].w * rstd * gg.w); o8[64 * j] = w; }
}
__device__ __forceinline__ void rope_entry(int idx, f32x2* tab) {
    const int pos = idx >> 6, i = idx & 63;
    const float inv = (float)exp2(-(double)(2 * i) * (13.287712379549449 / 128.0));
    const float angf = (float)pos * inv;
    const double a = (double)angf; const double q = rint(a * 0.6366197723675814); const double r = a - q * 1.5707963267948966;
    const double r2 = r * r;
    double sn = r * (1.0 - r2 / 6.0 * (1.0 - r2 / 20.0 * (1.0 - r2 / 42.0 * (1.0 - r2 / 72.0 * (1.0 - r2 / 110.0 * (1.0 - r2 / 156.0))))));
    double cs = 1.0 - r2 / 2.0 * (1.0 - r2 / 12.0 * (1.0 - r2 / 30.0 * (1.0 - r2 / 56.0 * (1.0 - r2 / 90.0 * (1.0 - r2 / 132.0)))));
    const int qi = ((int)q) & 3;
    double c2, s2;
    if (qi == 0) { c2 = cs; s2 = sn; } else if (qi == 1) { c2 = -sn; s2 = cs; } else if (qi == 2) { c2 = -cs; s2 = -sn; } else { c2 = sn; s2 = -cs; }
    tab[idx] = (f32x2){(float)c2, (float)s2};
}

__global__ void __launch_bounds__(NTHREADS, 2) mega_fwd(Args args) {
    extern __shared__ __attribute__((aligned(16))) unsigned char lds_raw[];
    LAS unsigned char* lds = (LAS unsigned char*)lds_raw;
    cg::grid_group grid = cg::this_grid();
    const int G = gridDim.x, bx = blockIdx.x;
    volatile LAS unsigned* bst = (volatile LAS unsigned*)(lds + LDS_BYTES - 16);
    if (threadIdx.x < 4) bst[threadIdx.x] = 0u;
    __syncthreads();
    XcdBarrier xbar; xbar.bar = (unsigned*)(args.ws + WS_BAR); xbar.x = 0; xbar.st = bst;
    if (args.coop) xbar = xcd_barrier_post((unsigned*)(args.ws + WS_BAR), bst);
    unsigned char* ws = args.ws;
#define XIN (args.in[0])
#define norm0 (args.in[1])
#define w_in0 (args.in[2])
#define w_pool0 (args.in[3])
#define pool_scale0 (args.in[4])
#define w_out0 (args.in[5])
#define norm1 (args.in[6])
#define w_in1 (args.in[7])
#define q_norm1 (args.in[8])
#define k_norm1 (args.in[9])
#define w_out1 (args.in[10])
    float* out = args.out;
#define WIN0 ((bf16_t*)(ws + WS_WIN0))
#define WP ((bf16_t*)(ws + WS_WP))
#define WOUT0 ((bf16_t*)(ws + WS_WOUT0))
#define WIN1 ((bf16_t*)(ws + WS_WIN1))
#define WOUT1 ((bf16_t*)(ws + WS_WOUT1))
#define H0 ((bf16_t*)(ws + WS_H0))
#define POOLED ((bf16_t*)(ws + WS_POOLED))
#define U ((bf16_t*)(ws + WS_U))
#define SZ0 ((bf16_t*)(ws + WS_SZ0))
#define H1 ((bf16_t*)(ws + WS_H1))
#define QG ((bf16_t*)(ws + WS_QG))
#define KG ((bf16_t*)(ws + WS_KG))
#define VG ((bf16_t*)(ws + WS_VG))
#define SZG ((bf16_t*)(ws + WS_SZG))
#define OPART ((bf16_t*)(ws + WS_OPART))
#define AT ((bf16_t*)(ws + WS_A))
#define KMEAN ((float*)(ws + WS_KMEAN))
#define SEL ((unsigned*)(ws + WS_SEL))
#define LPART ((float*)(ws + WS_LPART))
#define TAB ((f32x2*)(ws + WS_TAB))
#define LIST ((unsigned short*)(ws + WS_LIST))
#define CNT ((unsigned*)(ws + WS_CTL))
    const int lo = args.ph_lo, hi = args.ph_hi;
#define IN(k) (lo <= (k) && (k) < hi)
#define SYNC(k) do { if (IN(k) && IN((k) + 1) && args.coop) { if ((k) == 0) grid.sync(); else xcd_barrier(xbar); } } while (0)
    {
        if (IN(0) && (PH_MASK & 1)) {
            int tid = threadIdx.x; asm volatile("" : "+v"(tid)); const int lane = tid & 63, wave = __builtin_amdgcn_readfirstlane(tid >> 6); (void)lane; (void)wave;
            LAS float* scr = (LAS float*)(lds + wave * 16384);
            const int gw = bx * 8 + wave, NGW = G * 8;
            constexpr int I0 = (D / 64) * (2 * DI / 32), IP = (512 / 64) * (512 / 32), I1 = (DI / 64) * (D / 32), I2 = (D / 64) * (4 * DI / 32), I3 = I1;
            constexpr int NITEMS = I0 + 4 * IP + I1 + I2 + I3;
            for (int it = gw; it < NITEMS; it += NGW) {
                int r = it;
                if (r < I0) { transpose_item(w_in0, D, 2 * DI, WIN0, scr, r, lane); continue; } r -= I0;
                if (r < 4 * IP) { const int gp = r / IP; transpose_item(w_pool0 + (size_t)gp * 512 * 512, 512, 512, WP + (size_t)gp * 512 * 512, scr, r - gp * IP, lane); continue; } r -= 4 * IP;
                if (r < I1) { transpose_item(w_out0, DI, D, WOUT0, scr, r, lane); continue; } r -= I1;
                if (r < I2) { transpose_item(w_in1, D, 4 * DI, WIN1, scr, r, lane); continue; } r -= I2;
                transpose_item(w_out1, DI, D, WOUT1, scr, r, lane);
            }
            for (int idx = bx * NTHREADS + tid; idx < SEQ * 64; idx += G * NTHREADS) rope_entry(idx, TAB);
            for (int m = gw; m < M; m += NGW) rms_row(XIN + (size_t)m * D, norm0, H0 + (size_t)m * D, lane);
        }
        SYNC(0);
        if (IN(1) && (PH_MASK & 2)) {
            int tid = threadIdx.x; asm volatile("" : "+v"(tid)); const int lane = tid & 63, wave = __builtin_amdgcn_readfirstlane(tid >> 6); (void)lane; (void)wave;
            pg8::Gemm<D, D, D> g{H0, WIN0}; pg8::StaticOrder S; S.init(M, 2 * DI, G, bx);
            pg8::EpiSplit<DI, 8, 1> E{U, SZ0, U, U}; pg8::MapPlain<D, D> MP;
            pg8::gemm_phase(lds, g, S, MP, E);
        }
        SYNC(1);
        if (IN(2) && (PH_MASK & 4)) {
            int tid = threadIdx.x; asm volatile("" : "+v"(tid)); const int lane = tid & 63, wave = __builtin_amdgcn_readfirstlane(tid >> 6); (void)lane; (void)wave;
            const int cgp = tid & 255, hh = tid >> 8, col = cgp * 8, w = 2 << (cgp >> 6);
            for (int unit = bx; unit < M / 64; unit += G) {
                const int r0 = unit * 64 + hh * 32, p0 = r0 & (SEQ - 1);
                float sum[8];
#pragma unroll
                for (int e = 0; e < 8; ++e) sum[e] = 0.f;
                for (int i = 1; i < w; ++i) { if (p0 - i >= 0) { const u32x4 v = *(const u32x4*)(U + (size_t)(r0 - i) * DI + col);
                    sum[0] += bf_lo(v.x); sum[1] += bf_hi(v.x); sum[2] += bf_lo(v.y); sum[3] += bf_hi(v.y); sum[4] += bf_lo(v.z); sum[5] += bf_hi(v.z); sum[6] += bf_lo(v.w); sum[7] += bf_hi(v.w); } }
                for (int t = 0; t < 32; ++t) {
                    const int p = p0 + t; const u32x4 v = *(const u32x4*)(U + (size_t)(r0 + t) * DI + col);
                    float c[8] = {bf_lo(v.x), bf_hi(v.x), bf_lo(v.y), bf_hi(v.y), bf_lo(v.z), bf_hi(v.z), bf_lo(v.w), bf_hi(v.w)};
                    const float rc = 1.0f / (float)((p + 1) < w ? (p + 1) : w);
                    float o[8];
#pragma unroll
                    for (int e = 0; e < 8; ++e) { sum[e] += c[e]; o[e] = sum[e] * rc - c[e]; }
                    u32x4 wv; wv.x = cvt_pk_bf16(o[0], o[1]); wv.y = cvt_pk_bf16(o[2], o[3]); wv.z = cvt_pk_bf16(o[4], o[5]); wv.w = cvt_pk_bf16(o[6], o[7]);
                    *(u32x4*)(POOLED + (size_t)(r0 + t) * DI + col) = wv;
                    if (p - w + 1 >= 0) { const u32x4 q = *(const u32x4*)(U + (size_t)(r0 + t - w + 1) * DI + col);
                        sum[0] -= bf_lo(q.x); sum[1] -= bf_hi(q.x); sum[2] -= bf_lo(q.y); sum[3] -= bf_hi(q.y); sum[4] -= bf_lo(q.z); sum[5] -= bf_hi(q.z); sum[6] -= bf_lo(q.w); sum[7] -= bf_hi(q.w); }
                }
            }
        }
        SYNC(2);
        if (IN(3) && (PH_MASK & 8)) {
            int tid = threadIdx.x; asm volatile("" : "+v"(tid)); const int lane = tid & 63, wave = __builtin_amdgcn_readfirstlane(tid >> 6); (void)lane; (void)wave;
            pg8::Gemm<DI, 512, 512> g{POOLED, WP}; pg8::StaticOrder S; S.init(M, DI, G, bx);
            pg8::EpiGate E{U, SZ0, pool_scale0}; pg8::MapPool MP;
            pg8::gemm_phase(lds, g, S, MP, E);
        }
        SYNC(3);
        if (IN(4) && (PH_MASK & 16)) {
            int tid = threadIdx.x; asm volatile("" : "+v"(tid)); const int lane = tid & 63, wave = __builtin_amdgcn_readfirstlane(tid >> 6); (void)lane; (void)wave;
            pg8::Gemm<DI, DI, DI> g{U, WOUT0}; pg8::StaticOrder S; S.init(M, D, G, bx);
            pg8::EpiRes E{XIN, out}; pg8::MapPlain<DI, DI> MP;
            pg8::gemm_phase(lds, g, S, MP, E);
        }
        SYNC(4);
        if (IN(5) && (PH_MASK & 32)) {
            int tid = threadIdx.x; asm volatile("" : "+v"(tid)); const int lane = tid & 63, wave = __builtin_amdgcn_readfirstlane(tid >> 6); (void)lane; (void)wave;
            const int gw = bx * 8 + wave, NGW = G * 8;
            for (int m = gw; m < M; m += NGW) rms_row(out + (size_t)m * D, norm1, H1 + (size_t)m * D, lane);
        }
        SYNC(5);
#pragma unroll
        for (int g = 0; g < NG; ++g) {
            const int pb = 6 + 5 * g;
            if (IN(pb) && (PH_MASK & 64)) {
            int tid = threadIdx.x; asm volatile("" : "+v"(tid)); const int lane = tid & 63, wave = __builtin_amdgcn_readfirstlane(tid >> 6); (void)lane; (void)wave;
                pg8::Gemm<D, D, D> gm{H1, WIN1}; pg8::StaticOrder S; S.init(M, 4 * GW, G, bx);
                pg8::EpiSplit<GW, 2, 3> E{QG, KG, VG, SZG}; pg8::MapQkvz MP{g};
                pg8::gemm_phase(lds, gm, S, MP, E);
            }
            SYNC(pb);
            if (IN(pb + 1) && (PH_MASK & 128)) {
            int tid = threadIdx.x; asm volatile("" : "+v"(tid)); const int lane = tid & 63, wave = __builtin_amdgcn_readfirstlane(tid >> 6); (void)lane; (void)wave;
                LAS float* wsum = (LAS float*)lds;
                const int j8 = (lane & 7) * 8, rsub = lane >> 3;
                f32x4 gq[4], gk[4];
                gq[0] = *(const f32x4*)(q_norm1 + j8); gq[1] = *(const f32x4*)(q_norm1 + j8 + 4); gq[2] = *(const f32x4*)(q_norm1 + 64 + j8); gq[3] = *(const f32x4*)(q_norm1 + 68 + j8);
                gk[0] = *(const f32x4*)(k_norm1 + j8); gk[1] = *(const f32x4*)(k_norm1 + j8 + 4); gk[2] = *(const f32x4*)(k_norm1 + 64 + j8); gk[3] = *(const f32x4*)(k_norm1 + 68 + j8);
#pragma unroll 1
                for (int unit = bx; unit < 8 * NB; unit += G) {
                    const int bh = unit >> 5, n = unit & 31, b = bh >> 2, hl = bh & 3;
                    float ks[16];
#pragma unroll
                    for (int e = 0; e < 16; ++e) ks[e] = 0.f;
#pragma unroll 1
                    for (int hb = 0; hb < 2; ++hb) {
                    u32x4 ka[2], kc[2], qa[2], qc[2]; f32x4 tb[2][4];
#pragma unroll
                    for (int it = 0; it < 2; ++it) {
                        const int pos = n * BLK + wave * 32 + (hb * 2 + it) * 8 + rsub;
                        const size_t off = (size_t)(b * SEQ + pos) * GW + hl * HD + j8;
                        ka[it] = *(const u32x4*)(KG + off); kc[it] = *(const u32x4*)(KG + off + 64);
                        qa[it] = *(const u32x4*)(QG + off); qc[it] = *(const u32x4*)(QG + off + 64);
                        const f32x4* tp = (const f32x4*)(TAB + pos * 64 + j8);
                        tb[it][0] = tp[0]; tb[it][1] = tp[1]; tb[it][2] = tp[2]; tb[it][3] = tp[3];
                    }
#pragma unroll
                    for (int it = 0; it < 2; ++it) {
                        const int pos = n * BLK + wave * 32 + (hb * 2 + it) * 8 + rsub;
                        const size_t off = (size_t)(b * SEQ + pos) * GW + hl * HD + j8;
                        float cs[8], sn[8];
#pragma unroll
                        for (int e = 0; e < 4; ++e) { cs[2 * e] = tb[it][e].x; sn[2 * e] = tb[it][e].y; cs[2 * e + 1] = tb[it][e].z; sn[2 * e + 1] = tb[it][e].w; }
#pragma unroll
                        for (int which = 0; which < 2; ++which) {
                            const u32x4 va = which == 0 ? ka[it] : qa[it], vc = which == 0 ? kc[it] : qc[it];
                            float x1[8] = {bf_lo(va.x), bf_hi(va.x), bf_lo(va.y), bf_hi(va.y), bf_lo(va.z), bf_hi(va.z), bf_lo(va.w), bf_hi(va.w)};
                            float x2[8] = {bf_lo(vc.x), bf_hi(vc.x), bf_lo(vc.y), bf_hi(vc.y), bf_lo(vc.z), bf_hi(vc.z), bf_lo(vc.w), bf_hi(vc.w)};
                            float ss = 0.f;
#pragma unroll
                            for (int e = 0; e < 8; ++e) ss += x1[e] * x1[e] + x2[e] * x2[e];
                            ss += __shfl_xor(ss, 1); ss += __shfl_xor(ss, 2); ss += __shfl_xor(ss, 4);
                            const float rstd = (which == 0 ? 1.0f : QSCALE) / sqrtf(ss * (1.f / HD) + EPS);
                            float o1[8], o2[8];
#pragma unroll
                            for (int e = 0; e < 8; ++e) {
                                const float g1 = which == 0 ? gk[e >> 2][e & 3] : gq[e >> 2][e & 3], g2 = which == 0 ? gk[2 + (e >> 2)][e & 3] : gq[2 + (e >> 2)][e & 3];
                                const float y1 = x1[e] * rstd * g1, y2 = x2[e] * rstd * g2;
                                o1[e] = y1 * cs[e] - y2 * sn[e]; o2[e] = y2 * cs[e] + y1 * sn[e];
                                if (which == 0) { ks[e] += o1[e]; ks[8 + e] += o2[e]; }
                            }
                            u32x4 w1, w2;
                            w1.x = cvt_pk_bf16(o1[0], o1[1]); w1.y = cvt_pk_bf16(o1[2], o1[3]); w1.z = cvt_pk_bf16(o1[4], o1[5]); w1.w = cvt_pk_bf16(o1[6], o1[7]);
                            w2.x = cvt_pk_bf16(o2[0], o2[1]); w2.y = cvt_pk_bf16(o2[2], o2[3]); w2.z = cvt_pk_bf16(o2[4], o2[5]); w2.w = cvt_pk_bf16(o2[6], o2[7]);
                            bf16_t* dstp = which == 0 ? KG : QG;
                            *(u32x4*)(dstp + off) = w1; *(u32x4*)(dstp + off + 64) = w2;
                        }
                    }
                    }
#pragma unroll
                    for (int e = 0; e < 16; ++e) { float v = ks[e]; v += __shfl_xor(v, 8); v += __shfl_xor(v, 16); v += __shfl_xor(v, 32); ks[e] = v; }
                    if (lane < 8) {
#pragma unroll
                        for (int e = 0; e < 8; ++e) { wsum[wave * 128 + j8 + e] = ks[e]; wsum[wave * 128 + 64 + j8 + e] = ks[8 + e]; }
                    }
                    __syncthreads();
                    if (tid < 128) { float sv = 0.f;
#pragma unroll
                        for (int w8 = 0; w8 < 8; ++w8) sv += wsum[w8 * 128 + tid];
                        KMEAN[((size_t)(g * 8 + bh) * NB + n) * HD + tid] = sv * (1.f / BLK); }
                    __syncthreads();
                }
            }
            SYNC(pb + 1);
            if (IN(pb + 2) && (PH_MASK & 256)) {
            int tid = threadIdx.x; asm volatile("" : "+v"(tid)); const int lane = tid & 63, wave = __builtin_amdgcn_readfirstlane(tid >> 6); (void)lane; (void)wave;
                LAS float* km = (LAS float*)lds;
                LAS float* mv = (LAS float*)(lds + 16384);
                LAS int* mi = (LAS int*)(lds + 16384 + 3072);
                LAS unsigned* lcnt = (LAS unsigned*)(lds + 16384 + 6144);
                LAS unsigned* lbase = lcnt + 32;
                if (tid < 32) lcnt[tid] = 0u;
                __syncthreads();
#pragma unroll 1
                for (int unit = bx; unit < 8 * NB; unit += G) {
                    const int bh = unit >> 5, qb = unit & 31, b = bh >> 2, hl = bh & 3;
                    const int qi = tid & 255, hf = tid >> 8;
                    const int s = qb * BLK + qi; const size_t mrow = (size_t)b * SEQ + s;
                    if (qb > 0) {
                        u32x4 qv[16];
#pragma unroll
                        for (int c = 0; c < 16; ++c) qv[c] = *(const u32x4*)(QG + mrow * GW + hl * HD + c * 8);
                        for (int c = tid; c < qb * 32; c += NTHREADS) *(LAS f32x4*)(km + c * 4) = *(const f32x4*)(KMEAN + (size_t)(g * 8 + bh) * NB * HD + c * 4);
                        __syncthreads();
                        float v0 = -INFINITY, v1 = -INFINITY, v2 = -INFINITY; int i0 = 255, i1 = 255, i2 = 255;
#pragma unroll 1
                        for (int n = hf; n < qb; n += 2) {
                            float acc = 0.f;
#pragma unroll
                            for (int c = 0; c < 16; ++c) { const f32x4 ka = *(const LAS f32x4*)(km + n * 128 + c * 8), kb = *(const LAS f32x4*)(km + n * 128 + c * 8 + 4);
                                acc += bf_lo(qv[c].x) * ka.x + bf_hi(qv[c].x) * ka.y + bf_lo(qv[c].y) * ka.z + bf_hi(qv[c].y) * ka.w + bf_lo(qv[c].z) * kb.x + bf_hi(qv[c].z) * kb.y + bf_lo(qv[c].w) * kb.z + bf_hi(qv[c].w) * kb.w; }
                            if (acc > v0) { v2 = v1; i2 = i1; v1 = v0; i1 = i0; v0 = acc; i0 = n; }
                            else if (acc > v1) { v2 = v1; i2 = i1; v1 = acc; i1 = n; }
                            else if (acc > v2) { v2 = acc; i2 = n; }
                        }
                        if (hf == 1) { mv[qi * 3] = v0; mv[qi * 3 + 1] = v1; mv[qi * 3 + 2] = v2; mi[qi * 3] = i0; mi[qi * 3 + 1] = i1; mi[qi * 3 + 2] = i2; }
                        __syncthreads();
                        unsigned rk0 = 0, rk1 = 0, rk2 = 0;
                        if (hf == 0) {
#pragma unroll
                            for (int e = 0; e < 3; ++e) { const float acc = mv[qi * 3 + e]; const int n = mi[qi * 3 + e];
                                if (n < 255) {
                                    const bool g0 = acc > v0 || (acc == v0 && n < i0), g1 = acc > v1 || (acc == v1 && n < i1), g2 = acc > v2 || (acc == v2 && n < i2);
                                    if (g0) { v2 = v1; i2 = i1; v1 = v0; i1 = i0; v0 = acc; i0 = n; }
                                    else if (g1) { v2 = v1; i2 = i1; v1 = acc; i1 = n; }
                                    else if (g2) { v2 = acc; i2 = n; }
                                } }
                            SEL[mrow * NH + g * HG + hl] = (unsigned)i0 | ((unsigned)i1 << 8) | ((unsigned)i2 << 16);
                            if (i0 < 255) rk0 = atomicAdd((unsigned*)&lcnt[i0], 1u);
                            if (i1 < 255) rk1 = atomicAdd((unsigned*)&lcnt[i1], 1u);
                            if (i2 < 255) rk2 = atomicAdd((unsigned*)&lcnt[i2], 1u);
                        }
                        __syncthreads();
                        if (tid < 32) { const unsigned c = lcnt[tid]; lbase[tid] = c ? atomicAdd(&CNT[g * 256 + bh * NB + tid], c) : 0u; lcnt[tid] = 0u; }
                        __syncthreads();
                        if (hf == 0) {
                            if (i0 < 255) LIST[(size_t)(bh * NB + i0) * SEQ + lbase[i0] + rk0] = (unsigned short)(s | (0 << 13));
                            if (i1 < 255) LIST[(size_t)(bh * NB + i1) * SEQ + lbase[i1] + rk1] = (unsigned short)(s | (1 << 13));
                            if (i2 < 255) LIST[(size_t)(bh * NB + i2) * SEQ + lbase[i2] + rk2] = (unsigned short)(s | (2 << 13));
                        }
                        __syncthreads();
                    } else if (hf == 0) {
                        SEL[mrow * NH + g * HG + hl] = 0x00ffffffu;
                    }
                }
            }
            SYNC(pb + 2);
            if (IN(pb + 3) && (PH_MASK & 512)) {
            int tid = threadIdx.x; asm volatile("" : "+v"(tid)); const int lane = tid & 63, wave = __builtin_amdgcn_readfirstlane(tid >> 6); (void)lane; (void)wave;
                LAS unsigned char* Ks = lds;
                LAS unsigned char* Vt = lds + 256 * 272;
                LAS int* pre = (LAS int*)(lds + 256 * 272 + 128 * 528);
                LAS float* red = (LAS float*)(lds + 256 * 272 + 128 * 528 + 2048);
                {
                    float mq = 0.f, mk = 0.f;
                    if (tid < 128) { mq = fabsf(q_norm1[tid]); mk = fabsf(k_norm1[tid]); }
#pragma unroll
                    for (int o = 1; o < 64; o <<= 1) { mq = fmaxf(mq, __shfl_xor(mq, o)); mk = fmaxf(mk, __shfl_xor(mk, o)); }
                    if (lane == 0) { red[wave * 2] = mq; red[wave * 2 + 1] = mk; }
                    if (tid < 256) pre[tid + 1] = 1 + (int)((CNT[g * 256 + tid] + 255u) >> 8);
                    if (tid == 0) pre[0] = 0;
                    __syncthreads();
                    if (tid == 0) { int a = 0; for (int i = 1; i <= 256; ++i) { a += pre[i]; pre[i] = a; } }
                    __syncthreads();
                }
                const float MSH = 128.0f * QSCALE * fmaxf(red[0], red[2]) * fmaxf(red[1], red[3]) * 1.02f;
                const int total = pre[256];
                const int fr = lane & 15, fq = lane >> 4;
#pragma unroll 1
                for (int item = bx; item < total; item += G) {
                    int loi = 0, hii = 256;
                    while (hii - loi > 1) { const int mid = (loi + hii) >> 1; if (pre[mid] <= item) loi = mid; else hii = mid; }
                    const int li = loi, c = item - pre[li], bh = li >> 5, n = li & 31, b = bh >> 2, hl = bh & 3;
                    const int cnt = (int)CNT[g * 256 + li];
                    const size_t rowbase = (size_t)b * SEQ;
                    __syncthreads();
                    for (int cc = tid; cc < 256 * 16; cc += NTHREADS) { const int r = cc >> 4, c16 = cc & 15;
                        *(LAS u32x4*)(Ks + r * 272 + c16 * 16) = *(const u32x4*)(KG + (rowbase + n * BLK + r) * GW + hl * HD + c16 * 8); }
                    for (int task = tid; task < 1024; task += NTHREADS) {
                        const int a = (task & 15) | ((task >> 5) & 3) << 4, cch = ((task >> 4) & 1) | ((task >> 7) << 1);
                        u32x4 v[4];
#pragma unroll
                        for (int kk = 0; kk < 4; ++kk) v[kk] = *(const u32x4*)(VG + (rowbase + n * BLK + a * 4 + kk) * GW + hl * HD + cch * 8);
#pragma unroll
                        for (int e = 0; e < 4; ++e) {
                            const unsigned w0 = e == 0 ? v[0].x : e == 1 ? v[0].y : e == 2 ? v[0].z : v[0].w, w1 = e == 0 ? v[1].x : e == 1 ? v[1].y : e == 2 ? v[1].z : v[1].w;
                            const unsigned w2 = e == 0 ? v[2].x : e == 1 ? v[2].y : e == 2 ? v[2].z : v[2].w, w3 = e == 0 ? v[3].x : e == 1 ? v[3].y : e == 2 ? v[3].z : v[3].w;
                            u32x2 lo2, hi2;
                            lo2.x = (w0 & 0xffffu) | (w1 << 16); lo2.y = (w2 & 0xffffu) | (w3 << 16);
                            hi2.x = (w0 >> 16) | (w1 & 0xffff0000u); hi2.y = (w2 >> 16) | (w3 & 0xffff0000u);
                            *(LAS u32x2*)(Vt + (cch * 8 + 2 * e) * 528 + a * 8) = lo2;
                            *(LAS u32x2*)(Vt + (cch * 8 + 2 * e + 1) * 528 + a * 8) = hi2;
                        }
                    }
                    int qpos[2], qslot[2]; bool qok[2];
                    bf16x8 qf[2][4];
#pragma unroll
                    for (int t = 0; t < 2; ++t) {
                        const int ridx = wave * 32 + t * 16 + fr;
                        if (c == 0) { qpos[t] = n * BLK + ridx; qslot[t] = 3; qok[t] = true; }
                        else { const int lidx = (c - 1) * 256 + ridx; qok[t] = lidx < cnt; const unsigned e = LIST[(size_t)li * SEQ + (qok[t] ? lidx : 0)]; qpos[t] = e & 8191; qslot[t] = e >> 13; }
                        const bf16_t* qp = QG + (rowbase + qpos[t]) * GW + hl * HD + fq * 8;
#pragma unroll
                        for (int ks = 0; ks < 4; ++ks) qf[t][ks] = *(const bf16x8*)(qp + ks * 32);
                    }
                    __syncthreads();
                    f32x4 oacc[2][8]; float lsum[2] = {0.f, 0.f};
#pragma unroll
                    for (int t = 0; t < 2; ++t)
#pragma unroll
                        for (int dt = 0; dt < 8; ++dt) oacc[t][dt] = (f32x4){0.f, 0.f, 0.f, 0.f};
                    const int qrel0 = qpos[0] - n * BLK, qrel1 = qpos[1] - n * BLK;
#pragma unroll 1
                    for (int kg = 0; kg < 8; ++kg) {
                        f32x4 sacc[2][2];
#pragma unroll
                        for (int kt = 0; kt < 2; ++kt) { sacc[kt][0] = (f32x4){0.f, 0.f, 0.f, 0.f}; sacc[kt][1] = (f32x4){0.f, 0.f, 0.f, 0.f};
#pragma unroll
                            for (int ks = 0; ks < 4; ++ks) { const bf16x8 kf = *(const LAS bf16x8*)(Ks + (kg * 32 + kt * 16 + fr) * 272 + ks * 64 + fq * 16);
                                sacc[kt][0] = __builtin_amdgcn_mfma_f32_16x16x32_bf16(kf, qf[0][ks], sacc[kt][0], 0, 0, 0);
                                sacc[kt][1] = __builtin_amdgcn_mfma_f32_16x16x32_bf16(kf, qf[1][ks], sacc[kt][1], 0, 0, 0); } }
                        bf16x8 pb[2];
#pragma unroll
                        for (int t = 0; t < 2; ++t) {
                            float p[8];
#pragma unroll
                            for (int kt = 0; kt < 2; ++kt)
#pragma unroll
                                for (int j = 0; j < 4; ++j) { float pv = __builtin_amdgcn_exp2f(sacc[kt][t][j] - MSH);
                                    if (c == 0) { const int key = kg * 32 + kt * 16 + fq * 4 + j; if (key > (t == 0 ? qrel0 : qrel1)) pv = 0.f; }
                                    p[kt * 4 + j] = pv; lsum[t] += pv; }
                            u32x4 w; w.x = cvt_pk_bf16(p[0], p[1]); w.y = cvt_pk_bf16(p[2], p[3]); w.z = cvt_pk_bf16(p[4], p[5]); w.w = cvt_pk_bf16(p[6], p[7]);
                            pb[t] = __builtin_bit_cast(bf16x8, w);
                        }
#pragma unroll
                        for (int dt = 0; dt < 8; ++dt) {
                            const u32x2 va = *(const LAS u32x2*)(Vt + (dt * 16 + fr) * 528 + kg * 64 + fq * 8), vb = *(const LAS u32x2*)(Vt + (dt * 16 + fr) * 528 + kg * 64 + 32 + fq * 8);
                            u32x4 vv; vv.x = va.x; vv.y = va.y; vv.z = vb.x; vv.w = vb.y; const bf16x8 vf = __builtin_bit_cast(bf16x8, vv);
                            oacc[0][dt] = __builtin_amdgcn_mfma_f32_16x16x32_bf16(vf, pb[0], oacc[0][dt], 0, 0, 0);
                            oacc[1][dt] = __builtin_amdgcn_mfma_f32_16x16x32_bf16(vf, pb[1], oacc[1][dt], 0, 0, 0);
                        }
                    }
#pragma unroll
                    for (int t = 0; t < 2; ++t) {
                        float l = lsum[t]; l += __shfl_xor(l, 16); l += __shfl_xor(l, 32);
                        if (qok[t]) {
                            const size_t pair = (rowbase + qpos[t]) * HG + hl;
                            bf16_t* op = OPART + (pair * 4 + qslot[t]) * HD + fq * 4;
#pragma unroll
                            for (int dt = 0; dt < 8; ++dt) { u32x2 w; w.x = cvt_pk_bf16(oacc[t][dt][0], oacc[t][dt][1]); w.y = cvt_pk_bf16(oacc[t][dt][2], oacc[t][dt][3]); *(u32x2*)(op + dt * 16) = w; }
                            if (fq == 0) LPART[pair * 4 + qslot[t]] = l;
                        }
                    }
                }
            }
            SYNC(pb + 3);
            if (IN(pb + 4) && (PH_MASK & 1024)) {
            int tid = threadIdx.x; asm volatile("" : "+v"(tid)); const int lane = tid & 63, wave = __builtin_amdgcn_readfirstlane(tid >> 6); (void)lane; (void)wave;
                for (int idx = bx * NTHREADS + tid; idx < M * HG * 16; idx += G * NTHREADS) {
                    const int pair = idx >> 4, ch = idx & 15, m = pair >> 2, hl = pair & 3;
                    const unsigned sel = SEL[(size_t)m * NH + g * HG + hl];
                    float o[8]; float l = LPART[(size_t)pair * 4 + 3];
                    { const u32x4 v = *(const u32x4*)(OPART + ((size_t)pair * 4 + 3) * HD + ch * 8);
                      o[0] = bf_lo(v.x); o[1] = bf_hi(v.x); o[2] = bf_lo(v.y); o[3] = bf_hi(v.y); o[4] = bf_lo(v.z); o[5] = bf_hi(v.z); o[6] = bf_lo(v.w); o[7] = bf_hi(v.w); }
#pragma unroll
                    for (int e = 0; e < 3; ++e) if (((sel >> (8 * e)) & 0xffu) != 0xffu) {
                        const u32x4 v = *(const u32x4*)(OPART + ((size_t)pair * 4 + e) * HD + ch * 8); l += LPART[(size_t)pair * 4 + e];
                        o[0] += bf_lo(v.x); o[1] += bf_hi(v.x); o[2] += bf_lo(v.y); o[3] += bf_hi(v.y); o[4] += bf_lo(v.z); o[5] += bf_hi(v.z); o[6] += bf_lo(v.w); o[7] += bf_hi(v.w); }
                    const float rl = 1.0f / l;
                    const u32x4 z = *(const u32x4*)(SZG + (size_t)m * GW + hl * HD + ch * 8);
                    u32x4 w; w.x = cvt_pk_bf16(o[0] * rl * bf_lo(z.x), o[1] * rl * bf_hi(z.x)); w.y = cvt_pk_bf16(o[2] * rl * bf_lo(z.y), o[3] * rl * bf_hi(z.y));
                    w.z = cvt_pk_bf16(o[4] * rl * bf_lo(z.z), o[5] * rl * bf_hi(z.z)); w.w = cvt_pk_bf16(o[6] * rl * bf_lo(z.w), o[7] * rl * bf_hi(z.w));
                    *(u32x4*)(AT + (size_t)m * DI + g * GW + hl * HD + ch * 8) = w;
                }
            }
            SYNC(pb + 4);
        }
        if (IN(6 + 5 * NG) && (PH_MASK & 2048)) {
            int tid = threadIdx.x; asm volatile("" : "+v"(tid)); const int lane = tid & 63, wave = __builtin_amdgcn_readfirstlane(tid >> 6); (void)lane; (void)wave;
            pg8::Gemm<DI, DI, DI> gm{AT, WOUT1}; pg8::StaticOrder S; S.init(M, D, G, bx);
            pg8::EpiRes E{out, out}; pg8::MapPlain<DI, DI> MP;
            pg8::gemm_phase(lds, gm, S, MP, E);
        }
    }
}

constexpr int NPHASES = 6 + 5 * NG + 1;

extern "C" void kernel_launch(void* const* d_in, const int* in_sizes, int n_in, void* d_out, int out_size, void* d_ws, size_t ws_size, hipStream_t stream) {
    static int grid = 0;
    if (grid == 0) {
        int dev = 0, cus = 0, per_cu = 0;
        hipGetDevice(&dev);
        hipDeviceGetAttribute(&cus, hipDeviceAttributeMultiprocessorCount, dev);
        hipFuncSetAttribute((const void*)mega_fwd, hipFuncAttributeMaxDynamicSharedMemorySize, LDS_BYTES);
        hipOccupancyMaxActiveBlocksPerMultiprocessor(&per_cu, (const void*)mega_fwd, NTHREADS, LDS_BYTES);
        if (per_cu < 1) { fprintf(stderr, "kernel_launch: occupancy query says %d blocks per CU\n", per_cu); per_cu = 1; }
        grid = cus;
        if (ws_size < WS_END) fprintf(stderr, "kernel_launch: workspace too small: %zu < %zu\n", ws_size, (size_t)WS_END);
    }
    hipMemsetAsync((char*)d_ws + WS_CTL, 0, CTL_BYTES, stream);
    Args a{};
    for (int i = 0; i < 11; ++i) a.in[i] = (const float*)d_in[i];
    a.out = (float*)d_out; a.ws = (unsigned char*)d_ws; a.pad = 0;
#if defined(MK_PER_PHASE)
    for (int ph = 0; ph < NPHASES; ++ph) { a.ph_lo = ph; a.ph_hi = ph + 1; a.coop = 0; hipLaunchKernelGGL(mega_fwd, dim3(grid), dim3(NTHREADS), LDS_BYTES, stream, a); }
#else
    a.ph_lo = 0; a.ph_hi = NPHASES; a.coop = 1;
    void* kargs[] = {&a};
    hipError_t e = hipLaunchCooperativeKernel((const void*)mega_fwd, dim3(grid), dim3(NTHREADS), kargs, LDS_BYTES, stream);
    if (e != hipSuccess) fprintf(stderr, "cooperative launch failed: %s (grid %d)\n", hipGetErrorString(e), grid);
#endif
}
```

```cpp
#include <hip/hip_runtime.h>
#include <hip/hip_cooperative_groups.h>
#include <cstdio>
#include <cstdint>
namespace cg = cooperative_groups;

#define LAS __attribute__((address_space(3)))
typedef unsigned short bf16_t;
typedef short bf16x8 __attribute__((ext_vector_type(8)));
typedef float f32x4 __attribute__((ext_vector_type(4)));
typedef float f32x2 __attribute__((ext_vector_type(2)));
typedef unsigned u32x4 __attribute__((ext_vector_type(4)));
typedef unsigned u32x2 __attribute__((ext_vector_type(2)));

constexpr int SEQ = 8192, NBATCH = 2, M = NBATCH * SEQ, D = 1024, DI = 2048, NH = 16, HD = 128, BLK = 256, NB = SEQ / BLK;
constexpr int NG = 4, HG = NH / NG, GW = HG * HD;
constexpr float EPS = 1e-6f;
constexpr float QSCALE = 0.08838834764831845f * 1.4426950408889634f;

constexpr size_t MiB = 1u << 20;
constexpr size_t WS_CTL = 0, CTL_BYTES = 65536;
constexpr size_t WS_BAR = 8192;
constexpr size_t WS_KMEAN = 1 * MiB;
constexpr size_t WS_SEL = 2 * MiB;
constexpr size_t WS_LPART = 3 * MiB;
constexpr size_t WS_TAB = 4 * MiB;
constexpr size_t WS_WIN1 = 8 * MiB, WS_WOUT1 = 24 * MiB;
constexpr size_t WS_LIST = 28 * MiB;
constexpr size_t WS_WIN0 = 28 * MiB, WS_WP = 36 * MiB, WS_WOUT0 = 38 * MiB;
constexpr size_t WS_H0 = 42 * MiB, WS_POOLED = 42 * MiB, WS_U = 106 * MiB, WS_SZ0 = 170 * MiB;
constexpr size_t WS_H1 = 32 * MiB, WS_QG = 64 * MiB, WS_KG = 80 * MiB, WS_VG = 96 * MiB, WS_SZG = 112 * MiB;
constexpr size_t WS_OPART = 128 * MiB, WS_A = 192 * MiB, WS_END = 256 * MiB;

constexpr int LDS_BYTES = 140 * 1024;
constexpr int NTHREADS = 512;
#ifndef PH_MASK
#define PH_MASK 0xfff
#endif

__device__ __forceinline__ unsigned cvt_pk_bf16(float lo, float hi) { unsigned r; asm volatile("v_cvt_pk_bf16_f32 %0, %1, %2" : "=v"(r) : "v"(lo), "v"(hi)); return r; }
__device__ __forceinline__ float bf_lo(unsigned u) { return __uint_as_float(u << 16); }
__device__ __forceinline__ float bf_hi(unsigned u) { return __uint_as_float(u & 0xffff0000u); }
__device__ __forceinline__ float silu_f(float z) { return z * __builtin_amdgcn_rcpf(1.0f + __builtin_amdgcn_exp2f(-1.4426950408889634f * z)); }
__device__ __forceinline__ float wave_sum(float v) {
#pragma unroll
    for (int o = 1; o < 64; o <<= 1) v += __shfl_xor(v, o);
    return v;
}

namespace pg8 {
constexpr int BM = 256, BK = 64, HALF = 128, HTB = HALF * BK * 2, STAGE_BYTES = 8 * HTB, NXCD = 8, WGM = 8;
__host__ __device__ __forceinline__ int lds_byte(int r, int c) { const int st = (r >> 4) * 2 + (c >> 5), rr = r & 15, cc = c & 31, ob = rr * 64 + cc * 2; return st * 1024 + (ob ^ (((ob >> 9) & 1) << 5)); }
__host__ __device__ __forceinline__ void stage_rc(int b, int& R, int& C) { const int st = b / 1024, sb = b % 1024, swz = sb ^ (((sb >> 9) & 1) << 5); R = (st >> 1) * 16 + swz / 64; C = (st & 1) * 32 + (swz % 64) / 2; }
__host__ __device__ __forceinline__ int perm32(int rho) { const int n = rho >> 4, i = rho & 15; return 8 * (i >> 2) + 4 * n + (i & 3); }

struct Unit { int pm, pn; };
template <int LDA_, int LDB_, int K_> struct Gemm { const bf16_t* A; const bf16_t* Bt; static constexpr int lda = LDA_, ldb = LDB_, K = K_; };
struct StaticOrder {
    int nM, nN, nwg, G, c;
    __device__ void init(int M_, int N_, int G_, int c_) { nM = M_ / BM; nN = N_ / BM; nwg = nM * nN; G = G_; c = c_; }
    __device__ bool next(int i, Unit& u) const {
        const long L = (long)i * G + c; if (L >= nwg) return false;
        int wgid = (int)L; { const int q = nwg / NXCD, r = nwg % NXCD, xcd = wgid % NXCD, off = wgid / NXCD; wgid = (xcd < r ? xcd * (q + 1) : r * (q + 1) + (xcd - r) * q) + off; }
        const int nig = WGM * nN, gid = wgid / nig, fm = gid * WGM, gsz = (nM - fm) < WGM ? (nM - fm) : WGM;
        u.pm = fm + ((wgid % nig) % gsz); u.pn = (wgid % nig) / gsz; return true;
    }
};
template <class Epi, class Map, class GemmT>
__device__ __forceinline__ void gemm_phase(LAS unsigned char* lds, const GemmT g, const StaticOrder& S, const Map& MP, const Epi& E) {
    int tid_ = threadIdx.x; asm volatile("" : "+v"(tid_));
    const int tid = tid_, wid = __builtin_amdgcn_readfirstlane(tid >> 6), lane = tid & 63, wr = wid >> 2, wc = wid & 3, fr = lane & 15, fq = lane >> 4;
    constexpr int K = GemmT::K, nt = K / BK;
    unsigned voffA[2], voffB[2];
#pragma unroll
    for (int i = 0; i < 2; ++i) { int R, C; stage_rc(tid * 16 + i * 8192, R, C); const int Rb = Epi::PERM ? ((R & ~31) + perm32(R & 31)) : R;
        voffA[i] = (unsigned)(R * GemmT::lda + C) * 2u; voffB[i] = (unsigned)(Rb * GemmT::ldb + C) * 2u; }
    constexpr size_t kstep = (size_t)(BK * 2);
    constexpr size_t hstepA = (size_t)HALF * GemmT::lda * 2, hstepB = (size_t)HALF * GemmT::ldb * 2;
    const unsigned ldsw = (unsigned)wid * 1024u;
    const int aoff = lds_byte(wr * 64 + fr, fq * 8), boff = lds_byte(wc * 32 + fr, fq * 8);
#define PG8_SA(b, h) (((b) * 2 + (h)) * HTB)
#define PG8_SB(b, h) ((4 + (b) * 2 + (h)) * HTB)
#define PG8_STAGE(bufoff, gbase, voff) do { _Pragma("unroll") for (int _i = 0; _i < 2; ++_i) \
        __builtin_amdgcn_global_load_lds((const unsigned*)((const char*)(gbase) + (voff)[_i]), (LAS unsigned*)(lds + (bufoff) + ldsw + _i * 8192), 16, 0, 0); } while (0)
#define PG8_LDA(dst, b, h) do { _Pragma("unroll") for (int m = 0; m < 4; ++m) _Pragma("unroll") for (int k = 0; k < 2; ++k) dst[m][k] = *(const LAS bf16x8*)(lds + PG8_SA(b, h) + aoff + m * 2048 + k * 1024); } while (0)
#define PG8_LDB(dst, b, h) do { _Pragma("unroll") for (int n = 0; n < 2; ++n) _Pragma("unroll") for (int k = 0; k < 2; ++k) dst[n][k] = *(const LAS bf16x8*)(lds + PG8_SB(b, h) + boff + n * 2048 + k * 1024); } while (0)
#define PG8_MMA(ai, bj, At, Bt) do { __builtin_amdgcn_s_setprio(1); _Pragma("unroll") for (int m = 0; m < 4; ++m) _Pragma("unroll") for (int n = 0; n < 2; ++n) _Pragma("unroll") for (int k = 0; k < 2; ++k) \
        acc[ai][bj][m][n] = __builtin_amdgcn_mfma_f32_16x16x32_bf16(Bt[n][k], At[m][k], acc[ai][bj][m][n], 0, 0, 0); __builtin_amdgcn_s_setprio(0); } while (0)
#define PG8_WAIT_V(n) asm volatile("s_waitcnt vmcnt(" #n ")" ::: "memory")
#define PG8_WAIT_L(n) asm volatile("s_waitcnt lgkmcnt(" #n ")" ::: "memory")
#define PG8_BAR __builtin_amdgcn_s_barrier()
#define PG8_SCHED __builtin_amdgcn_sched_barrier(0)
    Unit cur, nxt; int ui = 0;
    if (!S.next(0, cur)) return;
    f32x4 acc[2][2][4][2];
#pragma unroll
    for (int a = 0; a < 2; ++a)
#pragma unroll
        for (int b = 0; b < 2; ++b)
#pragma unroll
            for (int m = 0; m < 4; ++m)
#pragma unroll
                for (int n = 0; n < 2; ++n) acc[a][b][m][n] = (f32x4){0.f, 0.f, 0.f, 0.f};
    bf16x8 At[4][2], B0[2][2], B1[2][2];
    const char* cA = (const char*)(g.A + MP.a_off(cur)); const char* cB = (const char*)(g.Bt + MP.b_off(cur));
    PG8_STAGE(PG8_SB(0, 0), cB, voffB); PG8_STAGE(PG8_SB(0, 1), cB + hstepB, voffB); PG8_STAGE(PG8_SA(0, 0), cA, voffA); PG8_STAGE(PG8_SA(0, 1), cA + hstepA, voffA);
    if (wr == 1) PG8_BAR;
    PG8_WAIT_V(2); PG8_BAR;
    PG8_STAGE(PG8_SB(1, 0), cB + kstep, voffB); PG8_STAGE(PG8_SA(1, 0), cA + kstep, voffA); PG8_STAGE(PG8_SB(1, 1), cB + hstepB + kstep, voffB);
    PG8_WAIT_V(6); PG8_BAR;
    for (;;) {
        const bool has_next = S.next(ui + 1, nxt);
        const char* nA = has_next ? (const char*)(g.A + MP.a_off(nxt)) : cA; const char* nB = has_next ? (const char*)(g.Bt + MP.b_off(nxt)) : cB;
        for (int t = 0; t < nt; t += 2) {
            const bool last = (t == nt - 2);
            const char* a1 = cA + (size_t)(t + 1) * kstep;
            const char* a2 = last ? nA : cA + (size_t)(t + 2) * kstep; const char* b2 = last ? nB : cB + (size_t)(t + 2) * kstep;
            const char* a3 = a2 + kstep; const char* b3 = b2 + kstep;
            PG8_LDB(B0, 0, 0); PG8_LDB(B1, 0, 1); PG8_SCHED; PG8_LDA(At, 0, 0); PG8_STAGE(PG8_SA(1, 1), a1 + hstepA, voffA);
            PG8_WAIT_V(8); PG8_WAIT_L(0); PG8_BAR; PG8_MMA(0, 0, At, B0); PG8_MMA(0, 1, At, B1); PG8_BAR; PG8_SCHED;
            PG8_LDA(At, 0, 1); PG8_STAGE(PG8_SB(0, 0), b2, voffB); PG8_STAGE(PG8_SB(0, 1), b2 + hstepB, voffB); PG8_STAGE(PG8_SA(0, 0), a2, voffA);
            PG8_WAIT_V(8); PG8_WAIT_L(0); PG8_BAR; PG8_MMA(1, 0, At, B0); PG8_MMA(1, 1, At, B1); PG8_BAR; PG8_SCHED;
            PG8_LDB(B0, 1, 0); PG8_LDB(B1, 1, 1); PG8_SCHED; PG8_LDA(At, 1, 0); PG8_STAGE(PG8_SA(0, 1), a2 + hstepA, voffA);
            PG8_WAIT_V(8); PG8_WAIT_L(0); PG8_BAR; PG8_MMA(0, 0, At, B0); PG8_MMA(0, 1, At, B1); PG8_BAR; PG8_SCHED;
            PG8_LDA(At, 1, 1); PG8_STAGE(PG8_SB(1, 0), b3, voffB); PG8_STAGE(PG8_SB(1, 1), b3 + hstepB, voffB); PG8_STAGE(PG8_SA(1, 0), a3, voffA);
            PG8_WAIT_V(8); PG8_WAIT_L(0); PG8_BAR; PG8_MMA(1, 0, At, B0); PG8_MMA(1, 1, At, B1); PG8_BAR; PG8_SCHED;
        }
        if (wr == 0) PG8_BAR;
        E(acc, cur, wr, wc, fr, fq);
        if (!has_next) break;
#pragma unroll
        for (int a = 0; a < 2; ++a)
#pragma unroll
            for (int b = 0; b < 2; ++b)
#pragma unroll
                for (int m = 0; m < 4; ++m)
#pragma unroll
                    for (int n = 0; n < 2; ++n) acc[a][b][m][n] = (f32x4){0.f, 0.f, 0.f, 0.f};
        cur = nxt; cA = nA; cB = nB; ++ui;
        if (wr == 1) PG8_BAR;
    }
    PG8_WAIT_V(0);
    PG8_BAR;
#undef PG8_SA
#undef PG8_SB
#undef PG8_STAGE
#undef PG8_LDA
#undef PG8_LDB
#undef PG8_MMA
#undef PG8_WAIT_V
#undef PG8_WAIT_L
#undef PG8_BAR
#undef PG8_SCHED
}

template <int ldc, int tiles_per_dst, int silu_dst> struct EpiSplit {
    static constexpr bool PERM = true;
    bf16_t *d0, *d1, *d2, *d3;
    __device__ __forceinline__ void operator()(const f32x4 (&acc)[2][2][4][2], const Unit& u, int wr, int wc, int fr, int fq) const {
        const int di = u.pn / tiles_per_dst, ct = u.pn - di * tiles_per_dst;
        bf16_t* base = di == 0 ? d0 : di == 1 ? d1 : di == 2 ? d2 : d3; const bool act = (di == silu_dst);
        const int row0 = u.pm * BM + wr * 64 + fr, col0 = ct * BM + wc * 32 + 8 * fq;
#pragma unroll
        for (int ai = 0; ai < 2; ++ai)
#pragma unroll
            for (int m = 0; m < 4; ++m) { bf16_t* rowp = base + (size_t)(row0 + ai * HALF + m * 16) * ldc + col0;
#pragma unroll
                for (int bj = 0; bj < 2; ++bj) { f32x4 v0 = acc[ai][bj][m][0], v1 = acc[ai][bj][m][1];
                    if (act) { v0 = (f32x4){silu_f(v0[0]), silu_f(v0[1]), silu_f(v0[2]), silu_f(v0[3])}; v1 = (f32x4){silu_f(v1[0]), silu_f(v1[1]), silu_f(v1[2]), silu_f(v1[3])}; }
                    u32x4 w; w.x = cvt_pk_bf16(v0[0], v0[1]); w.y = cvt_pk_bf16(v0[2], v0[3]); w.z = cvt_pk_bf16(v1[0], v1[1]); w.w = cvt_pk_bf16(v1[2], v1[3]);
                    *(u32x4*)(rowp + bj * HALF) = w; } }
    }
};
struct EpiGate {
    static constexpr bool PERM = true; static constexpr int ldc = DI;
    bf16_t* Y; const bf16_t* SZ; const float* scale;
    __device__ __forceinline__ void operator()(const f32x4 (&acc)[2][2][4][2], const Unit& u, int wr, int wc, int fr, int fq) const {
        const int row0 = u.pm * BM + wr * 64 + fr, col0 = u.pn * BM + wc * 32 + 8 * fq;
        f32x4 sc[2][2];
#pragma unroll
        for (int bj = 0; bj < 2; ++bj) { sc[bj][0] = *(const f32x4*)(scale + col0 + bj * HALF); sc[bj][1] = *(const f32x4*)(scale + col0 + bj * HALF + 4); }
#pragma unroll
        for (int ai = 0; ai < 2; ++ai)
#pragma unroll
            for (int m = 0; m < 4; ++m) { const size_t off = (size_t)(row0 + ai * HALF + m * 16) * ldc + col0;
#pragma unroll
                for (int bj = 0; bj < 2; ++bj) { const u32x4 z = *(const u32x4*)(SZ + off + bj * HALF);
                    const f32x4 v0 = acc[ai][bj][m][0] * sc[bj][0], v1 = acc[ai][bj][m][1] * sc[bj][1];
                    u32x4 w; w.x = cvt_pk_bf16(v0[0] * bf_lo(z.x), v0[1] * bf_hi(z.x)); w.y = cvt_pk_bf16(v0[2] * bf_lo(z.y), v0[3] * bf_hi(z.y));
                    w.z = cvt_pk_bf16(v1[0] * bf_lo(z.z), v1[1] * bf_hi(z.z)); w.w = cvt_pk_bf16(v1[2] * bf_lo(z.w), v1[3] * bf_hi(z.w));
                    *(u32x4*)(Y + off + bj * HALF) = w; } }
    }
};
struct EpiRes {
    static constexpr bool PERM = false; static constexpr int ldc = D;
    const float* base; float* out;
    __device__ __forceinline__ void operator()(const f32x4 (&acc)[2][2][4][2], const Unit& u, int wr, int wc, int fr, int fq) const {
        const int row0 = u.pm * BM + wr * 64 + fr, col0 = u.pn * BM + wc * 32 + 4 * fq;
#pragma unroll
        for (int ai = 0; ai < 2; ++ai)
#pragma unroll
            for (int m = 0; m < 4; ++m) { const size_t off = (size_t)(row0 + ai * HALF + m * 16) * ldc + col0;
#pragma unroll
                for (int bj = 0; bj < 2; ++bj)
#pragma unroll
                    for (int n = 0; n < 2; ++n) { const f32x4 b = *(const f32x4*)(base + off + bj * HALF + n * 16); *(f32x4*)(out + off + bj * HALF + n * 16) = b + acc[ai][bj][m][n]; } }
    }
};
template <int lda, int ldb> struct MapPlain { __device__ __forceinline__ size_t a_off(const Unit& u) const { return (size_t)u.pm * BM * lda; } __device__ __forceinline__ size_t b_off(const Unit& u) const { return (size_t)u.pn * BM * ldb; } };
struct MapPool { __device__ __forceinline__ size_t a_off(const Unit& u) const { return (size_t)u.pm * BM * DI + (size_t)(u.pn >> 1) * 512; } __device__ __forceinline__ size_t b_off(const Unit& u) const { return (size_t)u.pn * BM * 512; } };
struct MapQkvz { int g; __device__ __forceinline__ size_t a_off(const Unit& u) const { return (size_t)u.pm * BM * D; } __device__ __forceinline__ size_t b_off(const Unit& u) const { return (size_t)((u.pn >> 1) * DI + g * GW + (u.pn & 1) * BM) * D; } };
}

#define XB_TMO      128
#define XB_XCNT(j)  (256  + 64 * (j))
#define XB_XSUB(j)  (1280 + 64 * (j))
#define XB_XGEN(j)  (2304 + 64 * (j))
#define XB_TOP      3328
#define XB_TOPGEN   3392
#define XCD_BAR_WORDS 3456
#define XB_SPIN_CAP (1u << 18)
__device__ __forceinline__ unsigned xb_ld(unsigned* p)              { return __hip_atomic_load(p, __ATOMIC_RELAXED, __HIP_MEMORY_SCOPE_AGENT); }
__device__ __forceinline__ unsigned xb_add(unsigned* p, unsigned v) { return __hip_atomic_fetch_add(p, v, __ATOMIC_RELAXED, __HIP_MEMORY_SCOPE_AGENT); }
__device__ __forceinline__ unsigned xb_xcc_id() { return (unsigned)__builtin_amdgcn_s_getreg((3 << 11) | 20) & 0xFu; }
#define XB_SPIN(cond, bar) do { unsigned _sp = 0; while (cond) { __builtin_amdgcn_s_sleep(1); \
    if ((++_sp & 255u) == 0u) { if (xb_ld(&(bar)[XB_TMO])) break; if (_sp > XB_SPIN_CAP) { atomicAdd(&(bar)[XB_TMO], 1u); break; } } } } while (0)
struct XcdBarrier { unsigned* bar; unsigned x; volatile LAS unsigned* st; };
__device__ __forceinline__ XcdBarrier xcd_barrier_post(unsigned* bar, volatile LAS unsigned* st) {
    XcdBarrier b; b.bar = bar; b.x = xb_xcc_id(); b.st = st;
    if (threadIdx.x == 0) (void)xb_add(&bar[XB_XCNT(b.x)], 1u);
    return b;
}
__device__ __forceinline__ void xcd_barrier_complete(unsigned* bar, unsigned x, unsigned& nloc, unsigned& nx) {
    const unsigned G = gridDim.x * gridDim.y * gridDim.z;
    unsigned sum, cnt, mine, sp = 0u;
    for (;;) {
        sum = 0u; cnt = 0u; mine = 0u;
#pragma unroll
        for (unsigned j = 0; j < 16; ++j) { const unsigned c = xb_ld(&bar[XB_XCNT(j)]); sum += c; cnt += (c > 0u) ? 1u : 0u; mine = (j == x) ? c : mine; }
        if (sum == G) break;
        __builtin_amdgcn_s_sleep(1);
        if ((++sp & 255u) == 0u) { if (xb_ld(&bar[XB_TMO])) break; if (sp > XB_SPIN_CAP) { atomicAdd(&bar[XB_TMO], 1u); break; } }
    }
    nloc = mine > 0u ? mine : 1u; nx = cnt > 0u ? cnt : 1u;
}
__device__ __forceinline__ void xcd_barrier(const XcdBarrier& b) {
    asm volatile("s_waitcnt vmcnt(0)" ::: "memory");
    __syncthreads();
    if (threadIdx.x == 0) {
        unsigned* bar = b.bar;
        __builtin_amdgcn_s_waitcnt(0);
        unsigned nloc = b.st[0], nx = b.st[1];
        if (nloc == 0u) { xcd_barrier_complete(bar, b.x, nloc, nx); b.st[0] = nloc; b.st[1] = nx; }
        const unsigned old = xb_add(&bar[XB_XSUB(b.x)], 1u);
        const unsigned gen = old / nloc;
        if (old + 1u == (gen + 1u) * nloc) {
            __builtin_amdgcn_fence(__ATOMIC_RELEASE, "agent");
            asm volatile("s_waitcnt vmcnt(0)" ::: "memory");
            const unsigned og = xb_add(&bar[XB_TOP], 1u);
            const unsigned tg = og / nx;
            if (og + 1u == (tg + 1u) * nx) xb_add(&bar[XB_TOPGEN], 1u);
            else XB_SPIN(xb_ld(&bar[XB_TOPGEN]) == tg, bar);
            __builtin_amdgcn_fence(__ATOMIC_ACQUIRE, "agent");
            xb_add(&bar[XB_XGEN(b.x)], 1u);
            asm volatile("s_waitcnt vmcnt(0)" ::: "memory");
        } else {
            XB_SPIN(xb_ld(&bar[XB_XGEN(b.x)]) == gen, bar);
            __builtin_amdgcn_fence(__ATOMIC_ACQUIRE, "agent");
            asm volatile("s_waitcnt vmcnt(0)" ::: "memory");
        }
    }
    __syncthreads();
}

struct Args { const float* in[11]; float* out; unsigned char* ws; int ph_lo, ph_hi, coop, pad; };

__device__ __forceinline__ void transpose_item(const float* W, int K, int N, bf16_t* WT, LAS float* scr, int item, int lane) {
    const int nblk = N / 32, kb = item / nblk, nb = item % nblk, k0 = 64 * kb, n0 = 32 * nb;
#pragma unroll 8
    for (int i = 0; i < 32; ++i) { const int kk = 2 * i + (lane >> 5); scr[kk * 33 + (lane & 31)] = W[(size_t)(k0 + kk) * N + n0 + (lane & 31)]; }
    asm volatile("s_waitcnt lgkmcnt(0)" ::: "memory");
    const int c = lane & 7;
#pragma unroll
    for (int j = 0; j < 4; ++j) { const int n = (lane >> 3) + 8 * j; const LAS float* s = scr + (8 * c) * 33 + n;
        u32x4 o; o.x = cvt_pk_bf16(s[0 * 33], s[1 * 33]); o.y = cvt_pk_bf16(s[2 * 33], s[3 * 33]); o.z = cvt_pk_bf16(s[4 * 33], s[5 * 33]); o.w = cvt_pk_bf16(s[6 * 33], s[7 * 33]);
        *(u32x4*)(WT + (size_t)(n0 + n) * K + k0 + 8 * c) = o; }
    asm volatile("s_waitcnt lgkmcnt(0)" ::: "memory");
}
__device__ __forceinline__ void rms_row(const float* xrow, const float* gain, bf16_t* orow, int lane) {
    const f32x4* xr = (const f32x4*)xrow + lane; const f32x4* gr = (const f32x4*)gain + lane;
    f32x4 v[4]; float s = 0.f;
#pragma unroll
    for (int j = 0; j < 4; ++j) { v[j] = xr[64 * j]; s += (v[j].x * v[j].x + v[j].y * v[j].y) + (v[j].z * v[j].z + v[j].w * v[j].w); }
    const float rstd = 1.0f / sqrtf(wave_sum(s) * (1.f / D) + EPS);
    u32x2* o8 = (u32x2*)orow + lane;
#pragma unroll
    for (int j = 0; j < 4; ++j) { const f32x4 gg = gr[64 * j]; u32x2 w; w.x = cvt_pk_bf16(v[j].x * rstd * gg.x, v[j].y * rstd * gg.y); w.y = cvt_pk_bf16(v[j].z * rstd * gg.z, v[j].w * rstd * gg.w); o8[64 * j] = w; }
}
__device__ __forceinline__ void rope_entry(int idx, f32x2* tab) {
    const int pos = idx >> 6, i = idx & 63;
    const float inv = (float)exp2(-(double)(2 * i) * (13.287712379549449 / 128.0));
    const float angf = (float)pos * inv;
    const double a = (double)angf; const double q = rint(a * 0.6366197723675814); const double r = a - q * 1.5707963267948966;
    const double r2 = r * r;
    double sn = r * (1.0 - r2 / 6.0 * (1.0 - r2 / 20.0 * (1.0 - r2 / 42.0 * (1.0 - r2 / 72.0 * (1.0 - r2 / 110.0 * (1.0 - r2 / 156.0))))));
    double cs = 1.0 - r2 / 2.0 * (1.0 - r2 / 12.0 * (1.0 - r2 / 30.0 * (1.0 - r2 / 56.0 * (1.0 - r2 / 90.0 * (1.0 - r2 / 132.0)))));
    const int qi = ((int)q) & 3;
    double c2, s2;
    if (qi == 0) { c2 = cs; s2 = sn; } else if (qi == 1) { c2 = -sn; s2 = cs; } else if (qi == 2) { c2 = -cs; s2 = -sn; } else { c2 = sn; s2 = -cs; }
    tab[idx] = (f32x2){(float)c2, (float)s2};
}

__global__ void __launch_bounds__(NTHREADS, 2) mega_fwd(Args args) {
    extern __shared__ __attribute__((aligned(16))) unsigned char lds_raw[];
    LAS unsigned char* lds = (LAS unsigned char*)lds_raw;
    cg::grid_group grid = cg::this_grid();
    const int G = gridDim.x, bx = blockIdx.x;
    volatile LAS unsigned* bst = (volatile LAS unsigned*)(lds + LDS_BYTES - 16);
    if (threadIdx.x < 4) bst[threadIdx.x] = 0u;
    __syncthreads();
    XcdBarrier xbar; xbar.bar = (unsigned*)(args.ws + WS_BAR); xbar.x = 0; xbar.st = bst;
    if (args.coop) xbar = xcd_barrier_post((unsigned*)(args.ws + WS_BAR), bst);
    unsigned char* ws = args.ws;
#define XIN (args.in[0])
#define norm0 (args.in[1])
#define w_in0 (args.in[2])
#define w_pool0 (args.in[3])
#define pool_scale0 (args.in[4])
#define w_out0 (args.in[5])
#define norm1 (args.in[6])
#define w_in1 (args.in[7])
#define q_norm1 (args.in[8])
#define k_norm1 (args.in[9])
#define w_out1 (args.in[10])
    float* out = args.out;
#define WIN0 ((bf16_t*)(ws + WS_WIN0))
#define WP ((bf16_t*)(ws + WS_WP))
#define WOUT0 ((bf16_t*)(ws + WS_WOUT0))
#define WIN1 ((bf16_t*)(ws + WS_WIN1))
#define WOUT1 ((bf16_t*)(ws + WS_WOUT1))
#define H0 ((bf16_t*)(ws + WS_H0))
#define POOLED ((bf16_t*)(ws + WS_POOLED))
#define U ((bf16_t*)(ws + WS_U))
#define SZ0 ((bf16_t*)(ws + WS_SZ0))
#define H1 ((bf16_t*)(ws + WS_H1))
#define QG ((bf16_t*)(ws + WS_QG))
#define KG ((bf16_t*)(ws + WS_KG))
#define VG ((bf16_t*)(ws + WS_VG))
#define SZG ((bf16_t*)(ws + WS_SZG))
#define OPART ((bf16_t*)(ws + WS_OPART))
#define AT ((bf16_t*)(ws + WS_A))
#define KMEAN ((float*)(ws + WS_KMEAN))
#define SEL ((unsigned*)(ws + WS_SEL))
#define LPART ((float*)(ws + WS_LPART))
#define TAB ((f32x2*)(ws + WS_TAB))
#define LIST ((unsigned short*)(ws + WS_LIST))
#define CNT ((unsigned*)(ws + WS_CTL))
    const int lo = args.ph_lo, hi = args.ph_hi;
#define IN(k) (lo <= (k) && (k) < hi)
#define SYNC(k) do { if (IN(k) && IN((k) + 1) && args.coop) { if ((k) == 0) grid.sync(); else xcd_barrier(xbar); } } while (0)
    {
        if (IN(0) && (PH_MASK & 1)) {
            int tid = threadIdx.x; asm volatile("" : "+v"(tid)); const int lane = tid & 63, wave = __builtin_amdgcn_readfirstlane(tid >> 6); (void)lane; (void)wave;
            LAS float* scr = (LAS float*)(lds + wave * 16384);
            const int gw = bx * 8 + wave, NGW = G * 8;
            constexpr int I0 = (D / 64) * (2 * DI / 32), IP = (512 / 64) * (512 / 32), I1 = (DI / 64) * (D / 32), I2 = (D / 64) * (4 * DI / 32), I3 = I1;
            constexpr int NITEMS = I0 + 4 * IP + I1 + I2 + I3;
            for (int it = gw; it < NITEMS; it += NGW) {
                int r = it;
                if (r < I0) { transpose_item(w_in0, D, 2 * DI, WIN0, scr, r, lane); continue; } r -= I0;
                if (r < 4 * IP) { const int gp = r / IP; transpose_item(w_pool0 + (size_t)gp * 512 * 512, 512, 512, WP + (size_t)gp * 512 * 512, scr, r - gp * IP, lane); continue; } r -= 4 * IP;
                if (r < I1) { transpose_item(w_out0, DI, D, WOUT0, scr, r, lane); continue; } r -= I1;
                if (r < I2) { transpose_item(w_in1, D, 4 * DI, WIN1, scr, r, lane); continue; } r -= I2;
                transpose_item(w_out1, DI, D, WOUT1, scr, r, lane);
            }
            for (int idx = bx * NTHREADS + tid; idx < SEQ * 64; idx += G * NTHREADS) rope_entry(idx, TAB);
            for (int m = gw; m < M; m += NGW) rms_row(XIN + (size_t)m * D, norm0, H0 + (size_t)m * D, lane);
        }
        SYNC(0);
        if (IN(1) && (PH_MASK & 2)) {
            int tid = threadIdx.x; asm volatile("" : "+v"(tid)); const int lane = tid & 63, wave = __builtin_amdgcn_readfirstlane(tid >> 6); (void)lane; (void)wave;
            pg8::Gemm<D, D, D> g{H0, WIN0}; pg8::StaticOrder S; S.init(M, 2 * DI, G, bx);
            pg8::EpiSplit<DI, 8, 1> E{U, SZ0, U, U}; pg8::MapPlain<D, D> MP;
            pg8::gemm_phase(lds, g, S, MP, E);
        }
        SYNC(1);
        if (IN(2) && (PH_MASK & 4)) {
            int tid = threadIdx.x; asm volatile("" : "+v"(tid)); const int lane = tid & 63, wave = __builtin_amdgcn_readfirstlane(tid >> 6); (void)lane; (void)wave;
            const int cgp = tid & 255, hh = tid >> 8, col = cgp * 8, w = 2 << (cgp >> 6);
            for (int unit = bx; unit < M / 64; unit += G) {
                const int r0 = unit * 64 + hh * 32, p0 = r0 & (SEQ - 1);
                float sum[8];
#pragma unroll
                for (int e = 0; e < 8; ++e) sum[e] = 0.f;
                for (int i = 1; i < w; ++i) { if (p0 - i >= 0) { const u32x4 v = *(const u32x4*)(U + (size_t)(r0 - i) * DI + col);
                    sum[0] += bf_lo(v.x); sum[1] += bf_hi(v.x); sum[2] += bf_lo(v.y); sum[3] += bf_hi(v.y); sum[4] += bf_lo(v.z); sum[5] += bf_hi(v.z); sum[6] += bf_lo(v.w); sum[7] += bf_hi(v.w); } }
                for (int t = 0; t < 32; ++t) {
                    const int p = p0 + t; const u32x4 v = *(const u32x4*)(U + (size_t)(r0 + t) * DI + col);
                    float c[8] = {bf_lo(v.x), bf_hi(v.x), bf_lo(v.y), bf_hi(v.y), bf_lo(v.z), bf_hi(v.z), bf_lo(v.w), bf_hi(v.w)};
                    const float rc = 1.0f / (float)((p + 1) < w ? (p + 1) : w);
                    float o[8];
#pragma unroll
                    for (int e = 0; e < 8; ++e) { sum[e] += c[e]; o[e] = sum[e] * rc - c[e]; }
                    u32x4 wv; wv.x = cvt_pk_bf16(o[0], o[1]); wv.y = cvt_pk_bf16(o[2], o[3]); wv.z = cvt_pk_bf16(o[4], o[5]); wv.w = cvt_pk_bf16(o[6], o[7]);
                    *(u32x4*)(POOLED + (size_t)(r0 + t) * DI + col) = wv;
                    if (p - w + 1 >= 0) { const u32x4 q = *(const u32x4*)(U + (size_t)(r0 + t - w + 1) * DI + col);
                        sum[0] -= bf_lo(q.x); sum[1] -= bf_hi(q.x); sum[2] -= bf_lo(q.y); sum[3] -= bf_hi(q.y); sum[4] -= bf_lo(q.z); sum[5] -= bf_hi(q.z); sum[6] -= bf_lo(q.w); sum[7] -= bf_hi(q.w); }
                }
            }
        }
        SYNC(2);
        if (IN(3) && (PH_MASK & 8)) {
            int tid = threadIdx.x; asm volatile("" : "+v"(tid)); const int lane = tid & 63, wave = __builtin_amdgcn_readfirstlane(tid >> 6); (void)lane; (void)wave;
            pg8::Gemm<DI, 512, 512> g{POOLED, WP}; pg8::StaticOrder S; S.init(M, DI, G, bx);
            pg8::EpiGate E{U, SZ0, pool_scale0}; pg8::MapPool MP;
            pg8::gemm_phase(lds, g, S, MP, E);
        }
        SYNC(3);
        if (IN(4) && (PH_MASK & 16)) {
            int tid = threadIdx.x; asm volatile("" : "+v"(tid)); const int lane = tid & 63, wave = __builtin_amdgcn_readfirstlane(tid >> 6); (void)lane; (void)wave;
            pg8::Gemm<DI, DI, DI> g{U, WOUT0}; pg8::StaticOrder S; S.init(M, D, G, bx);
            pg8::EpiRes E{XIN, out}; pg8::MapPlain<DI, DI> MP;
            pg8::gemm_phase(lds, g, S, MP, E);
        }
        SYNC(4);
        if (IN(5) && (PH_MASK & 32)) {
            int tid = threadIdx.x; asm volatile("" : "+v"(tid)); const int lane = tid & 63, wave = __builtin_amdgcn_readfirstlane(tid >> 6); (void)lane; (void)wave;
            const int gw = bx * 8 + wave, NGW = G * 8;
            for (int m = gw; m < M; m += NGW) rms_row(out + (size_t)m * D, norm1, H1 + (size_t)m * D, lane);
        }
        SYNC(5);
#pragma unroll
        for (int g = 0; g < NG; ++g) {
            const int pb = 6 + 5 * g;
            if (IN(pb) && (PH_MASK & 64)) {
            int tid = threadIdx.x; asm volatile("" : "+v"(tid)); const int lane = tid & 63, wave = __builtin_amdgcn_readfirstlane(tid >> 6); (void)lane; (void)wave;
                pg8::Gemm<D, D, D> gm{H1, WIN1}; pg8::StaticOrder S; S.init(M, 4 * GW, G, bx);
                pg8::EpiSplit<GW, 2, 3> E{QG, KG, VG, SZG}; pg8::MapQkvz MP{g};
                pg8::gemm_phase(lds, gm, S, MP, E);
            }
            SYNC(pb);
            if (IN(pb + 1) && (PH_MASK & 128)) {
            int tid = threadIdx.x; asm volatile("" : "+v"(tid)); const int lane = tid & 63, wave = __builtin_amdgcn_readfirstlane(tid >> 6); (void)lane; (void)wave;
                LAS float* wsum = (LAS float*)lds;
                const int j8 = (lane & 7) * 8, rsub = lane >> 3;
                f32x4 gq[4], gk[4];
                gq[0] = *(const f32x4*)(q_norm1 + j8); gq[1] = *(const f32x4*)(q_norm1 + j8 + 4); gq[2] = *(const f32x4*)(q_norm1 + 64 + j8); gq[3] = *(const f32x4*)(q_norm1 + 68 + j8);
                gk[0] = *(const f32x4*)(k_norm1 + j8); gk[1] = *(const f32x4*)(k_norm1 + j8 + 4); gk[2] = *(const f32x4*)(k_norm1 + 64 + j8); gk[3] = *(const f32x4*)(k_norm1 + 68 + j8);
#pragma unroll 1
                for (int unit = bx; unit < 8 * NB; unit += G) {
                    const int bh = unit >> 5, n = unit & 31, b = bh >> 2, hl = bh & 3;
                    float ks[16];
#pragma unroll
                    for (int e = 0; e < 16; ++e) ks[e] = 0.f;
#pragma unroll 1
                    for (int hb = 0; hb < 2; ++hb) {
                    u32x4 ka[2], kc[2], qa[2], qc[2]; f32x4 tb[2][4];
#pragma unroll
                    for (int it = 0; it < 2; ++it) {
                        const int pos = n * BLK + wave * 32 + (hb * 2 + it) * 8 + rsub;
                        const size_t off = (size_t)(b * SEQ + pos) * GW + hl * HD + j8;
                        ka[it] = *(const u32x4*)(KG + off); kc[it] = *(const u32x4*)(KG + off + 64);
                        qa[it] = *(const u32x4*)(QG + off); qc[it] = *(const u32x4*)(QG + off + 64);
                        const f32x4* tp = (const f32x4*)(TAB + pos * 64 + j8);
                        tb[it][0] = tp[0]; tb[it][1] = tp[1]; tb[it][2] = tp[2]; tb[it][3] = tp[3];
                    }
#pragma unroll
                    for (int it = 0; it < 2; ++it) {
                        const int pos = n * BLK + wave * 32 + (hb * 2 + it) * 8 + rsub;
                        const size_t off = (size_t)(b * SEQ + pos) * GW + hl * HD + j8;
                        float cs[8], sn[8];
#pragma unroll
                        for (int e = 0; e < 4; ++e) { cs[2 * e] = tb[it][e].x; sn[2 * e] = tb[it][e].y; cs[2 * e + 1] = tb[it][e].z; sn[2 * e + 1] = tb[it][e].w; }
#pragma unroll
                        for (int which = 0; which < 2; ++which) {
                            const u32x4 va = which == 0 ? ka[it] : qa[it], vc = which == 0 ? kc[it] : qc[it];
                            float x1[8] = {bf_lo(va.x), bf_hi(va.x), bf_lo(va.y), bf_hi(va.y), bf_lo(va.z), bf_hi(va.z), bf_lo(va.w), bf_hi(va.w)};
                            float x2[8] = {bf_lo(vc.x), bf_hi(vc.x), bf_lo(vc.y), bf_hi(vc.y), bf_lo(vc.z), bf_hi(vc.z), bf_lo(vc.w), bf_hi(vc.w)};
                            float ss = 0.f;
#pragma unroll
                            for (int e = 0; e < 8; ++e) ss += x1[e] * x1[e] + x2[e] * x2[e];
                            ss += __shfl_xor(ss, 1); ss += __shfl_xor(ss, 2); ss += __shfl_xor(ss, 4);
                            const float rstd = (which == 0 ? 1.0f : QSCALE) / sqrtf(ss * (1.f / HD) + EPS);
                            float o1[8], o2[8];
#pragma unroll
                            for (int e = 0; e < 8; ++e) {
                                const float g1 = which == 0 ? gk[e >> 2][e & 3] : gq[e >> 2][e & 3], g2 = which == 0 ? gk[2 + (e >> 2)][e & 3] : gq[2 + (e >> 2)][e & 3];
                                const float y1 = x1[e] * rstd * g1, y2 = x2[e] * rstd * g2;
                                o1[e] = y1 * cs[e] - y2 * sn[e]; o2[e] = y2 * cs[e] + y1 * sn[e];
                                if (which == 0) { ks[e] += o1[e]; ks[8 + e] += o2[e]; }
                            }
                            u32x4 w1, w2;
                            w1.x = cvt_pk_bf16(o1[0], o1[1]); w1.y = cvt_pk_bf16(o1[2], o1[3]); w1.z = cvt_pk_bf16(o1[4], o1[5]); w1.w = cvt_pk_bf16(o1[6], o1[7]);
                            w2.x = cvt_pk_bf16(o2[0], o2[1]); w2.y = cvt_pk_bf16(o2[2], o2[3]); w2.z = cvt_pk_bf16(o2[4], o2[5]); w2.w = cvt_pk_bf16(o2[6], o2[7]);
                            bf16_t* dstp = which == 0 ? KG : QG;
                            *(u32x4*)(dstp + off) = w1; *(u32x4*)(dstp + off + 64) = w2;
                        }
                    }
                    }
#pragma unroll
                    for (int e = 0; e < 16; ++e) { float v = ks[e]; v += __shfl_xor(v, 8); v += __shfl_xor(v, 16); v += __shfl_xor(v, 32); ks[e] = v; }
                    if (lane < 8) {
#pragma unroll
                        for (int e = 0; e < 8; ++e) { wsum[wave * 128 + j8 + e] = ks[e]; wsum[wave * 128 + 64 + j8 + e] = ks[8 + e]; }
                    }
                    __syncthreads();
                    if (tid < 128) { float sv = 0.f;
#pragma unroll
                        for (int w8 = 0; w8 < 8; ++w8) sv += wsum[w8 * 128 + tid];
                        KMEAN[((size_t)(g * 8 + bh) * NB + n) * HD + tid] = sv * (1.f / BLK); }
                    __syncthreads();
                }
            }
            SYNC(pb + 1);
            if (IN(pb + 2) && (PH_MASK & 256)) {
            int tid = threadIdx.x; asm volatile("" : "+v"(tid)); const int lane = tid & 63, wave = __builtin_amdgcn_readfirstlane(tid >> 6); (void)lane; (void)wave;
                LAS float* km = (LAS float*)lds;
                LAS float* mv = (LAS float*)(lds + 16384);
                LAS int* mi = (LAS int*)(lds + 16384 + 3072);
                LAS unsigned* lcnt = (LAS unsigned*)(lds + 16384 + 6144);
                LAS unsigned* lbase = lcnt + 32;
                if (tid < 32) lcnt[tid] = 0u;
                __syncthreads();
#pragma unroll 1
                for (int unit = bx; unit < 8 * NB; unit += G) {
                    const int bh = unit >> 5, qb = unit & 31, b = bh >> 2, hl = bh & 3;
                    const int qi = tid & 255, hf = tid >> 8;
                    const int s = qb * BLK + qi; const size_t mrow = (size_t)b * SEQ + s;
                    if (qb > 0) {
                        u32x4 qv[16];
#pragma unroll
                        for (int c = 0; c < 16; ++c) qv[c] = *(const u32x4*)(QG + mrow * GW + hl * HD + c * 8);
                        for (int c = tid; c < qb * 32; c += NTHREADS) *(LAS f32x4*)(km + c * 4) = *(const f32x4*)(KMEAN + (size_t)(g * 8 + bh) * NB * HD + c * 4);
                        __syncthreads();
                        float v0 = -INFINITY, v1 = -INFINITY, v2 = -INFINITY; int i0 = 255, i1 = 255, i2 = 255;
#pragma unroll 1
                        for (int n = hf; n < qb; n += 2) {
                            float acc = 0.f;
#pragma unroll
                            for (int c = 0; c < 16; ++c) { const f32x4 ka = *(const LAS f32x4*)(km + n * 128 + c * 8), kb = *(const LAS f32x4*)(km + n * 128 + c * 8 + 4);
                                acc += bf_lo(qv[c].x) * ka.x + bf_hi(qv[c].x) * ka.y + bf_lo(qv[c].y) * ka.z + bf_hi(qv[c].y) * ka.w + bf_lo(qv[c].z) * kb.x + bf_hi(qv[c].z) * kb.y + bf_lo(qv[c].w) * kb.z + bf_hi(qv[c].w) * kb.w; }
                            if (acc > v0) { v2 = v1; i2 = i1; v1 = v0; i1 = i0; v0 = acc; i0 = n; }
                            else if (acc > v1) { v2 = v1; i2 = i1; v1 = acc; i1 = n; }
                            else if (acc > v2) { v2 = acc; i2 = n; }
                        }
                        if (hf == 1) { mv[qi * 3] = v0; mv[qi * 3 + 1] = v1; mv[qi * 3 + 2] = v2; mi[qi * 3] = i0; mi[qi * 3 + 1] = i1; mi[qi * 3 + 2] = i2; }
                        __syncthreads();
                        unsigned rk0 = 0, rk1 = 0, rk2 = 0;
                        if (hf == 0) {
#pragma unroll
                            for (int e = 0; e < 3; ++e) { const float acc = mv[qi * 3 + e]; const int n = mi[qi * 3 + e];
                                if (n < 255) {
                                    const bool g0 = acc > v0 || (acc == v0 && n < i0), g1 = acc > v1 || (acc == v1 && n < i1), g2 = acc > v2 || (acc == v2 && n < i2);
                                    if (g0) { v2 = v1; i2 = i1; v1 = v0; i1 = i0; v0 = acc; i0 = n; }
                                    else if (g1) { v2 = v1; i2 = i1; v1 = acc; i1 = n; }
                                    else if (g2) { v2 = acc; i2 = n; }
                                } }
                            SEL[mrow * NH + g * HG + hl] = (unsigned)i0 | ((unsigned)i1 << 8) | ((unsigned)i2 << 16);
                            if (i0 < 255) rk0 = atomicAdd((unsigned*)&lcnt[i0], 1u);
                            if (i1 < 255) rk1 = atomicAdd((unsigned*)&lcnt[i1], 1u);
                            if (i2 < 255) rk2 = atomicAdd((unsigned*)&lcnt[i2], 1u);
                        }
                        __syncthreads();
                        if (tid < 32) { const unsigned c = lcnt[tid]; lbase[tid] = c ? atomicAdd(&CNT[g * 256 + bh * NB + tid], c) : 0u; lcnt[tid] = 0u; }
                        __syncthreads();
                        if (hf == 0) {
                            if (i0 < 255) LIST[(size_t)(bh * NB + i0) * SEQ + lbase[i0] + rk0] = (unsigned short)(s | (0 << 13));
                            if (i1 < 255) LIST[(size_t)(bh * NB + i1) * SEQ + lbase[i1] + rk1] = (unsigned short)(s | (1 << 13));
                            if (i2 < 255) LIST[(size_t)(bh * NB + i2) * SEQ + lbase[i2] + rk2] = (unsigned short)(s | (2 << 13));
                        }
                        __syncthreads();
                    } else if (hf == 0) {
                        SEL[mrow * NH + g * HG + hl] = 0x00ffffffu;
                    }
                }
            }
            SYNC(pb + 2);
            if (IN(pb + 3) && (PH_MASK & 512)) {
            int tid = threadIdx.x; asm volatile("" : "+v"(tid)); const int lane = tid & 63, wave = __builtin_amdgcn_readfirstlane(tid >> 6); (void)lane; (void)wave;
                LAS unsigned char* Ks = lds;
                LAS unsigned char* Vt = lds + 256 * 272;
                LAS int* pre = (LAS int*)(lds + 256 * 272 + 128 * 528);
                LAS float* red = (LAS float*)(lds + 256 * 272 + 128 * 528 + 2048);
                {
                    float mq = 0.f, mk = 0.f;
                    if (tid < 128) { mq = fabsf(q_norm1[tid]); mk = fabsf(k_norm1[tid]); }
#pragma unroll
                    for (int o = 1; o < 64; o <<= 1) { mq = fmaxf(mq, __shfl_xor(mq, o)); mk = fmaxf(mk, __shfl_xor(mk, o)); }
                    if (lane == 0) { red[wave * 2] = mq; red[wave * 2 + 1] = mk; }
                    if (tid < 256) pre[tid + 1] = 1 + (int)((CNT[g * 256 + tid] + 255u) >> 8);
                    if (tid == 0) pre[0] = 0;
                    __syncthreads();
                    if (tid == 0) { int a = 0; for (int i = 1; i <= 256; ++i) { a += pre[i]; pre[i] = a; } }
                    __syncthreads();
                }
                const float MSH = 128.0f * QSCALE * fmaxf(red[0], red[2]) * fmaxf(red[1], red[3]) * 1.02f;
                const int total = pre[256];
                const int fr = lane & 15, fq = lane >> 4;
                const int istart = (int)(((long)total * bx) / G), iend = (int)(((long)total * (bx + 1)) / G);
                int cur_li = -1;
#pragma unroll 1
                for (int item = istart; item < iend; ++item) {
                    int loi = 0, hii = 256;
                    while (hii - loi > 1) { const int mid = (loi + hii) >> 1; if (pre[mid] <= item) loi = mid; else hii = mid; }
                    const int li = loi, c = item - pre[li], bh = li >> 5, n = li & 31, b = bh >> 2, hl = bh & 3;
                    const int cnt = (int)CNT[g * 256 + li];
                    const size_t rowbase = (size_t)b * SEQ;
                    const bool restage = (li != cur_li); cur_li = li;
                    if (restage) {
                    __syncthreads();
                    for (int cc = tid; cc < 256 * 16; cc += NTHREADS) { const int r = cc >> 4, c16 = cc & 15;
                        *(LAS u32x4*)(Ks + r * 272 + c16 * 16) = *(const u32x4*)(KG + (rowbase + n * BLK + r) * GW + hl * HD + c16 * 8); }
                    for (int task = tid; task < 1024; task += NTHREADS) {
                        const int a = (task & 15) | ((task >> 5) & 3) << 4, cch = ((task >> 4) & 1) | ((task >> 7) << 1);
                        u32x4 v[4];
#pragma unroll
                        for (int kk = 0; kk < 4; ++kk) v[kk] = *(const u32x4*)(VG + (rowbase + n * BLK + a * 4 + kk) * GW + hl * HD + cch * 8);
#pragma unroll
                        for (int e = 0; e < 4; ++e) {
                            const unsigned w0 = e == 0 ? v[0].x : e == 1 ? v[0].y : e == 2 ? v[0].z : v[0].w, w1 = e == 0 ? v[1].x : e == 1 ? v[1].y : e == 2 ? v[1].z : v[1].w;
                            const unsigned w2 = e == 0 ? v[2].x : e == 1 ? v[2].y : e == 2 ? v[2].z : v[2].w, w3 = e == 0 ? v[3].x : e == 1 ? v[3].y : e == 2 ? v[3].z : v[3].w;
                            u32x2 lo2, hi2;
                            lo2.x = (w0 & 0xffffu) | (w1 << 16); lo2.y = (w2 & 0xffffu) | (w3 << 16);
                            hi2.x = (w0 >> 16) | (w1 & 0xffff0000u); hi2.y = (w2 >> 16) | (w3 & 0xffff0000u);
                            *(LAS u32x2*)(Vt + (cch * 8 + 2 * e) * 528 + a * 8) = lo2;
                            *(LAS u32x2*)(Vt + (cch * 8 + 2 * e + 1) * 528 + a * 8) = hi2;
                        }
                    }
                    }
                    int qpos[2], qslot[2]; bool qok[2];
                    bf16x8 qf[2][4];
#pragma unroll
                    for (int t = 0; t < 2; ++t) {
                        const int ridx = wave * 32 + t * 16 + fr;
                        if (c == 0) { qpos[t] = n * BLK + ridx; qslot[t] = 3; qok[t] = true; }
                        else { const int lidx = (c - 1) * 256 + ridx; qok[t] = lidx < cnt; const unsigned e = LIST[(size_t)li * SEQ + (qok[t] ? lidx : 0)]; qpos[t] = e & 8191; qslot[t] = e >> 13; }
                        const bf16_t* qp = QG + (rowbase + qpos[t]) * GW + hl * HD + fq * 8;
#pragma unroll
                        for (int ks = 0; ks < 4; ++ks) qf[t][ks] = *(const bf16x8*)(qp + ks * 32);
                    }
                    if (restage) __syncthreads();
                    f32x4 oacc[2][8]; float lsum[2] = {0.f, 0.f};
#pragma unroll
                    for (int t = 0; t < 2; ++t)
#pragma unroll
                        for (int dt = 0; dt < 8; ++dt) oacc[t][dt] = (f32x4){0.f, 0.f, 0.f, 0.f};
                    const int qrel0 = qpos[0] - n * BLK, qrel1 = qpos[1] - n * BLK;
#pragma unroll 1
                    for (int kg = 0; kg < 8; ++kg) {
                        f32x4 sacc[2][2];
#pragma unroll
                        for (int kt = 0; kt < 2; ++kt) { sacc[kt][0] = (f32x4){0.f, 0.f, 0.f, 0.f}; sacc[kt][1] = (f32x4){0.f, 0.f, 0.f, 0.f};
#pragma unroll
                            for (int ks = 0; ks < 4; ++ks) { const bf16x8 kf = *(const LAS bf16x8*)(Ks + (kg * 32 + kt * 16 + fr) * 272 + ks * 64 + fq * 16);
                                sacc[kt][0] = __builtin_amdgcn_mfma_f32_16x16x32_bf16(kf, qf[0][ks], sacc[kt][0], 0, 0, 0);
                                sacc[kt][1] = __builtin_amdgcn_mfma_f32_16x16x32_bf16(kf, qf[1][ks], sacc[kt][1], 0, 0, 0); } }
                        bf16x8 pb[2];
#pragma unroll
                        for (int t = 0; t < 2; ++t) {
                            float p[8];
#pragma unroll
                            for (int kt = 0; kt < 2; ++kt)
#pragma unroll
                                for (int j = 0; j < 4; ++j) { float pv = __builtin_amdgcn_exp2f(sacc[kt][t][j] - MSH);
                                    if (c == 0) { const int key = kg * 32 + kt * 16 + fq * 4 + j; if (key > (t == 0 ? qrel0 : qrel1)) pv = 0.f; }
                                    p[kt * 4 + j] = pv; lsum[t] += pv; }
                            u32x4 w; w.x = cvt_pk_bf16(p[0], p[1]); w.y = cvt_pk_bf16(p[2], p[3]); w.z = cvt_pk_bf16(p[4], p[5]); w.w = cvt_pk_bf16(p[6], p[7]);
                            pb[t] = __builtin_bit_cast(bf16x8, w);
                        }
#pragma unroll
                        for (int dt = 0; dt < 8; ++dt) {
                            const u32x2 va = *(const LAS u32x2*)(Vt + (dt * 16 + fr) * 528 + kg * 64 + fq * 8), vb = *(const LAS u32x2*)(Vt + (dt * 16 + fr) * 528 + kg * 64 + 32 + fq * 8);
                            u32x4 vv; vv.x = va.x; vv.y = va.y; vv.z = vb.x; vv.w = vb.y; const bf16x8 vf = __builtin_bit_cast(bf16x8, vv);
                            oacc[0][dt] = __builtin_amdgcn_mfma_f32_16x16x32_bf16(vf, pb[0], oacc[0][dt], 0, 0, 0);
                            oacc[1][dt] = __builtin_amdgcn_mfma_f32_16x16x32_bf16(vf, pb[1], oacc[1][dt], 0, 0, 0);
                        }
                    }
#pragma unroll
                    for (int t = 0; t < 2; ++t) {
                        float l = lsum[t]; l += __shfl_xor(l, 16); l += __shfl_xor(l, 32);
                        if (qok[t]) {
                            const size_t pair = (rowbase + qpos[t]) * HG + hl;
                            bf16_t* op = OPART + (pair * 4 + qslot[t]) * HD + fq * 4;
#pragma unroll
                            for (int dt = 0; dt < 8; ++dt) { u32x2 w; w.x = cvt_pk_bf16(oacc[t][dt][0], oacc[t][dt][1]); w.y = cvt_pk_bf16(oacc[t][dt][2], oacc[t][dt][3]); *(u32x2*)(op + dt * 16) = w; }
                            if (fq == 0) LPART[pair * 4 + qslot[t]] = l;
                        }
                    }
                }
            }
            SYNC(pb + 3);
            if (IN(pb + 4) && (PH_MASK & 1024)) {
            int tid = threadIdx.x; asm volatile("" : "+v"(tid)); const int lane = tid & 63, wave = __builtin_amdgcn_readfirstlane(tid >> 6); (void)lane; (void)wave;
                for (int idx = bx * NTHREADS + tid; idx < M * HG * 16; idx += G * NTHREADS) {
                    const int pair = idx >> 4, ch = idx & 15, m = pair >> 2, hl = pair & 3;
                    const unsigned sel = SEL[(size_t)m * NH + g * HG + hl];
                    float o[8]; float l = LPART[(size_t)pair * 4 + 3];
                    { const u32x4 v = *(const u32x4*)(OPART + ((size_t)pair * 4 + 3) * HD + ch * 8);
                      o[0] = bf_lo(v.x); o[1] = bf_hi(v.x); o[2] = bf_lo(v.y); o[3] = bf_hi(v.y); o[4] = bf_lo(v.z); o[5] = bf_hi(v.z); o[6] = bf_lo(v.w); o[7] = bf_hi(v.w); }
#pragma unroll
                    for (int e = 0; e < 3; ++e) if (((sel >> (8 * e)) & 0xffu) != 0xffu) {
                        const u32x4 v = *(const u32x4*)(OPART + ((size_t)pair * 4 + e) * HD + ch * 8); l += LPART[(size_t)pair * 4 + e];
                        o[0] += bf_lo(v.x); o[1] += bf_hi(v.x); o[2] += bf_lo(v.y); o[3] += bf_hi(v.y); o[4] += bf_lo(v.z); o[5] += bf_hi(v.z); o[6] += bf_lo(v.w); o[7] += bf_hi(v.w); }
                    const float rl = 1.0f / l;
                    const u32x4 z = *(const u32x4*)(SZG + (size_t)m * GW + hl * HD + ch * 8);
                    u32x4 w; w.x = cvt_pk_bf16(o[0] * rl * bf_lo(z.x), o[1] * rl * bf_hi(z.x)); w.y = cvt_pk_bf16(o[2] * rl * bf_lo(z.y), o[3] * rl * bf_hi(z.y));
                    w.z = cvt_pk_bf16(o[4] * rl * bf_lo(z.z), o[5] * rl * bf_hi(z.z)); w.w = cvt_pk_bf16(o[6] * rl * bf_lo(z.w), o[7] * rl * bf_hi(z.w));
                    *(u32x4*)(AT + (size_t)m * DI + g * GW + hl * HD + ch * 8) = w;
                }
            }
            SYNC(pb + 4);
        }
        if (IN(6 + 5 * NG) && (PH_MASK & 2048)) {
            int tid = threadIdx.x; asm volatile("" : "+v"(tid)); const int lane = tid & 63, wave = __builtin_amdgcn_readfirstlane(tid >> 6); (void)lane; (void)wave;
            pg8::Gemm<DI, DI, DI> gm{AT, WOUT1}; pg8::StaticOrder S; S.init(M, D, G, bx);
            pg8::EpiRes E{out, out}; pg8::MapPlain<DI, DI> MP;
            pg8::gemm_phase(lds, gm, S, MP, E);
        }
    }
}

constexpr int NPHASES = 6 + 5 * NG + 1;

extern "C" void kernel_launch(void* const* d_in, const int* in_sizes, int n_in, void* d_out, int out_size, void* d_ws, size_t ws_size, hipStream_t stream) {
    static int grid = 0;
    if (grid == 0) {
        int dev = 0, cus = 0, per_cu = 0;
        hipGetDevice(&dev);
        hipDeviceGetAttribute(&cus, hipDeviceAttributeMultiprocessorCount, dev);
        hipFuncSetAttribute((const void*)mega_fwd, hipFuncAttributeMaxDynamicSharedMemorySize, LDS_BYTES);
        hipOccupancyMaxActiveBlocksPerMultiprocessor(&per_cu, (const void*)mega_fwd, NTHREADS, LDS_BYTES);
        if (per_cu < 1) { fprintf(stderr, "kernel_launch: occupancy query says %d blocks per CU\n", per_cu); per_cu = 1; }
        grid = cus;
        if (ws_size < WS_END) fprintf(stderr, "kernel_launch: workspace too small: %zu < %zu\n", ws_size, (size_t)WS_END);
    }
    hipMemsetAsync((char*)d_ws + WS_CTL, 0, CTL_BYTES, stream);
    Args a{};
    for (int i = 0; i < 11; ++i) a.in[i] = (const float*)d_in[i];
    a.out = (float*)d_out; a.ws = (unsigned char*)d_ws; a.pad = 0;
#if defined(MK_PER_PHASE)
    for (int ph = 0; ph < NPHASES; ++ph) { a.ph_lo = ph; a.ph_hi = ph + 1; a.coop = 0; hipLaunchKernelGGL(mega_fwd, dim3(grid), dim3(NTHREADS), LDS_BYTES, stream, a); }
#else
    a.ph_lo = 0; a.ph_hi = NPHASES; a.coop = 1;
    void* kargs[] = {&a};
    hipError_t e = hipLaunchCooperativeKernel((const void*)mega_fwd, dim3(grid), dim3(NTHREADS), kargs, LDS_BYTES, stream);
    if (e != hipSuccess) fprintf(stderr, "cooperative launch failed: %s (grid %d)\n", hipGetErrorString(e), grid);
#endif
}
```

```cpp
#include <hip/hip_runtime.h>
#include <hip/hip_cooperative_groups.h>
#include <cstdio>
#include <cstdint>
namespace cg = cooperative_groups;

#define LAS __attribute__((address_space(3)))
typedef unsigned short bf16_t;
typedef short bf16x8 __attribute__((ext_vector_type(8)));
typedef float f32x4 __attribute__((ext_vector_type(4)));
typedef float f32x2 __attribute__((ext_vector_type(2)));
typedef unsigned u32x4 __attribute__((ext_vector_type(4)));
typedef unsigned u32x2 __attribute__((ext_vector_type(2)));

constexpr int SEQ = 8192, NBATCH = 2, M = NBATCH * SEQ, D = 1024, DI = 2048, NH = 16, HD = 128, BLK = 256, NB = SEQ / BLK;
constexpr int NG = 4, HG = NH / NG, GW = HG * HD;
constexpr float EPS = 1e-6f;
constexpr float QSCALE = 0.08838834764831845f * 1.4426950408889634f;

constexpr size_t MiB = 1u << 20;
constexpr size_t WS_CTL = 0, CTL_BYTES = 65536;
constexpr size_t WS_BAR = 8192;
constexpr size_t WS_KMEAN = 1 * MiB;
constexpr size_t WS_SEL = 2 * MiB;
constexpr size_t WS_LPART = 3 * MiB;
constexpr size_t WS_TAB = 4 * MiB;
constexpr size_t WS_WIN1 = 8 * MiB, WS_WOUT1 = 24 * MiB;
constexpr size_t WS_LIST = 28 * MiB;
constexpr size_t WS_WIN0 = 28 * MiB, WS_WP = 36 * MiB, WS_WOUT0 = 38 * MiB;
constexpr size_t WS_H0 = 42 * MiB, WS_POOLED = 42 * MiB, WS_U = 106 * MiB, WS_SZ0 = 170 * MiB;
constexpr size_t WS_H1 = 32 * MiB, WS_QG = 64 * MiB, WS_KG = 80 * MiB, WS_VG = 96 * MiB, WS_SZG = 112 * MiB;
constexpr size_t WS_OPART = 128 * MiB, WS_A = 192 * MiB, WS_END = 256 * MiB;

constexpr int LDS_BYTES = 140 * 1024;
constexpr int NTHREADS = 512;
#ifndef PH_MASK
#define PH_MASK 0xfff
#endif

__device__ __forceinline__ unsigned cvt_pk_bf16(float lo, float hi) { unsigned r; asm volatile("v_cvt_pk_bf16_f32 %0, %1, %2" : "=v"(r) : "v"(lo), "v"(hi)); return r; }
__device__ __forceinline__ float bf_lo(unsigned u) { return __uint_as_float(u << 16); }
__device__ __forceinline__ float bf_hi(unsigned u) { return __uint_as_float(u & 0xffff0000u); }
__device__ __forceinline__ float silu_f(float z) { return z * __builtin_amdgcn_rcpf(1.0f + __builtin_amdgcn_exp2f(-1.4426950408889634f * z)); }
__device__ __forceinline__ float wave_sum(float v) {
#pragma unroll
    for (int o = 1; o < 64; o <<= 1) v += __shfl_xor(v, o);
    return v;
}

namespace pg8 {
constexpr int BM = 256, BK = 64, HALF = 128, HTB = HALF * BK * 2, STAGE_BYTES = 8 * HTB, NXCD = 8, WGM = 8;
__host__ __device__ __forceinline__ int lds_byte(int r, int c) { const int st = (r >> 4) * 2 + (c >> 5), rr = r & 15, cc = c & 31, ob = rr * 64 + cc * 2; return st * 1024 + (ob ^ (((ob >> 9) & 1) << 5)); }
__host__ __device__ __forceinline__ void stage_rc(int b, int& R, int& C) { const int st = b / 1024, sb = b % 1024, swz = sb ^ (((sb >> 9) & 1) << 5); R = (st >> 1) * 16 + swz / 64; C = (st & 1) * 32 + (swz % 64) / 2; }
__host__ __device__ __forceinline__ int perm32(int rho) { const int n = rho >> 4, i = rho & 15; return 8 * (i >> 2) + 4 * n + (i & 3); }

struct Unit { int pm, pn; };
template <int LDA_, int LDB_, int K_> struct Gemm { const bf16_t* A; const bf16_t* Bt; static constexpr int lda = LDA_, ldb = LDB_, K = K_; };
struct StaticOrder {
    int nM, nN, nwg, G, c;
    __device__ void init(int M_, int N_, int G_, int c_) { nM = M_ / BM; nN = N_ / BM; nwg = nM * nN; G = G_; c = c_; }
    __device__ bool next(int i, Unit& u) const {
        const long L = (long)i * G + c; if (L >= nwg) return false;
        int wgid = (int)L; { const int q = nwg / NXCD, r = nwg % NXCD, xcd = wgid % NXCD, off = wgid / NXCD; wgid = (xcd < r ? xcd * (q + 1) : r * (q + 1) + (xcd - r) * q) + off; }
        const int nig = WGM * nN, gid = wgid / nig, fm = gid * WGM, gsz = (nM - fm) < WGM ? (nM - fm) : WGM;
        u.pm = fm + ((wgid % nig) % gsz); u.pn = (wgid % nig) / gsz; return true;
    }
};
template <class Epi, class Map, class GemmT>
__device__ __forceinline__ void gemm_phase(LAS unsigned char* lds, const GemmT g, const StaticOrder& S, const Map& MP, const Epi& E) {
    int tid_ = threadIdx.x; asm volatile("" : "+v"(tid_));
    const int tid = tid_, wid = __builtin_amdgcn_readfirstlane(tid >> 6), lane = tid & 63, wr = wid >> 2, wc = wid & 3, fr = lane & 15, fq = lane >> 4;
    constexpr int K = GemmT::K, nt = K / BK;
    unsigned voffA[2], voffB[2];
#pragma unroll
    for (int i = 0; i < 2; ++i) { int R, C; stage_rc(tid * 16 + i * 8192, R, C); const int Rb = Epi::PERM ? ((R & ~31) + perm32(R & 31)) : R;
        voffA[i] = (unsigned)(R * GemmT::lda + C) * 2u; voffB[i] = (unsigned)(Rb * GemmT::ldb + C) * 2u; }
    constexpr size_t kstep = (size_t)(BK * 2);
    constexpr size_t hstepA = (size_t)HALF * GemmT::lda * 2, hstepB = (size_t)HALF * GemmT::ldb * 2;
    const unsigned ldsw = (unsigned)wid * 1024u;
    const int aoff = lds_byte(wr * 64 + fr, fq * 8), boff = lds_byte(wc * 32 + fr, fq * 8);
#define PG8_SA(b, h) (((b) * 2 + (h)) * HTB)
#define PG8_SB(b, h) ((4 + (b) * 2 + (h)) * HTB)
#define PG8_STAGE(bufoff, gbase, voff) do { _Pragma("unroll") for (int _i = 0; _i < 2; ++_i) \
        __builtin_amdgcn_global_load_lds((const unsigned*)((const char*)(gbase) + (voff)[_i]), (LAS unsigned*)(lds + (bufoff) + ldsw + _i * 8192), 16, 0, 0); } while (0)
#define PG8_LDA(dst, b, h) do { _Pragma("unroll") for (int m = 0; m < 4; ++m) _Pragma("unroll") for (int k = 0; k < 2; ++k) dst[m][k] = *(const LAS bf16x8*)(lds + PG8_SA(b, h) + aoff + m * 2048 + k * 1024); } while (0)
#define PG8_LDB(dst, b, h) do { _Pragma("unroll") for (int n = 0; n < 2; ++n) _Pragma("unroll") for (int k = 0; k < 2; ++k) dst[n][k] = *(const LAS bf16x8*)(lds + PG8_SB(b, h) + boff + n * 2048 + k * 1024); } while (0)
#define PG8_MMA(ai, bj, At, Bt) do { __builtin_amdgcn_s_setprio(1); _Pragma("unroll") for (int m = 0; m < 4; ++m) _Pragma("unroll") for (int n = 0; n < 2; ++n) _Pragma("unroll") for (int k = 0; k < 2; ++k) \
        acc[ai][bj][m][n] = __builtin_amdgcn_mfma_f32_16x16x32_bf16(Bt[n][k], At[m][k], acc[ai][bj][m][n], 0, 0, 0); __builtin_amdgcn_s_setprio(0); } while (0)
#define PG8_WAIT_V(n) asm volatile("s_waitcnt vmcnt(" #n ")" ::: "memory")
#define PG8_WAIT_L(n) asm volatile("s_waitcnt lgkmcnt(" #n ")" ::: "memory")
#define PG8_BAR __builtin_amdgcn_s_barrier()
#define PG8_SCHED __builtin_amdgcn_sched_barrier(0)
    Unit cur, nxt; int ui = 0;
    if (!S.next(0, cur)) return;
    f32x4 acc[2][2][4][2];
#pragma unroll
    for (int a = 0; a < 2; ++a)
#pragma unroll
        for (int b = 0; b < 2; ++b)
#pragma unroll
            for (int m = 0; m < 4; ++m)
#pragma unroll
                for (int n = 0; n < 2; ++n) acc[a][b][m][n] = (f32x4){0.f, 0.f, 0.f, 0.f};
    bf16x8 At[4][2], B0[2][2], B1[2][2];
    const char* cA = (const char*)(g.A + MP.a_off(cur)); const char* cB = (const char*)(g.Bt + MP.b_off(cur));
    PG8_STAGE(PG8_SB(0, 0), cB, voffB); PG8_STAGE(PG8_SB(0, 1), cB + hstepB, voffB); PG8_STAGE(PG8_SA(0, 0), cA, voffA); PG8_STAGE(PG8_SA(0, 1), cA + hstepA, voffA);
    if (wr == 1) PG8_BAR;
    PG8_WAIT_V(2); PG8_BAR;
    PG8_STAGE(PG8_SB(1, 0), cB + kstep, voffB); PG8_STAGE(PG8_SA(1, 0), cA + kstep, voffA); PG8_STAGE(PG8_SB(1, 1), cB + hstepB + kstep, voffB);
    PG8_WAIT_V(6); PG8_BAR;
    for (;;) {
        const bool has_next = S.next(ui + 1, nxt);
        const char* nA = has_next ? (const char*)(g.A + MP.a_off(nxt)) : cA; const char* nB = has_next ? (const char*)(g.Bt + MP.b_off(nxt)) : cB;
        for (int t = 0; t < nt; t += 2) {
            const bool last = (t == nt - 2);
            const char* a1 = cA + (size_t)(t + 1) * kstep;
            const char* a2 = last ? nA : cA + (size_t)(t + 2) * kstep; const char* b2 = last ? nB : cB + (size_t)(t + 2) * kstep;
            const char* a3 = a2 + kstep; const char* b3 = b2 + kstep;
            PG8_LDB(B0, 0, 0); PG8_LDB(B1, 0, 1); PG8_SCHED; PG8_LDA(At, 0, 0); PG8_STAGE(PG8_SA(1, 1), a1 + hstepA, voffA);
            PG8_WAIT_V(8); PG8_WAIT_L(0); PG8_BAR; PG8_MMA(0, 0, At, B0); PG8_MMA(0, 1, At, B1); PG8_BAR; PG8_SCHED;
            PG8_LDA(At, 0, 1); PG8_STAGE(PG8_SB(0, 0), b2, voffB); PG8_STAGE(PG8_SB(0, 1), b2 + hstepB, voffB); PG8_STAGE(PG8_SA(0, 0), a2, voffA);
            PG8_WAIT_V(8); PG8_WAIT_L(0); PG8_BAR; PG8_MMA(1, 0, At, B0); PG8_MMA(1, 1, At, B1); PG8_BAR; PG8_SCHED;
            PG8_LDB(B0, 1, 0); PG8_LDB(B1, 1, 1); PG8_SCHED; PG8_LDA(At, 1, 0); PG8_STAGE(PG8_SA(0, 1), a2 + hstepA, voffA);
            PG8_WAIT_V(8); PG8_WAIT_L(0); PG8_BAR; PG8_MMA(0, 0, At, B0); PG8_MMA(0, 1, At, B1); PG8_BAR; PG8_SCHED;
            PG8_LDA(At, 1, 1); PG8_STAGE(PG8_SB(1, 0), b3, voffB); PG8_STAGE(PG8_SB(1, 1), b3 + hstepB, voffB); PG8_STAGE(PG8_SA(1, 0), a3, voffA);
            PG8_WAIT_V(8); PG8_WAIT_L(0); PG8_BAR; PG8_MMA(1, 0, At, B0); PG8_MMA(1, 1, At, B1); PG8_BAR; PG8_SCHED;
        }
        if (wr == 0) PG8_BAR;
        E(acc, cur, wr, wc, fr, fq);
        if (!has_next) break;
#pragma unroll
        for (int a = 0; a < 2; ++a)
#pragma unroll
            for (int b = 0; b < 2; ++b)
#pragma unroll
                for (int m = 0; m < 4; ++m)
#pragma unroll
                    for (int n = 0; n < 2; ++n) acc[a][b][m][n] = (f32x4){0.f, 0.f, 0.f, 0.f};
        cur = nxt; cA = nA; cB = nB; ++ui;
        if (wr == 1) PG8_BAR;
    }
    PG8_WAIT_V(0);
    PG8_BAR;
#undef PG8_SA
#undef PG8_SB
#undef PG8_STAGE
#undef PG8_LDA
#undef PG8_LDB
#undef PG8_MMA
#undef PG8_WAIT_V
#undef PG8_WAIT_L
#undef PG8_BAR
#undef PG8_SCHED
}

template <int ldc, int tiles_per_dst, int silu_dst> struct EpiSplit {
    static constexpr bool PERM = true;
    bf16_t *d0, *d1, *d2, *d3;
    __device__ __forceinline__ void operator()(const f32x4 (&acc)[2][2][4][2], const Unit& u, int wr, int wc, int fr, int fq) const {
        const int di = u.pn / tiles_per_dst, ct = u.pn - di * tiles_per_dst;
        bf16_t* base = di == 0 ? d0 : di == 1 ? d1 : di == 2 ? d2 : d3; const bool act = (di == silu_dst);
        const int row0 = u.pm * BM + wr * 64 + fr, col0 = ct * BM + wc * 32 + 8 * fq;
#pragma unroll
        for (int ai = 0; ai < 2; ++ai)
#pragma unroll
            for (int m = 0; m < 4; ++m) { bf16_t* rowp = base + (size_t)(row0 + ai * HALF + m * 16) * ldc + col0;
#pragma unroll
                for (int bj = 0; bj < 2; ++bj) { f32x4 v0 = acc[ai][bj][m][0], v1 = acc[ai][bj][m][1];
                    if (act) { v0 = (f32x4){silu_f(v0[0]), silu_f(v0[1]), silu_f(v0[2]), silu_f(v0[3])}; v1 = (f32x4){silu_f(v1[0]), silu_f(v1[1]), silu_f(v1[2]), silu_f(v1[3])}; }
                    u32x4 w; w.x = cvt_pk_bf16(v0[0], v0[1]); w.y = cvt_pk_bf16(v0[2], v0[3]); w.z = cvt_pk_bf16(v1[0], v1[1]); w.w = cvt_pk_bf16(v1[2], v1[3]);
                    *(u32x4*)(rowp + bj * HALF) = w; } }
    }
};
struct EpiGate {
    static constexpr bool PERM = true; static constexpr int ldc = DI;
    bf16_t* Y; const bf16_t* SZ; const float* scale;
    __device__ __forceinline__ void operator()(const f32x4 (&acc)[2][2][4][2], const Unit& u, int wr, int wc, int fr, int fq) const {
        const int row0 = u.pm * BM + wr * 64 + fr, col0 = u.pn * BM + wc * 32 + 8 * fq;
        f32x4 sc[2][2];
#pragma unroll
        for (int bj = 0; bj < 2; ++bj) { sc[bj][0] = *(const f32x4*)(scale + col0 + bj * HALF); sc[bj][1] = *(const f32x4*)(scale + col0 + bj * HALF + 4); }
#pragma unroll
        for (int ai = 0; ai < 2; ++ai)
#pragma unroll
            for (int m = 0; m < 4; ++m) { const size_t off = (size_t)(row0 + ai * HALF + m * 16) * ldc + col0;
#pragma unroll
                for (int bj = 0; bj < 2; ++bj) { const u32x4 z = *(const u32x4*)(SZ + off + bj * HALF);
                    const f32x4 v0 = acc[ai][bj][m][0] * sc[bj][0], v1 = acc[ai][bj][m][1] * sc[bj][1];
                    u32x4 w; w.x = cvt_pk_bf16(v0[0] * bf_lo(z.x), v0[1] * bf_hi(z.x)); w.y = cvt_pk_bf16(v0[2] * bf_lo(z.y), v0[3] * bf_hi(z.y));
                    w.z = cvt_pk_bf16(v1[0] * bf_lo(z.z), v1[1] * bf_hi(z.z)); w.w = cvt_pk_bf16(v1[2] * bf_lo(z.w), v1[3] * bf_hi(z.w));
                    *(u32x4*)(Y + off + bj * HALF) = w; } }
    }
};
struct EpiRes {
    static constexpr bool PERM = false; static constexpr int ldc = D;
    const float* base; float* out;
    __device__ __forceinline__ void operator()(const f32x4 (&acc)[2][2][4][2], const Unit& u, int wr, int wc, int fr, int fq) const {
        const int row0 = u.pm * BM + wr * 64 + fr, col0 = u.pn * BM + wc * 32 + 4 * fq;
#pragma unroll
        for (int ai = 0; ai < 2; ++ai)
#pragma unroll
            for (int m = 0; m < 4; ++m) { const size_t off = (size_t)(row0 + ai * HALF + m * 16) * ldc + col0;
#pragma unroll
                for (int bj = 0; bj < 2; ++bj)
#pragma unroll
                    for (int n = 0; n < 2; ++n) { const f32x4 b = *(const f32x4*)(base + off + bj * HALF + n * 16); *(f32x4*)(out + off + bj * HALF + n * 16) = b + acc[ai][bj][m][n]; } }
    }
};
template <int lda, int ldb> struct MapPlain { __device__ __forceinline__ size_t a_off(const Unit& u) const { return (size_t)u.pm * BM * lda; } __device__ __forceinline__ size_t b_off(const Unit& u) const { return (size_t)u.pn * BM * ldb; } };
struct MapPool { __device__ __forceinline__ size_t a_off(const Unit& u) const { return (size_t)u.pm * BM * DI + (size_t)(u.pn >> 1) * 512; } __device__ __forceinline__ size_t b_off(const Unit& u) const { return (size_t)u.pn * BM * 512; } };
struct MapQkvz { int g; __device__ __forceinline__ size_t a_off(const Unit& u) const { return (size_t)u.pm * BM * D; } __device__ __forceinline__ size_t b_off(const Unit& u) const { return (size_t)((u.pn >> 1) * DI + g * GW + (u.pn & 1) * BM) * D; } };
}

#define XB_TMO      128
#define XB_XCNT(j)  (256  + 64 * (j))
#define XB_XSUB(j)  (1280 + 64 * (j))
#define XB_XGEN(j)  (2304 + 64 * (j))
#define XB_TOP      3328
#define XB_TOPGEN   3392
#define XCD_BAR_WORDS 3456
#define XB_SPIN_CAP (1u << 18)
__device__ __forceinline__ unsigned xb_ld(unsigned* p)              { return __hip_atomic_load(p, __ATOMIC_RELAXED, __HIP_MEMORY_SCOPE_AGENT); }
__device__ __forceinline__ unsigned xb_add(unsigned* p, unsigned v) { return __hip_atomic_fetch_add(p, v, __ATOMIC_RELAXED, __HIP_MEMORY_SCOPE_AGENT); }
__device__ __forceinline__ unsigned xb_xcc_id() { return (unsigned)__builtin_amdgcn_s_getreg((3 << 11) | 20) & 0xFu; }
#define XB_SPIN(cond, bar) do { unsigned _sp = 0; while (cond) { __builtin_amdgcn_s_sleep(1); \
    if ((++_sp & 255u) == 0u) { if (xb_ld(&(bar)[XB_TMO])) break; if (_sp > XB_SPIN_CAP) { atomicAdd(&(bar)[XB_TMO], 1u); break; } } } } while (0)
struct XcdBarrier { unsigned* bar; unsigned x; volatile LAS unsigned* st; };
__device__ __forceinline__ XcdBarrier xcd_barrier_post(unsigned* bar, volatile LAS unsigned* st) {
    XcdBarrier b; b.bar = bar; b.x = xb_xcc_id(); b.st = st;
    if (threadIdx.x == 0) (void)xb_add(&bar[XB_XCNT(b.x)], 1u);
    return b;
}
__device__ __forceinline__ void xcd_barrier_complete(unsigned* bar, unsigned x, unsigned& nloc, unsigned& nx) {
    const unsigned G = gridDim.x * gridDim.y * gridDim.z;
    unsigned sum, cnt, mine, sp = 0u;
    for (;;) {
        sum = 0u; cnt = 0u; mine = 0u;
#pragma unroll
        for (unsigned j = 0; j < 16; ++j) { const unsigned c = xb_ld(&bar[XB_XCNT(j)]); sum += c; cnt += (c > 0u) ? 1u : 0u; mine = (j == x) ? c : mine; }
        if (sum == G) break;
        __builtin_amdgcn_s_sleep(1);
        if ((++sp & 255u) == 0u) { if (xb_ld(&bar[XB_TMO])) break; if (sp > XB_SPIN_CAP) { atomicAdd(&bar[XB_TMO], 1u); break; } }
    }
    nloc = mine > 0u ? mine : 1u; nx = cnt > 0u ? cnt : 1u;
}
__device__ __forceinline__ void xcd_barrier(const XcdBarrier& b) {
    asm volatile("s_waitcnt vmcnt(0)" ::: "memory");
    __syncthreads();
    if (threadIdx.x == 0) {
        unsigned* bar = b.bar;
        __builtin_amdgcn_s_waitcnt(0);
        unsigned nloc = b.st[0], nx = b.st[1];
        if (nloc == 0u) { xcd_barrier_complete(bar, b.x, nloc, nx); b.st[0] = nloc; b.st[1] = nx; }
        const unsigned old = xb_add(&bar[XB_XSUB(b.x)], 1u);
        const unsigned gen = old / nloc;
        if (old + 1u == (gen + 1u) * nloc) {
            __builtin_amdgcn_fence(__ATOMIC_RELEASE, "agent");
            asm volatile("s_waitcnt vmcnt(0)" ::: "memory");
            const unsigned og = xb_add(&bar[XB_TOP], 1u);
            const unsigned tg = og / nx;
            if (og + 1u == (tg + 1u) * nx) xb_add(&bar[XB_TOPGEN], 1u);
            else XB_SPIN(xb_ld(&bar[XB_TOPGEN]) == tg, bar);
            __builtin_amdgcn_fence(__ATOMIC_ACQUIRE, "agent");
            xb_add(&bar[XB_XGEN(b.x)], 1u);
            asm volatile("s_waitcnt vmcnt(0)" ::: "memory");
        } else {
            XB_SPIN(xb_ld(&bar[XB_XGEN(b.x)]) == gen, bar);
            __builtin_amdgcn_fence(__ATOMIC_ACQUIRE, "agent");
            asm volatile("s_waitcnt vmcnt(0)" ::: "memory");
        }
    }
    __syncthreads();
}

struct Args { const float* in[11]; float* out; unsigned char* ws; int ph_lo, ph_hi, coop, pad; };

__device__ __forceinline__ void transpose_item(const float* W, int K, int N, bf16_t* WT, LAS float* scr, int item, int lane) {
    const int nblk = N / 32, kb = item / nblk, nb = item % nblk, k0 = 64 * kb, n0 = 32 * nb;
#pragma unroll 8
    for (int i = 0; i < 32; ++i) { const int kk = 2 * i + (lane >> 5); scr[kk * 33 + (lane & 31)] = W[(size_t)(k0 + kk) * N + n0 + (lane & 31)]; }
    asm volatile("s_waitcnt lgkmcnt(0)" ::: "memory");
    const int c = lane & 7;
#pragma unroll
    for (int j = 0; j < 4; ++j) { const int n = (lane >> 3) + 8 * j; const LAS float* s = scr + (8 * c) * 33 + n;
        u32x4 o; o.x = cvt_pk_bf16(s[0 * 33], s[1 * 33]); o.y = cvt_pk_bf16(s[2 * 33], s[3 * 33]); o.z = cvt_pk_bf16(s[4 * 33], s[5 * 33]); o.w = cvt_pk_bf16(s[6 * 33], s[7 * 33]);
        *(u32x4*)(WT + (size_t)(n0 + n) * K + k0 + 8 * c) = o; }
    asm volatile("s_waitcnt lgkmcnt(0)" ::: "memory");
}
__device__ __forceinline__ void rms_row(const float* xrow, const float* gain, bf16_t* orow, int lane) {
    const f32x4* xr = (const f32x4*)xrow + lane; const f32x4* gr = (const f32x4*)gain + lane;
    f32x4 v[4]; float s = 0.f;
#pragma unroll
    for (int j = 0; j < 4; ++j) { v[j] = xr[64 * j]; s += (v[j].x * v[j].x + v[j].y * v[j].y) + (v[j].z * v[j].z + v[j].w * v[j].w); }
    const float rstd = 1.0f / sqrtf(wave_sum(s) * (1.f / D) + EPS);
    u32x2* o8 = (u32x2*)orow + lane;
#pragma unroll
    for (int j = 0; j < 4; ++j) { const f32x4 gg = gr[64 * j]; u32x2 w; w.x = cvt_pk_bf16(v[j].x * rstd * gg.x, v[j].y * rstd * gg.y); w.y = cvt_pk_bf16(v[j].z * rstd * gg.z, v[j].w * rstd * gg.w); o8[64 * j] = w; }
}
__device__ __forceinline__ void rope_entry(int idx, f32x2* tab) {
    const int pos = idx >> 6, i = idx & 63;
    const float inv = (float)exp2(-(double)(2 * i) * (13.287712379549449 / 128.0));
    const float angf = (float)pos * inv;
    const double a = (double)angf; const double q = rint(a * 0.6366197723675814); const double r = a - q * 1.5707963267948966;
    const double r2 = r * r;
    double sn = r * (1.0 - r2 / 6.0 * (1.0 - r2 / 20.0 * (1.0 - r2 / 42.0 * (1.0 - r2 / 72.0 * (1.0 - r2 / 110.0 * (1.0 - r2 / 156.0))))));
    double cs = 1.0 - r2 / 2.0 * (1.0 - r2 / 12.0 * (1.0 - r2 / 30.0 * (1.0 - r2 / 56.0 * (1.0 - r2 / 90.0 * (1.0 - r2 / 132.0)))));
    const int qi = ((int)q) & 3;
    double c2, s2;
    if (qi == 0) { c2 = cs; s2 = sn; } else if (qi == 1) { c2 = -sn; s2 = cs; } else if (qi == 2) { c2 = -cs; s2 = -sn; } else { c2 = sn; s2 = -cs; }
    tab[idx] = (f32x2){(float)c2, (float)s2};
}

__global__ void __launch_bounds__(NTHREADS, 2) mega_fwd(Args args) {
    extern __shared__ __attribute__((aligned(16))) unsigned char lds_raw[];
    LAS unsigned char* lds = (LAS unsigned char*)lds_raw;
    cg::grid_group grid = cg::this_grid();
    const int G = gridDim.x, bx = blockIdx.x;
    volatile LAS unsigned* bst = (volatile LAS unsigned*)(lds + LDS_BYTES - 16);
    if (threadIdx.x < 4) bst[threadIdx.x] = 0u;
    __syncthreads();
    XcdBarrier xbar; xbar.bar = (unsigned*)(args.ws + WS_BAR); xbar.x = 0; xbar.st = bst;
    if (args.coop) xbar = xcd_barrier_post((unsigned*)(args.ws + WS_BAR), bst);
    unsigned char* ws = args.ws;
#define XIN (args.in[0])
#define norm0 (args.in[1])
#define w_in0 (args.in[2])
#define w_pool0 (args.in[3])
#define pool_scale0 (args.in[4])
#define w_out0 (args.in[5])
#define norm1 (args.in[6])
#define w_in1 (args.in[7])
#define q_norm1 (args.in[8])
#define k_norm1 (args.in[9])
#define w_out1 (args.in[10])
    float* out = args.out;
#define WIN0 ((bf16_t*)(ws + WS_WIN0))
#define WP ((bf16_t*)(ws + WS_WP))
#define WOUT0 ((bf16_t*)(ws + WS_WOUT0))
#define WIN1 ((bf16_t*)(ws + WS_WIN1))
#define WOUT1 ((bf16_t*)(ws + WS_WOUT1))
#define H0 ((bf16_t*)(ws + WS_H0))
#define POOLED ((bf16_t*)(ws + WS_POOLED))
#define U ((bf16_t*)(ws + WS_U))
#define SZ0 ((bf16_t*)(ws + WS_SZ0))
#define H1 ((bf16_t*)(ws + WS_H1))
#define QG ((bf16_t*)(ws + WS_QG))
#define KG ((bf16_t*)(ws + WS_KG))
#define VG ((bf16_t*)(ws + WS_VG))
#define SZG ((bf16_t*)(ws + WS_SZG))
#define OPART ((bf16_t*)(ws + WS_OPART))
#define AT ((bf16_t*)(ws + WS_A))
#define KMEAN ((float*)(ws + WS_KMEAN))
#define SEL ((unsigned*)(ws + WS_SEL))
#define LPART ((float*)(ws + WS_LPART))
#define TAB ((f32x2*)(ws + WS_TAB))
#define LIST ((unsigned short*)(ws + WS_LIST))
#define CNT ((unsigned*)(ws + WS_CTL))
    const int lo = args.ph_lo, hi = args.ph_hi;
#define IN(k) (lo <= (k) && (k) < hi)
#define SYNC(k) do { if (IN(k) && IN((k) + 1) && args.coop) { if ((k) == 0) grid.sync(); else xcd_barrier(xbar); } } while (0)
    {
        if (IN(0) && (PH_MASK & 1)) {
            int tid = threadIdx.x; asm volatile("" : "+v"(tid)); const int lane = tid & 63, wave = __builtin_amdgcn_readfirstlane(tid >> 6); (void)lane; (void)wave;
            LAS float* scr = (LAS float*)(lds + wave * 16384);
            const int gw = bx * 8 + wave, NGW = G * 8;
            constexpr int I0 = (D / 64) * (2 * DI / 32), IP = (512 / 64) * (512 / 32), I1 = (DI / 64) * (D / 32), I2 = (D / 64) * (4 * DI / 32), I3 = I1;
            constexpr int NITEMS = I0 + 4 * IP + I1 + I2 + I3;
            for (int it = gw; it < NITEMS; it += NGW) {
                int r = it;
                if (r < I0) { transpose_item(w_in0, D, 2 * DI, WIN0, scr, r, lane); continue; } r -= I0;
                if (r < 4 * IP) { const int gp = r / IP; transpose_item(w_pool0 + (size_t)gp * 512 * 512, 512, 512, WP + (size_t)gp * 512 * 512, scr, r - gp * IP, lane); continue; } r -= 4 * IP;
                if (r < I1) { transpose_item(w_out0, DI, D, WOUT0, scr, r, lane); continue; } r -= I1;
                if (r < I2) { transpose_item(w_in1, D, 4 * DI, WIN1, scr, r, lane); continue; } r -= I2;
                transpose_item(w_out1, DI, D, WOUT1, scr, r, lane);
            }
            for (int idx = bx * NTHREADS + tid; idx < SEQ * 64; idx += G * NTHREADS) rope_entry(idx, TAB);
            for (int m = gw; m < M; m += NGW) rms_row(XIN + (size_t)m * D, norm0, H0 + (size_t)m * D, lane);
        }
        SYNC(0);
        if (IN(1) && (PH_MASK & 2)) {
            int tid = threadIdx.x; asm volatile("" : "+v"(tid)); const int lane = tid & 63, wave = __builtin_amdgcn_readfirstlane(tid >> 6); (void)lane; (void)wave;
            pg8::Gemm<D, D, D> g{H0, WIN0}; pg8::StaticOrder S; S.init(M, 2 * DI, G, bx);
            pg8::EpiSplit<DI, 8, 1> E{U, SZ0, U, U}; pg8::MapPlain<D, D> MP;
            pg8::gemm_phase(lds, g, S, MP, E);
        }
        SYNC(1);
        if (IN(2) && (PH_MASK & 4)) {
            int tid = threadIdx.x; asm volatile("" : "+v"(tid)); const int lane = tid & 63, wave = __builtin_amdgcn_readfirstlane(tid >> 6); (void)lane; (void)wave;
            const int cgp = tid & 255, hh = tid >> 8, col = cgp * 8, w = 2 << (cgp >> 6);
            for (int unit = bx; unit < M / 64; unit += G) {
                const int r0 = unit * 64 + hh * 32, p0 = r0 & (SEQ - 1);
                float sum[8];
#pragma unroll
                for (int e = 0; e < 8; ++e) sum[e] = 0.f;
                for (int i = 1; i < w; ++i) { if (p0 - i >= 0) { const u32x4 v = *(const u32x4*)(U + (size_t)(r0 - i) * DI + col);
                    sum[0] += bf_lo(v.x); sum[1] += bf_hi(v.x); sum[2] += bf_lo(v.y); sum[3] += bf_hi(v.y); sum[4] += bf_lo(v.z); sum[5] += bf_hi(v.z); sum[6] += bf_lo(v.w); sum[7] += bf_hi(v.w); } }
                for (int t = 0; t < 32; ++t) {
                    const int p = p0 + t; const u32x4 v = *(const u32x4*)(U + (size_t)(r0 + t) * DI + col);
                    float c[8] = {bf_lo(v.x), bf_hi(v.x), bf_lo(v.y), bf_hi(v.y), bf_lo(v.z), bf_hi(v.z), bf_lo(v.w), bf_hi(v.w)};
                    const float rc = 1.0f / (float)((p + 1) < w ? (p + 1) : w);
                    float o[8];
#pragma unroll
                    for (int e = 0; e < 8; ++e) { sum[e] += c[e]; o[e] = sum[e] * rc - c[e]; }
                    u32x4 wv; wv.x = cvt_pk_bf16(o[0], o[1]); wv.y = cvt_pk_bf16(o[2], o[3]); wv.z = cvt_pk_bf16(o[4], o[5]); wv.w = cvt_pk_bf16(o[6], o[7]);
                    *(u32x4*)(POOLED + (size_t)(r0 + t) * DI + col) = wv;
                    if (p - w + 1 >= 0) { const u32x4 q = *(const u32x4*)(U + (size_t)(r0 + t - w + 1) * DI + col);
                        sum[0] -= bf_lo(q.x); sum[1] -= bf_hi(q.x); sum[2] -= bf_lo(q.y); sum[3] -= bf_hi(q.y); sum[4] -= bf_lo(q.z); sum[5] -= bf_hi(q.z); sum[6] -= bf_lo(q.w); sum[7] -= bf_hi(q.w); }
                }
            }
        }
        SYNC(2);
        if (IN(3) && (PH_MASK & 8)) {
            int tid = threadIdx.x; asm volatile("" : "+v"(tid)); const int lane = tid & 63, wave = __builtin_amdgcn_readfirstlane(tid >> 6); (void)lane; (void)wave;
            pg8::Gemm<DI, 512, 512> g{POOLED, WP}; pg8::StaticOrder S; S.init(M, DI, G, bx);
            pg8::EpiGate E{U, SZ0, pool_scale0}; pg8::MapPool MP;
            pg8::gemm_phase(lds, g, S, MP, E);
        }
        SYNC(3);
        if (IN(4) && (PH_MASK & 16)) {
            int tid = threadIdx.x; asm volatile("" : "+v"(tid)); const int lane = tid & 63, wave = __builtin_amdgcn_readfirstlane(tid >> 6); (void)lane; (void)wave;
            pg8::Gemm<DI, DI, DI> g{U, WOUT0}; pg8::StaticOrder S; S.init(M, D, G, bx);
            pg8::EpiRes E{XIN, out}; pg8::MapPlain<DI, DI> MP;
            pg8::gemm_phase(lds, g, S, MP, E);
        }
        SYNC(4);
        if (IN(5) && (PH_MASK & 32)) {
            int tid = threadIdx.x; asm volatile("" : "+v"(tid)); const int lane = tid & 63, wave = __builtin_amdgcn_readfirstlane(tid >> 6); (void)lane; (void)wave;
            const int gw = bx * 8 + wave, NGW = G * 8;
            for (int m = gw; m < M; m += NGW) rms_row(out + (size_t)m * D, norm1, H1 + (size_t)m * D, lane);
        }
        SYNC(5);
#pragma unroll
        for (int g = 0; g < NG; ++g) {
            const int pb = 6 + 5 * g;
            if (IN(pb) && (PH_MASK & 64)) {
            int tid = threadIdx.x; asm volatile("" : "+v"(tid)); const int lane = tid & 63, wave = __builtin_amdgcn_readfirstlane(tid >> 6); (void)lane; (void)wave;
                pg8::Gemm<D, D, D> gm{H1, WIN1}; pg8::StaticOrder S; S.init(M, 4 * GW, G, bx);
                pg8::EpiSplit<GW, 2, 3> E{QG, KG, VG, SZG}; pg8::MapQkvz MP{g};
                pg8::gemm_phase(lds, gm, S, MP, E);
            }
            SYNC(pb);
            if (IN(pb + 1) && (PH_MASK & 128)) {
            int tid = threadIdx.x; asm volatile("" : "+v"(tid)); const int lane = tid & 63, wave = __builtin_amdgcn_readfirstlane(tid >> 6); (void)lane; (void)wave;
                LAS float* wsum = (LAS float*)lds;
                const int j8 = (lane & 7) * 8, rsub = lane >> 3;
                f32x4 gq[4], gk[4];
                gq[0] = *(const f32x4*)(q_norm1 + j8); gq[1] = *(const f32x4*)(q_norm1 + j8 + 4); gq[2] = *(const f32x4*)(q_norm1 + 64 + j8); gq[3] = *(const f32x4*)(q_norm1 + 68 + j8);
                gk[0] = *(const f32x4*)(k_norm1 + j8); gk[1] = *(const f32x4*)(k_norm1 + j8 + 4); gk[2] = *(const f32x4*)(k_norm1 + 64 + j8); gk[3] = *(const f32x4*)(k_norm1 + 68 + j8);
#pragma unroll 1
                for (int unit = bx; unit < 8 * NB; unit += G) {
                    const int bh = unit >> 5, n = unit & 31, b = bh >> 2, hl = bh & 3;
                    float ks[16];
#pragma unroll
                    for (int e = 0; e < 16; ++e) ks[e] = 0.f;
#pragma unroll 1
                    for (int hb = 0; hb < 2; ++hb) {
                    u32x4 ka[2], kc[2], qa[2], qc[2]; f32x4 tb[2][4];
#pragma unroll
                    for (int it = 0; it < 2; ++it) {
                        const int pos = n * BLK + wave * 32 + (hb * 2 + it) * 8 + rsub;
                        const size_t off = (size_t)(b * SEQ + pos) * GW + hl * HD + j8;
                        ka[it] = *(const u32x4*)(KG + off); kc[it] = *(const u32x4*)(KG + off + 64);
                        qa[it] = *(const u32x4*)(QG + off); qc[it] = *(const u32x4*)(QG + off + 64);
                        const f32x4* tp = (const f32x4*)(TAB + pos * 64 + j8);
                        tb[it][0] = tp[0]; tb[it][1] = tp[1]; tb[it][2] = tp[2]; tb[it][3] = tp[3];
                    }
#pragma unroll
                    for (int it = 0; it < 2; ++it) {
                        const int pos = n * BLK + wave * 32 + (hb * 2 + it) * 8 + rsub;
                        const size_t off = (size_t)(b * SEQ + pos) * GW + hl * HD + j8;
                        float cs[8], sn[8];
#pragma unroll
                        for (int e = 0; e < 4; ++e) { cs[2 * e] = tb[it][e].x; sn[2 * e] = tb[it][e].y; cs[2 * e + 1] = tb[it][e].z; sn[2 * e + 1] = tb[it][e].w; }
#pragma unroll
                        for (int which = 0; which < 2; ++which) {
                            const u32x4 va = which == 0 ? ka[it] : qa[it], vc = which == 0 ? kc[it] : qc[it];
                            float x1[8] = {bf_lo(va.x), bf_hi(va.x), bf_lo(va.y), bf_hi(va.y), bf_lo(va.z), bf_hi(va.z), bf_lo(va.w), bf_hi(va.w)};
                            float x2[8] = {bf_lo(vc.x), bf_hi(vc.x), bf_lo(vc.y), bf_hi(vc.y), bf_lo(vc.z), bf_hi(vc.z), bf_lo(vc.w), bf_hi(vc.w)};
                            float ss = 0.f;
#pragma unroll
                            for (int e = 0; e < 8; ++e) ss += x1[e] * x1[e] + x2[e] * x2[e];
                            ss += __shfl_xor(ss, 1); ss += __shfl_xor(ss, 2); ss += __shfl_xor(ss, 4);
                            const float rstd = (which == 0 ? 1.0f : QSCALE) / sqrtf(ss * (1.f / HD) + EPS);
                            float o1[8], o2[8];
#pragma unroll
                            for (int e = 0; e < 8; ++e) {
                                const float g1 = which == 0 ? gk[e >> 2][e & 3] : gq[e >> 2][e & 3], g2 = which == 0 ? gk[2 + (e >> 2)][e & 3] : gq[2 + (e >> 2)][e & 3];
                                const float y1 = x1[e] * rstd * g1, y2 = x2[e] * rstd * g2;
                                o1[e] = y1 * cs[e] - y2 * sn[e]; o2[e] = y2 * cs[e] + y1 * sn[e];
                                if (which == 0) { ks[e] += o1[e]; ks[8 + e] += o2[e]; }
                            }
                            u32x4 w1, w2;
                            w1.x = cvt_pk_bf16(o1[0], o1[1]); w1.y = cvt_pk_bf16(o1[2], o1[3]); w1.z = cvt_pk_bf16(o1[4], o1[5]); w1.w = cvt_pk_bf16(o1[6], o1[7]);
                            w2.x = cvt_pk_bf16(o2[0], o2[1]); w2.y = cvt_pk_bf16(o2[2], o2[3]); w2.z = cvt_pk_bf16(o2[4], o2[5]); w2.w = cvt_pk_bf16(o2[6], o2[7]);
                            bf16_t* dstp = which == 0 ? KG : QG;
                            *(u32x4*)(dstp + off) = w1; *(u32x4*)(dstp + off + 64) = w2;
                        }
                    }
                    }
#pragma unroll
                    for (int e = 0; e < 16; ++e) { float v = ks[e]; v += __shfl_xor(v, 8); v += __shfl_xor(v, 16); v += __shfl_xor(v, 32); ks[e] = v; }
                    if (lane < 8) {
#pragma unroll
                        for (int e = 0; e < 8; ++e) { wsum[wave * 128 + j8 + e] = ks[e]; wsum[wave * 128 + 64 + j8 + e] = ks[8 + e]; }
                    }
                    __syncthreads();
                    if (tid < 128) { float sv = 0.f;
#pragma unroll
                        for (int w8 = 0; w8 < 8; ++w8) sv += wsum[w8 * 128 + tid];
                        KMEAN[((size_t)(g * 8 + bh) * NB + n) * HD + tid] = sv * (1.f / BLK); }
                    __syncthreads();
                }
            }
            SYNC(pb + 1);
            if (IN(pb + 2) && (PH_MASK & 256)) {
            int tid = threadIdx.x; asm volatile("" : "+v"(tid)); const int lane = tid & 63, wave = __builtin_amdgcn_readfirstlane(tid >> 6); (void)lane; (void)wave;
                LAS float* km = (LAS float*)lds;
                LAS float* mv = (LAS float*)(lds + 16384);
                LAS int* mi = (LAS int*)(lds + 16384 + 3072);
                LAS unsigned* lcnt = (LAS unsigned*)(lds + 16384 + 6144);
                LAS unsigned* lbase = lcnt + 32;
                if (tid < 32) lcnt[tid] = 0u;
                __syncthreads();
#pragma unroll 1
                for (int unit = bx; unit < 8 * NB; unit += G) {
                    const int bh = unit >> 5, qb = unit & 31, b = bh >> 2, hl = bh & 3;
                    const int qi = tid & 255, hf = tid >> 8;
                    const int s = qb * BLK + qi; const size_t mrow = (size_t)b * SEQ + s;
                    if (qb > 0) {
                        u32x4 qv[16];
#pragma unroll
                        for (int c = 0; c < 16; ++c) qv[c] = *(const u32x4*)(QG + mrow * GW + hl * HD + c * 8);
                        for (int c = tid; c < qb * 32; c += NTHREADS) *(LAS f32x4*)(km + c * 4) = *(const f32x4*)(KMEAN + (size_t)(g * 8 + bh) * NB * HD + c * 4);
                        __syncthreads();
                        float v0 = -INFINITY, v1 = -INFINITY, v2 = -INFINITY; int i0 = 255, i1 = 255, i2 = 255;
#pragma unroll 1
                        for (int n = hf; n < qb; n += 2) {
                            float acc = 0.f;
#pragma unroll
                            for (int c = 0; c < 16; ++c) { const f32x4 ka = *(const LAS f32x4*)(km + n * 128 + c * 8), kb = *(const LAS f32x4*)(km + n * 128 + c * 8 + 4);
                                acc += bf_lo(qv[c].x) * ka.x + bf_hi(qv[c].x) * ka.y + bf_lo(qv[c].y) * ka.z + bf_hi(qv[c].y) * ka.w + bf_lo(qv[c].z) * kb.x + bf_hi(qv[c].z) * kb.y + bf_lo(qv[c].w) * kb.z + bf_hi(qv[c].w) * kb.w; }
                            if (acc > v0) { v2 = v1; i2 = i1; v1 = v0; i1 = i0; v0 = acc; i0 = n; }
                            else if (acc > v1) { v2 = v1; i2 = i1; v1 = acc; i1 = n; }
                            else if (acc > v2) { v2 = acc; i2 = n; }
                        }
                        if (hf == 1) { mv[qi * 3] = v0; mv[qi * 3 + 1] = v1; mv[qi * 3 + 2] = v2; mi[qi * 3] = i0; mi[qi * 3 + 1] = i1; mi[qi * 3 + 2] = i2; }
                        __syncthreads();
                        unsigned rk0 = 0, rk1 = 0, rk2 = 0;
                        if (hf == 0) {
#pragma unroll
                            for (int e = 0; e < 3; ++e) { const float acc = mv[qi * 3 + e]; const int n = mi[qi * 3 + e];
                                if (n < 255) {
                                    const bool g0 = acc > v0 || (acc == v0 && n < i0), g1 = acc > v1 || (acc == v1 && n < i1), g2 = acc > v2 || (acc == v2 && n < i2);
                                    if (g0) { v2 = v1; i2 = i1; v1 = v0; i1 = i0; v0 = acc; i0 = n; }
                                    else if (g1) { v2 = v1; i2 = i1; v1 = acc; i1 = n; }
                                    else if (g2) { v2 = acc; i2 = n; }
                                } }
                            SEL[mrow * NH + g * HG + hl] = (unsigned)i0 | ((unsigned)i1 << 8) | ((unsigned)i2 << 16);
                            if (i0 < 255) rk0 = atomicAdd((unsigned*)&lcnt[i0], 1u);
                            if (i1 < 255) rk1 = atomicAdd((unsigned*)&lcnt[i1], 1u);
                            if (i2 < 255) rk2 = atomicAdd((unsigned*)&lcnt[i2], 1u);
                        }
                        __syncthreads();
                        if (tid < 32) { const unsigned c = lcnt[tid]; lbase[tid] = c ? atomicAdd(&CNT[g * 256 + bh * NB + tid], c) : 0u; lcnt[tid] = 0u; }
                        __syncthreads();
                        if (hf == 0) {
                            if (i0 < 255) LIST[(size_t)(bh * NB + i0) * SEQ + lbase[i0] + rk0] = (unsigned short)(s | (0 << 13));
                            if (i1 < 255) LIST[(size_t)(bh * NB + i1) * SEQ + lbase[i1] + rk1] = (unsigned short)(s | (1 << 13));
                            if (i2 < 255) LIST[(size_t)(bh * NB + i2) * SEQ + lbase[i2] + rk2] = (unsigned short)(s | (2 << 13));
                        }
                        __syncthreads();
                    } else if (hf == 0) {
                        SEL[mrow * NH + g * HG + hl] = 0x00ffffffu;
                    }
                }
            }
            SYNC(pb + 2);
            if (IN(pb + 3) && (PH_MASK & 512)) {
            int tid = threadIdx.x; asm volatile("" : "+v"(tid)); const int lane = tid & 63, wave = __builtin_amdgcn_readfirstlane(tid >> 6); (void)lane; (void)wave;
                LAS unsigned char* Ks = lds;
                LAS unsigned char* Vt = lds + 256 * 272;
                LAS int* pre = (LAS int*)(lds + 256 * 272 + 128 * 528);
                LAS float* red = (LAS float*)(lds + 256 * 272 + 128 * 528 + 2048);
                {
                    float mq = 0.f, mk = 0.f;
                    if (tid < 128) { mq = fabsf(q_norm1[tid]); mk = fabsf(k_norm1[tid]); }
#pragma unroll
                    for (int o = 1; o < 64; o <<= 1) { mq = fmaxf(mq, __shfl_xor(mq, o)); mk = fmaxf(mk, __shfl_xor(mk, o)); }
                    if (lane == 0) { red[wave * 2] = mq; red[wave * 2 + 1] = mk; }
                    if (tid < 256) pre[tid + 1] = 1 + (int)((CNT[g * 256 + tid] + 255u) >> 8);
                    if (tid == 0) pre[0] = 0;
                    __syncthreads();
                    if (tid == 0) { int a = 0; for (int i = 1; i <= 256; ++i) { a += pre[i]; pre[i] = a; } }
                    __syncthreads();
                }
                const float MSH = 128.0f * QSCALE * fmaxf(red[0], red[2]) * fmaxf(red[1], red[3]) * 1.02f;
                const int total = pre[256];
                const int fr = lane & 15, fq = lane >> 4;
                const int istart = (int)(((long)total * bx) / G), iend = (int)(((long)total * (bx + 1)) / G);
                int cur_li = -1;
#pragma unroll 1
                for (int item = istart; item < iend; ++item) {
                    int loi = 0, hii = 256;
                    while (hii - loi > 1) { const int mid = (loi + hii) >> 1; if (pre[mid] <= item) loi = mid; else hii = mid; }
                    const int li = loi, c = item - pre[li], bh = li >> 5, n = li & 31, b = bh >> 2, hl = bh & 3;
                    const int cnt = (int)CNT[g * 256 + li];
                    const size_t rowbase = (size_t)b * SEQ;
                    const bool restage = (li != cur_li); cur_li = li;
                    if (restage) {
                    __syncthreads();
                    for (int cc = tid; cc < 256 * 16; cc += NTHREADS) { const int r = cc >> 4, c16 = cc & 15;
                        *(LAS u32x4*)(Ks + r * 272 + c16 * 16) = *(const u32x4*)(KG + (rowbase + n * BLK + r) * GW + hl * HD + c16 * 8); }
                    for (int task = tid; task < 1024; task += NTHREADS) {
                        const int a = (task & 15) | ((task >> 5) & 3) << 4, cch = ((task >> 4) & 1) | ((task >> 7) << 1);
                        u32x4 v[4];
#pragma unroll
                        for (int kk = 0; kk < 4; ++kk) v[kk] = *(const u32x4*)(VG + (rowbase + n * BLK + a * 4 + kk) * GW + hl * HD + cch * 8);
#pragma unroll
                        for (int e = 0; e < 4; ++e) {
                            const unsigned w0 = e == 0 ? v[0].x : e == 1 ? v[0].y : e == 2 ? v[0].z : v[0].w, w1 = e == 0 ? v[1].x : e == 1 ? v[1].y : e == 2 ? v[1].z : v[1].w;
                            const unsigned w2 = e == 0 ? v[2].x : e == 1 ? v[2].y : e == 2 ? v[2].z : v[2].w, w3 = e == 0 ? v[3].x : e == 1 ? v[3].y : e == 2 ? v[3].z : v[3].w;
                            u32x2 lo2, hi2;
                            lo2.x = (w0 & 0xffffu) | (w1 << 16); lo2.y = (w2 & 0xffffu) | (w3 << 16);
                            hi2.x = (w0 >> 16) | (w1 & 0xffff0000u); hi2.y = (w2 >> 16) | (w3 & 0xffff0000u);
                            *(LAS u32x2*)(Vt + (cch * 8 + 2 * e) * 528 + a * 8) = lo2;
                            *(LAS u32x2*)(Vt + (cch * 8 + 2 * e + 1) * 528 + a * 8) = hi2;
                        }
                    }
                    }
                    int qpos[2], qslot[2]; bool qok[2];
                    bf16x8 qf[2][4];
#pragma unroll
                    for (int t = 0; t < 2; ++t) {
                        const int ridx = wave * 32 + t * 16 + fr;
                        if (c == 0) { qpos[t] = n * BLK + ridx; qslot[t] = 3; qok[t] = true; }
                        else { const int lidx = (c - 1) * 256 + ridx; qok[t] = lidx < cnt; const unsigned e = LIST[(size_t)li * SEQ + (qok[t] ? lidx : 0)]; qpos[t] = e & 8191; qslot[t] = e >> 13; }
                        const bf16_t* qp = QG + (rowbase + qpos[t]) * GW + hl * HD + fq * 8;
#pragma unroll
                        for (int ks = 0; ks < 4; ++ks) qf[t][ks] = *(const bf16x8*)(qp + ks * 32);
                    }
                    if (restage) __syncthreads();
                    f32x4 oacc[2][8], lacc[2];
#pragma unroll
                    for (int t = 0; t < 2; ++t) { lacc[t] = (f32x4){0.f, 0.f, 0.f, 0.f};
#pragma unroll
                        for (int dt = 0; dt < 8; ++dt) oacc[t][dt] = (f32x4){0.f, 0.f, 0.f, 0.f}; }
                    const int qrel0 = qpos[0] - n * BLK, qrel1 = qpos[1] - n * BLK;
                    const int kg_end = (c == 0) ? wave + 1 : 8;
                    const bf16x8 ones = {0x3F80, 0x3F80, 0x3F80, 0x3F80, 0x3F80, 0x3F80, 0x3F80, 0x3F80};
                    bf16x8 kf[2][4];
#pragma unroll
                    for (int kt = 0; kt < 2; ++kt)
#pragma unroll
                        for (int ks = 0; ks < 4; ++ks) kf[kt][ks] = *(const LAS bf16x8*)(Ks + (kt * 16 + fr) * 272 + ks * 64 + fq * 16);
#pragma unroll 1
                    for (int kg = 0; kg < kg_end; ++kg) {
                        u32x2 va[8], vb[8];
#pragma unroll
                        for (int dt = 0; dt < 8; ++dt) { va[dt] = *(const LAS u32x2*)(Vt + (dt * 16 + fr) * 528 + kg * 64 + fq * 8); vb[dt] = *(const LAS u32x2*)(Vt + (dt * 16 + fr) * 528 + kg * 64 + 32 + fq * 8); }
                        __builtin_amdgcn_sched_barrier(0);
                        f32x4 sacc[2][2];
#pragma unroll
                        for (int kt = 0; kt < 2; ++kt) { sacc[kt][0] = (f32x4){-MSH, -MSH, -MSH, -MSH}; sacc[kt][1] = (f32x4){-MSH, -MSH, -MSH, -MSH}; }
#pragma unroll
                        for (int ks = 0; ks < 4; ++ks)
#pragma unroll
                            for (int kt = 0; kt < 2; ++kt) {
                                sacc[kt][0] = __builtin_amdgcn_mfma_f32_16x16x32_bf16(kf[kt][ks], qf[0][ks], sacc[kt][0], 0, 0, 0);
                                sacc[kt][1] = __builtin_amdgcn_mfma_f32_16x16x32_bf16(kf[kt][ks], qf[1][ks], sacc[kt][1], 0, 0, 0); }
                        __builtin_amdgcn_sched_barrier(0);
                        if (kg + 1 < kg_end) {
#pragma unroll
                            for (int kt = 0; kt < 2; ++kt)
#pragma unroll
                                for (int ks = 0; ks < 4; ++ks) kf[kt][ks] = *(const LAS bf16x8*)(Ks + ((kg + 1) * 32 + kt * 16 + fr) * 272 + ks * 64 + fq * 16);
                        }
                        bf16x8 pb[2];
                        if (c == 0 && kg == wave) {
#pragma unroll
                            for (int t = 0; t < 2; ++t) {
                                float p[8];
#pragma unroll
                                for (int kt = 0; kt < 2; ++kt)
#pragma unroll
                                    for (int j = 0; j < 4; ++j) { float pv = __builtin_amdgcn_exp2f(sacc[kt][t][j]);
                                        const int key = kg * 32 + kt * 16 + fq * 4 + j; if (key > (t == 0 ? qrel0 : qrel1)) pv = 0.f;
                                        p[kt * 4 + j] = pv; }
                                u32x4 w; w.x = cvt_pk_bf16(p[0], p[1]); w.y = cvt_pk_bf16(p[2], p[3]); w.z = cvt_pk_bf16(p[4], p[5]); w.w = cvt_pk_bf16(p[6], p[7]);
                                pb[t] = __builtin_bit_cast(bf16x8, w);
                            }
                        } else {
#pragma unroll
                            for (int t = 0; t < 2; ++t) {
                                u32x4 w;
                                w.x = cvt_pk_bf16(__builtin_amdgcn_exp2f(sacc[0][t][0]), __builtin_amdgcn_exp2f(sacc[0][t][1])); w.y = cvt_pk_bf16(__builtin_amdgcn_exp2f(sacc[0][t][2]), __builtin_amdgcn_exp2f(sacc[0][t][3]));
                                w.z = cvt_pk_bf16(__builtin_amdgcn_exp2f(sacc[1][t][0]), __builtin_amdgcn_exp2f(sacc[1][t][1])); w.w = cvt_pk_bf16(__builtin_amdgcn_exp2f(sacc[1][t][2]), __builtin_amdgcn_exp2f(sacc[1][t][3]));
                                pb[t] = __builtin_bit_cast(bf16x8, w);
                            }
                        }
                        __builtin_amdgcn_sched_barrier(0);
                        lacc[0] = __builtin_amdgcn_mfma_f32_16x16x32_bf16(ones, pb[0], lacc[0], 0, 0, 0);
                        lacc[1] = __builtin_amdgcn_mfma_f32_16x16x32_bf16(ones, pb[1], lacc[1], 0, 0, 0);
#pragma unroll
                        for (int dt = 0; dt < 8; ++dt) {
                            u32x4 vv; vv.x = va[dt].x; vv.y = va[dt].y; vv.z = vb[dt].x; vv.w = vb[dt].y; const bf16x8 vf = __builtin_bit_cast(bf16x8, vv);
                            oacc[0][dt] = __builtin_amdgcn_mfma_f32_16x16x32_bf16(vf, pb[0], oacc[0][dt], 0, 0, 0);
                            oacc[1][dt] = __builtin_amdgcn_mfma_f32_16x16x32_bf16(vf, pb[1], oacc[1][dt], 0, 0, 0);
                        }
                    }
#pragma unroll
                    for (int t = 0; t < 2; ++t) {
                        const float l = lacc[t][0];
                        if (qok[t]) {
                            const size_t pair = (rowbase + qpos[t]) * HG + hl;
                            bf16_t* op = OPART + (pair * 4 + qslot[t]) * HD + fq * 4;
#pragma unroll
                            for (int dt = 0; dt < 8; ++dt) { u32x2 w; w.x = cvt_pk_bf16(oacc[t][dt][0], oacc[t][dt][1]); w.y = cvt_pk_bf16(oacc[t][dt][2], oacc[t][dt][3]); *(u32x2*)(op + dt * 16) = w; }
                            if (fq == 0) LPART[pair * 4 + qslot[t]] = l;
                        }
                    }
                }
            }
            SYNC(pb + 3);
            if (IN(pb + 4) && (PH_MASK & 1024)) {
            int tid = threadIdx.x; asm volatile("" : "+v"(tid)); const int lane = tid & 63, wave = __builtin_amdgcn_readfirstlane(tid >> 6); (void)lane; (void)wave;
                for (int idx = bx * NTHREADS + tid; idx < M * HG * 16; idx += G * NTHREADS) {
                    const int pair = idx >> 4, ch = idx & 15, m = pair >> 2, hl = pair & 3;
                    const unsigned sel = SEL[(size_t)m * NH + g * HG + hl];
                    float o[8]; float l = LPART[(size_t)pair * 4 + 3];
                    { const u32x4 v = *(const u32x4*)(OPART + ((size_t)pair * 4 + 3) * HD + ch * 8);
                      o[0] = bf_lo(v.x); o[1] = bf_hi(v.x); o[2] = bf_lo(v.y); o[3] = bf_hi(v.y); o[4] = bf_lo(v.z); o[5] = bf_hi(v.z); o[6] = bf_lo(v.w); o[7] = bf_hi(v.w); }
#pragma unroll
                    for (int e = 0; e < 3; ++e) if (((sel >> (8 * e)) & 0xffu) != 0xffu) {
                        const u32x4 v = *(const u32x4*)(OPART + ((size_t)pair * 4 + e) * HD + ch * 8); l += LPART[(size_t)pair * 4 + e];
                        o[0] += bf_lo(v.x); o[1] += bf_hi(v.x); o[2] += bf_lo(v.y); o[3] += bf_hi(v.y); o[4] += bf_lo(v.z); o[5] += bf_hi(v.z); o[6] += bf_lo(v.w); o[7] += bf_hi(v.w); }
                    const float rl = 1.0f / l;
                    const u32x4 z = *(const u32x4*)(SZG + (size_t)m * GW + hl * HD + ch * 8);
                    u32x4 w; w.x = cvt_pk_bf16(o[0] * rl * bf_lo(z.x), o[1] * rl * bf_hi(z.x)); w.y = cvt_pk_bf16(o[2] * rl * bf_lo(z.y), o[3] * rl * bf_hi(z.y));
                    w.z = cvt_pk_bf16(o[4] * rl * bf_lo(z.z), o[5] * rl * bf_hi(z.z)); w.w = cvt_pk_bf16(o[6] * rl * bf_lo(z.w), o[7] * rl * bf_hi(z.w));
                    *(u32x4*)(AT + (size_t)m * DI + g * GW + hl * HD + ch * 8) = w;
                }
            }
            SYNC(pb + 4);
        }
        if (IN(6 + 5 * NG) && (PH_MASK & 2048)) {
            int tid = threadIdx.x; asm volatile("" : "+v"(tid)); const int lane = tid & 63, wave = __builtin_amdgcn_readfirstlane(tid >> 6); (void)lane; (void)wave;
            pg8::Gemm<DI, DI, DI> gm{AT, WOUT1}; pg8::StaticOrder S; S.init(M, D, G, bx);
            pg8::EpiRes E{out, out}; pg8::MapPlain<DI, DI> MP;
            pg8::gemm_phase(lds, gm, S, MP, E);
        }
    }
}

constexpr int NPHASES = 6 + 5 * NG + 1;

extern "C" void kernel_launch(void* const* d_in, const int* in_sizes, int n_in, void* d_out, int out_size, void* d_ws, size_t ws_size, hipStream_t stream) {
    static int grid = 0;
    if (grid == 0) {
        int dev = 0, cus = 0, per_cu = 0;
        hipGetDevice(&dev);
        hipDeviceGetAttribute(&cus, hipDeviceAttributeMultiprocessorCount, dev);
        hipFuncSetAttribute((const void*)mega_fwd, hipFuncAttributeMaxDynamicSharedMemorySize, LDS_BYTES);
        hipOccupancyMaxActiveBlocksPerMultiprocessor(&per_cu, (const void*)mega_fwd, NTHREADS, LDS_BYTES);
        if (per_cu < 1) { fprintf(stderr, "kernel_launch: occupancy query says %d blocks per CU\n", per_cu); per_cu = 1; }
        grid = cus;
        if (ws_size < WS_END) fprintf(stderr, "kernel_launch: workspace too small: %zu < %zu\n", ws_size, (size_t)WS_END);
    }
    hipMemsetAsync((char*)d_ws + WS_CTL, 0, CTL_BYTES, stream);
    Args a{};
    for (int i = 0; i < 11; ++i) a.in[i] = (const float*)d_in[i];
    a.out = (float*)d_out; a.ws = (unsigned char*)d_ws; a.pad = 0;
#if defined(MK_PER_PHASE)
    for (int ph = 0; ph < NPHASES; ++ph) { a.ph_lo = ph; a.ph_hi = ph + 1; a.coop = 0; hipLaunchKernelGGL(mega_fwd, dim3(grid), dim3(NTHREADS), LDS_BYTES, stream, a); }
#else
    a.ph_lo = 0; a.ph_hi = NPHASES; a.coop = 1;
    void* kargs[] = {&a};
    hipError_t e = hipLaunchCooperativeKernel((const void*)mega_fwd, dim3(grid), dim3(NTHREADS), kargs, LDS_BYTES, stream);
    if (e != hipSuccess) fprintf(stderr, "cooperative launch failed: %s (grid %d)\n", hipGetErrorString(e), grid);
#endif
}
```

```cpp
#include <hip/hip_runtime.h>
#include <hip/hip_cooperative_groups.h>
#include <cstdio>
#include <cstdint>
namespace cg = cooperative_groups;

#define LAS __attribute__((address_space(3)))
typedef unsigned short bf16_t;
typedef short bf16x8 __attribute__((ext_vector_type(8)));
typedef float f32x4 __attribute__((ext_vector_type(4)));
typedef float f32x2 __attribute__((ext_vector_type(2)));
typedef unsigned u32x4 __attribute__((ext_vector_type(4)));
typedef unsigned u32x2 __attribute__((ext_vector_type(2)));

constexpr int SEQ = 8192, NBATCH = 2, M = NBATCH * SEQ, D = 1024, DI = 2048, NH = 16, HD = 128, BLK = 256, NB = SEQ / BLK;
constexpr int NG = 4, HG = NH / NG, GW = HG * HD;
constexpr float EPS = 1e-6f;
constexpr float QSCALE = 0.08838834764831845f * 1.4426950408889634f;

constexpr size_t MiB = 1u << 20;
constexpr size_t WS_CTL = 0, CTL_BYTES = 65536;
constexpr size_t WS_BAR = 8192;
constexpr size_t WS_KMEAN = 1 * MiB;
constexpr size_t WS_SEL = 2 * MiB;
constexpr size_t WS_LPART = 3 * MiB;
constexpr size_t WS_TAB = 4 * MiB;
constexpr size_t WS_WIN1 = 8 * MiB, WS_WOUT1 = 24 * MiB;
constexpr size_t WS_LIST = 28 * MiB;
constexpr size_t WS_WIN0 = 28 * MiB, WS_WP = 36 * MiB, WS_WOUT0 = 38 * MiB;
constexpr size_t WS_H0 = 42 * MiB, WS_POOLED = 42 * MiB, WS_U = 106 * MiB, WS_SZ0 = 170 * MiB;
constexpr size_t WS_H1 = 32 * MiB, WS_QG = 64 * MiB, WS_KG = 80 * MiB, WS_VG = 96 * MiB, WS_SZG = 112 * MiB;
constexpr size_t WS_OPART = 128 * MiB, WS_A = 192 * MiB, WS_END = 256 * MiB;

constexpr int LDS_BYTES = 140 * 1024;
constexpr int NTHREADS = 512;
#ifndef PH_MASK
#define PH_MASK 0xfff
#endif

__device__ __forceinline__ unsigned cvt_pk_bf16(float lo, float hi) { unsigned r; asm volatile("v_cvt_pk_bf16_f32 %0, %1, %2" : "=v"(r) : "v"(lo), "v"(hi)); return r; }
__device__ __forceinline__ float bf_lo(unsigned u) { return __uint_as_float(u << 16); }
__device__ __forceinline__ float bf_hi(unsigned u) { return __uint_as_float(u & 0xffff0000u); }
__device__ __forceinline__ float silu_f(float z) { return z * __builtin_amdgcn_rcpf(1.0f + __builtin_amdgcn_exp2f(-1.4426950408889634f * z)); }
__device__ __forceinline__ float wave_sum(float v) {
#pragma unroll
    for (int o = 1; o < 64; o <<= 1) v += __shfl_xor(v, o);
    return v;
}

namespace pg8 {
constexpr int BM = 256, BK = 64, HALF = 128, HTB = HALF * BK * 2, STAGE_BYTES = 8 * HTB, NXCD = 8, WGM = 8;
__host__ __device__ __forceinline__ int lds_byte(int r, int c) { const int st = (r >> 4) * 2 + (c >> 5), rr = r & 15, cc = c & 31, ob = rr * 64 + cc * 2; return st * 1024 + (ob ^ (((ob >> 9) & 1) << 5)); }
__host__ __device__ __forceinline__ void stage_rc(int b, int& R, int& C) { const int st = b / 1024, sb = b % 1024, swz = sb ^ (((sb >> 9) & 1) << 5); R = (st >> 1) * 16 + swz / 64; C = (st & 1) * 32 + (swz % 64) / 2; }
__host__ __device__ __forceinline__ int perm32(int rho) { const int n = rho >> 4, i = rho & 15; return 8 * (i >> 2) + 4 * n + (i & 3); }

struct Unit { int pm, pn; };
template <int LDA_, int LDB_, int K_> struct Gemm { const bf16_t* A; const bf16_t* Bt; static constexpr int lda = LDA_, ldb = LDB_, K = K_; };
struct StaticOrder {
    int nM, nN, nwg, G, c;
    __device__ void init(int M_, int N_, int G_, int c_) { nM = M_ / BM; nN = N_ / BM; nwg = nM * nN; G = G_; c = c_; }
    __device__ bool next(int i, Unit& u) const {
        const long L = (long)i * G + c; if (L >= nwg) return false;
        int wgid = (int)L; { const int q = nwg / NXCD, r = nwg % NXCD, xcd = wgid % NXCD, off = wgid / NXCD; wgid = (xcd < r ? xcd * (q + 1) : r * (q + 1) + (xcd - r) * q) + off; }
        const int nig = WGM * nN, gid = wgid / nig, fm = gid * WGM, gsz = (nM - fm) < WGM ? (nM - fm) : WGM;
        u.pm = fm + ((wgid % nig) % gsz); u.pn = (wgid % nig) / gsz; return true;
    }
};
template <class Epi, class Map, class GemmT>
__device__ __forceinline__ void gemm_phase(LAS unsigned char* lds, const GemmT g, const StaticOrder& S, const Map& MP, const Epi& E) {
    int tid_ = threadIdx.x; asm volatile("" : "+v"(tid_));
    const int tid = tid_, wid = __builtin_amdgcn_readfirstlane(tid >> 6), lane = tid & 63, wr = wid >> 2, wc = wid & 3, fr = lane & 15, fq = lane >> 4;
    constexpr int K = GemmT::K, nt = K / BK;
    unsigned voffA[2], voffB[2];
#pragma unroll
    for (int i = 0; i < 2; ++i) { int R, C; stage_rc(tid * 16 + i * 8192, R, C); const int Rb = Epi::PERM ? ((R & ~31) + perm32(R & 31)) : R;
        voffA[i] = (unsigned)(R * GemmT::lda + C) * 2u; voffB[i] = (unsigned)(Rb * GemmT::ldb + C) * 2u; }
    constexpr size_t kstep = (size_t)(BK * 2);
    constexpr size_t hstepA = (size_t)HALF * GemmT::lda * 2, hstepB = (size_t)HALF * GemmT::ldb * 2;
    const unsigned ldsw = (unsigned)wid * 1024u;
    const int aoff = lds_byte(wr * 64 + fr, fq * 8), boff = lds_byte(wc * 32 + fr, fq * 8);
#define PG8_SA(b, h) (((b) * 2 + (h)) * HTB)
#define PG8_SB(b, h) ((4 + (b) * 2 + (h)) * HTB)
#define PG8_STAGE(bufoff, gbase, voff) do { _Pragma("unroll") for (int _i = 0; _i < 2; ++_i) \
        __builtin_amdgcn_global_load_lds((const unsigned*)((const char*)(gbase) + (voff)[_i]), (LAS unsigned*)(lds + (bufoff) + ldsw + _i * 8192), 16, 0, 0); } while (0)
#define PG8_LDA(dst, b, h) do { _Pragma("unroll") for (int m = 0; m < 4; ++m) _Pragma("unroll") for (int k = 0; k < 2; ++k) dst[m][k] = *(const LAS bf16x8*)(lds + PG8_SA(b, h) + aoff + m * 2048 + k * 1024); } while (0)
#define PG8_LDB(dst, b, h) do { _Pragma("unroll") for (int n = 0; n < 2; ++n) _Pragma("unroll") for (int k = 0; k < 2; ++k) dst[n][k] = *(const LAS bf16x8*)(lds + PG8_SB(b, h) + boff + n * 2048 + k * 1024); } while (0)
#define PG8_MMA(ai, bj, At, Bt) do { __builtin_amdgcn_s_setprio(1); _Pragma("unroll") for (int m = 0; m < 4; ++m) _Pragma("unroll") for (int n = 0; n < 2; ++n) _Pragma("unroll") for (int k = 0; k < 2; ++k) \
        acc[ai][bj][m][n] = __builtin_amdgcn_mfma_f32_16x16x32_bf16(Bt[n][k], At[m][k], acc[ai][bj][m][n], 0, 0, 0); __builtin_amdgcn_s_setprio(0); } while (0)
#define PG8_WAIT_V(n) asm volatile("s_waitcnt vmcnt(" #n ")" ::: "memory")
#define PG8_WAIT_L(n) asm volatile("s_waitcnt lgkmcnt(" #n ")" ::: "memory")
#define PG8_BAR __builtin_amdgcn_s_barrier()
#define PG8_SCHED __builtin_amdgcn_sched_barrier(0)
    Unit cur, nxt; int ui = 0;
    if (!S.next(0, cur)) return;
    f32x4 acc[2][2][4][2];
#pragma unroll
    for (int a = 0; a < 2; ++a)
#pragma unroll
        for (int b = 0; b < 2; ++b)
#pragma unroll
            for (int m = 0; m < 4; ++m)
#pragma unroll
                for (int n = 0; n < 2; ++n) acc[a][b][m][n] = (f32x4){0.f, 0.f, 0.f, 0.f};
    bf16x8 At[4][2], B0[2][2], B1[2][2];
    const char* cA = (const char*)(g.A + MP.a_off(cur)); const char* cB = (const char*)(g.Bt + MP.b_off(cur));
    PG8_STAGE(PG8_SB(0, 0), cB, voffB); PG8_STAGE(PG8_SB(0, 1), cB + hstepB, voffB); PG8_STAGE(PG8_SA(0, 0), cA, voffA); PG8_STAGE(PG8_SA(0, 1), cA + hstepA, voffA);
    if (wr == 1) PG8_BAR;
    PG8_WAIT_V(2); PG8_BAR;
    PG8_STAGE(PG8_SB(1, 0), cB + kstep, voffB); PG8_STAGE(PG8_SA(1, 0), cA + kstep, voffA); PG8_STAGE(PG8_SB(1, 1), cB + hstepB + kstep, voffB);
    PG8_WAIT_V(6); PG8_BAR;
    for (;;) {
        const bool has_next = S.next(ui + 1, nxt);
        const char* nA = has_next ? (const char*)(g.A + MP.a_off(nxt)) : cA; const char* nB = has_next ? (const char*)(g.Bt + MP.b_off(nxt)) : cB;
        for (int t = 0; t < nt; t += 2) {
            const bool last = (t == nt - 2);
            const char* a1 = cA + (size_t)(t + 1) * kstep;
            const char* a2 = last ? nA : cA + (size_t)(t + 2) * kstep; const char* b2 = last ? nB : cB + (size_t)(t + 2) * kstep;
            const char* a3 = a2 + kstep; const char* b3 = b2 + kstep;
            PG8_LDB(B0, 0, 0); PG8_LDB(B1, 0, 1); PG8_SCHED; PG8_LDA(At, 0, 0); PG8_STAGE(PG8_SA(1, 1), a1 + hstepA, voffA);
            PG8_WAIT_V(8); PG8_WAIT_L(0); PG8_BAR; PG8_MMA(0, 0, At, B0); PG8_MMA(0, 1, At, B1); PG8_BAR; PG8_SCHED;
            PG8_LDA(At, 0, 1); PG8_STAGE(PG8_SB(0, 0), b2, voffB); PG8_STAGE(PG8_SB(0, 1), b2 + hstepB, voffB); PG8_STAGE(PG8_SA(0, 0), a2, voffA);
            PG8_WAIT_V(8); PG8_WAIT_L(0); PG8_BAR; PG8_MMA(1, 0, At, B0); PG8_MMA(1, 1, At, B1); PG8_BAR; PG8_SCHED;
            PG8_LDB(B0, 1, 0); PG8_LDB(B1, 1, 1); PG8_SCHED; PG8_LDA(At, 1, 0); PG8_STAGE(PG8_SA(0, 1), a2 + hstepA, voffA);
            PG8_WAIT_V(8); PG8_WAIT_L(0); PG8_BAR; PG8_MMA(0, 0, At, B0); PG8_MMA(0, 1, At, B1); PG8_BAR; PG8_SCHED;
            PG8_LDA(At, 1, 1); PG8_STAGE(PG8_SB(1, 0), b3, voffB); PG8_STAGE(PG8_SB(1, 1), b3 + hstepB, voffB); PG8_STAGE(PG8_SA(1, 0), a3, voffA);
            PG8_WAIT_V(8); PG8_WAIT_L(0); PG8_BAR; PG8_MMA(1, 0, At, B0); PG8_MMA(1, 1, At, B1); PG8_BAR; PG8_SCHED;
        }
        if (wr == 0) PG8_BAR;
        E(acc, cur, wr, wc, fr, fq);
        if (!has_next) break;
#pragma unroll
        for (int a = 0; a < 2; ++a)
#pragma unroll
            for (int b = 0; b < 2; ++b)
#pragma unroll
                for (int m = 0; m < 4; ++m)
#pragma unroll
                    for (int n = 0; n < 2; ++n) acc[a][b][m][n] = (f32x4){0.f, 0.f, 0.f, 0.f};
        cur = nxt; cA = nA; cB = nB; ++ui;
        if (wr == 1) PG8_BAR;
    }
    PG8_WAIT_V(0);
    PG8_BAR;
#undef PG8_SA
#undef PG8_SB
#undef PG8_STAGE
#undef PG8_LDA
#undef PG8_LDB
#undef PG8_MMA
#undef PG8_WAIT_V
#undef PG8_WAIT_L
#undef PG8_BAR
#undef PG8_SCHED
}

template <int ldc, int tiles_per_dst, int silu_dst> struct EpiSplit {
    static constexpr bool PERM = true;
    bf16_t *d0, *d1, *d2, *d3;
    __device__ __forceinline__ void operator()(const f32x4 (&acc)[2][2][4][2], const Unit& u, int wr, int wc, int fr, int fq) const {
        const int di = u.pn / tiles_per_dst, ct = u.pn - di * tiles_per_dst;
        bf16_t* base = di == 0 ? d0 : di == 1 ? d1 : di == 2 ? d2 : d3; const bool act = (di == silu_dst);
        const int row0 = u.pm * BM + wr * 64 + fr, col0 = ct * BM + wc * 32 + 8 * fq;
#pragma unroll
        for (int ai = 0; ai < 2; ++ai)
#pragma unroll
            for (int m = 0; m < 4; ++m) { bf16_t* rowp = base + (size_t)(row0 + ai * HALF + m * 16) * ldc + col0;
#pragma unroll
                for (int bj = 0; bj < 2; ++bj) { f32x4 v0 = acc[ai][bj][m][0], v1 = acc[ai][bj][m][1];
                    if (act) { v0 = (f32x4){silu_f(v0[0]), silu_f(v0[1]), silu_f(v0[2]), silu_f(v0[3])}; v1 = (f32x4){silu_f(v1[0]), silu_f(v1[1]), silu_f(v1[2]), silu_f(v1[3])}; }
                    u32x4 w; w.x = cvt_pk_bf16(v0[0], v0[1]); w.y = cvt_pk_bf16(v0[2], v0[3]); w.z = cvt_pk_bf16(v1[0], v1[1]); w.w = cvt_pk_bf16(v1[2], v1[3]);
                    *(u32x4*)(rowp + bj * HALF) = w; } }
    }
};
struct EpiGate {
    static constexpr bool PERM = true; static constexpr int ldc = DI;
    bf16_t* Y; const bf16_t* SZ; const float* scale;
    __device__ __forceinline__ void operator()(const f32x4 (&acc)[2][2][4][2], const Unit& u, int wr, int wc, int fr, int fq) const {
        const int row0 = u.pm * BM + wr * 64 + fr, col0 = u.pn * BM + wc * 32 + 8 * fq;
        f32x4 sc[2][2];
#pragma unroll
        for (int bj = 0; bj < 2; ++bj) { sc[bj][0] = *(const f32x4*)(scale + col0 + bj * HALF); sc[bj][1] = *(const f32x4*)(scale + col0 + bj * HALF + 4); }
#pragma unroll
        for (int ai = 0; ai < 2; ++ai)
#pragma unroll
            for (int m = 0; m < 4; ++m) { const size_t off = (size_t)(row0 + ai * HALF + m * 16) * ldc + col0;
#pragma unroll
                for (int bj = 0; bj < 2; ++bj) { const u32x4 z = *(const u32x4*)(SZ + off + bj * HALF);
                    const f32x4 v0 = acc[ai][bj][m][0] * sc[bj][0], v1 = acc[ai][bj][m][1] * sc[bj][1];
                    u32x4 w; w.x = cvt_pk_bf16(v0[0] * bf_lo(z.x), v0[1] * bf_hi(z.x)); w.y = cvt_pk_bf16(v0[2] * bf_lo(z.y), v0[3] * bf_hi(z.y));
                    w.z = cvt_pk_bf16(v1[0] * bf_lo(z.z), v1[1] * bf_hi(z.z)); w.w = cvt_pk_bf16(v1[2] * bf_lo(z.w), v1[3] * bf_hi(z.w));
                    *(u32x4*)(Y + off + bj * HALF) = w; } }
    }
};
struct EpiRes {
    static constexpr bool PERM = false; static constexpr int ldc = D;
    const float* base; float* out;
    __device__ __forceinline__ void operator()(const f32x4 (&acc)[2][2][4][2], const Unit& u, int wr, int wc, int fr, int fq) const {
        const int row0 = u.pm * BM + wr * 64 + fr, col0 = u.pn * BM + wc * 32 + 4 * fq;
#pragma unroll
        for (int ai = 0; ai < 2; ++ai)
#pragma unroll
            for (int m = 0; m < 4; ++m) { const size_t off = (size_t)(row0 + ai * HALF + m * 16) * ldc + col0;
#pragma unroll
                for (int bj = 0; bj < 2; ++bj)
#pragma unroll
                    for (int n = 0; n < 2; ++n) { const f32x4 b = *(const f32x4*)(base + off + bj * HALF + n * 16); *(f32x4*)(out + off + bj * HALF + n * 16) = b + acc[ai][bj][m][n]; } }
    }
};
template <int lda, int ldb> struct MapPlain { __device__ __forceinline__ size_t a_off(const Unit& u) const { return (size_t)u.pm * BM * lda; } __device__ __forceinline__ size_t b_off(const Unit& u) const { return (size_t)u.pn * BM * ldb; } };
struct MapPool { __device__ __forceinline__ size_t a_off(const Unit& u) const { return (size_t)u.pm * BM * DI + (size_t)(u.pn >> 1) * 512; } __device__ __forceinline__ size_t b_off(const Unit& u) const { return (size_t)u.pn * BM * 512; } };
struct MapQkvz { int g; __device__ __forceinline__ size_t a_off(const Unit& u) const { return (size_t)u.pm * BM * D; } __device__ __forceinline__ size_t b_off(const Unit& u) const { return (size_t)((u.pn >> 1) * DI + g * GW + (u.pn & 1) * BM) * D; } };
}

#define XB_TMO      128
#define XB_XCNT(j)  (256  + 64 * (j))
#define XB_XSUB(j)  (1280 + 64 * (j))
#define XB_XGEN(j)  (2304 + 64 * (j))
#define XB_TOP      3328
#define XB_TOPGEN   3392
#define XCD_BAR_WORDS 3456
#define XB_SPIN_CAP (1u << 18)
__device__ __forceinline__ unsigned xb_ld(unsigned* p)              { return __hip_atomic_load(p, __ATOMIC_RELAXED, __HIP_MEMORY_SCOPE_AGENT); }
__device__ __forceinline__ unsigned xb_add(unsigned* p, unsigned v) { return __hip_atomic_fetch_add(p, v, __ATOMIC_RELAXED, __HIP_MEMORY_SCOPE_AGENT); }
__device__ __forceinline__ unsigned xb_xcc_id() { return (unsigned)__builtin_amdgcn_s_getreg((3 << 11) | 20) & 0xFu; }
#define XB_SPIN(cond, bar) do { unsigned _sp = 0; while (cond) { __builtin_amdgcn_s_sleep(1); \
    if ((++_sp & 255u) == 0u) { if (xb_ld(&(bar)[XB_TMO])) break; if (_sp > XB_SPIN_CAP) { atomicAdd(&(bar)[XB_TMO], 1u); break; } } } } while (0)
struct XcdBarrier { unsigned* bar; unsigned x; volatile LAS unsigned* st; };
__device__ __forceinline__ XcdBarrier xcd_barrier_post(unsigned* bar, volatile LAS unsigned* st) {
    XcdBarrier b; b.bar = bar; b.x = xb_xcc_id(); b.st = st;
    if (threadIdx.x == 0) (void)xb_add(&bar[XB_XCNT(b.x)], 1u);
    return b;
}
__device__ __forceinline__ void xcd_barrier_complete(unsigned* bar, unsigned x, unsigned& nloc, unsigned& nx) {
    const unsigned G = gridDim.x * gridDim.y * gridDim.z;
    unsigned sum, cnt, mine, sp = 0u;
    for (;;) {
        sum = 0u; cnt = 0u; mine = 0u;
#pragma unroll
        for (unsigned j = 0; j < 16; ++j) { const unsigned c = xb_ld(&bar[XB_XCNT(j)]); sum += c; cnt += (c > 0u) ? 1u : 0u; mine = (j == x) ? c : mine; }
        if (sum == G) break;
        __builtin_amdgcn_s_sleep(1);
        if ((++sp & 255u) == 0u) { if (xb_ld(&bar[XB_TMO])) break; if (sp > XB_SPIN_CAP) { atomicAdd(&bar[XB_TMO], 1u); break; } }
    }
    nloc = mine > 0u ? mine : 1u; nx = cnt > 0u ? cnt : 1u;
}
__device__ __forceinline__ void xcd_barrier(const XcdBarrier& b) {
    asm volatile("s_waitcnt vmcnt(0)" ::: "memory");
    __syncthreads();
    if (threadIdx.x == 0) {
        unsigned* bar = b.bar;
        __builtin_amdgcn_s_waitcnt(0);
        unsigned nloc = b.st[0], nx = b.st[1];
        if (nloc == 0u) { xcd_barrier_complete(bar, b.x, nloc, nx); b.st[0] = nloc; b.st[1] = nx; }
        const unsigned old = xb_add(&bar[XB_XSUB(b.x)], 1u);
        const unsigned gen = old / nloc;
        if (old + 1u == (gen + 1u) * nloc) {
            __builtin_amdgcn_fence(__ATOMIC_RELEASE, "agent");
            asm volatile("s_waitcnt vmcnt(0)" ::: "memory");
            const unsigned og = xb_add(&bar[XB_TOP], 1u);
            const unsigned tg = og / nx;
            if (og + 1u == (tg + 1u) * nx) xb_add(&bar[XB_TOPGEN], 1u);
            else XB_SPIN(xb_ld(&bar[XB_TOPGEN]) == tg, bar);
            __builtin_amdgcn_fence(__ATOMIC_ACQUIRE, "agent");
            xb_add(&bar[XB_XGEN(b.x)], 1u);
            asm volatile("s_waitcnt vmcnt(0)" ::: "memory");
        } else {
            XB_SPIN(xb_ld(&bar[XB_XGEN(b.x)]) == gen, bar);
            __builtin_amdgcn_fence(__ATOMIC_ACQUIRE, "agent");
            asm volatile("s_waitcnt vmcnt(0)" ::: "memory");
        }
    }
    __syncthreads();
}

struct Args { const float* in[11]; float* out; unsigned char* ws; int ph_lo, ph_hi, coop, pad; };

__device__ __forceinline__ void transpose_item(const float* W, int K, int N, bf16_t* WT, LAS float* scr, int item, int lane) {
    const int nblk = N / 32, kb = item / nblk, nb = item % nblk, k0 = 64 * kb, n0 = 32 * nb;
#pragma unroll 8
    for (int i = 0; i < 32; ++i) { const int kk = 2 * i + (lane >> 5); scr[kk * 33 + (lane & 31)] = W[(size_t)(k0 + kk) * N + n0 + (lane & 31)]; }
    asm volatile("s_waitcnt lgkmcnt(0)" ::: "memory");
    const int c = lane & 7;
#pragma unroll
    for (int j = 0; j < 4; ++j) { const int n = (lane >> 3) + 8 * j; const LAS float* s = scr + (8 * c) * 33 + n;
        u32x4 o; o.x = cvt_pk_bf16(s[0 * 33], s[1 * 33]); o.y = cvt_pk_bf16(s[2 * 33], s[3 * 33]); o.z = cvt_pk_bf16(s[4 * 33], s[5 * 33]); o.w = cvt_pk_bf16(s[6 * 33], s[7 * 33]);
        *(u32x4*)(WT + (size_t)(n0 + n) * K + k0 + 8 * c) = o; }
    asm volatile("s_waitcnt lgkmcnt(0)" ::: "memory");
}
__device__ __forceinline__ void rms_row(const float* xrow, const float* gain, bf16_t* orow, int lane) {
    const f32x4* xr = (const f32x4*)xrow + lane; const f32x4* gr = (const f32x4*)gain + lane;
    f32x4 v[4]; float s = 0.f;
#pragma unroll
    for (int j = 0; j < 4; ++j) { v[j] = xr[64 * j]; s += (v[j].x * v[j].x + v[j].y * v[j].y) + (v[j].z * v[j].z + v[j].w * v[j].w); }
    const float rstd = 1.0f / sqrtf(wave_sum(s) * (1.f / D) + EPS);
    u32x2* o8 = (u32x2*)orow + lane;
#pragma unroll
    for (int j = 0; j < 4; ++j) { const f32x4 gg = gr[64 * j]; u32x2 w; w.x = cvt_pk_bf16(v[j].x * rstd * gg.x, v[j].y * rstd * gg.y); w.y = cvt_pk_bf16(v[j].z * rstd * gg.z, v[j].w * rstd * gg.w); o8[64 * j] = w; }
}
__device__ __forceinline__ void rope_entry(int idx, f32x2* tab) {
    const int pos = idx >> 6, i = idx & 63;
    const float inv = (float)exp2(-(double)(2 * i) * (13.287712379549449 / 128.0));
    const float angf = (float)pos * inv;
    const double a = (double)angf; const double q = rint(a * 0.6366197723675814); const double r = a - q * 1.5707963267948966;
    const double r2 = r * r;
    double sn = r * (1.0 - r2 / 6.0 * (1.0 - r2 / 20.0 * (1.0 - r2 / 42.0 * (1.0 - r2 / 72.0 * (1.0 - r2 / 110.0 * (1.0 - r2 / 156.0))))));
    double cs = 1.0 - r2 / 2.0 * (1.0 - r2 / 12.0 * (1.0 - r2 / 30.0 * (1.0 - r2 / 56.0 * (1.0 - r2 / 90.0 * (1.0 - r2 / 132.0)))));
    const int qi = ((int)q) & 3;
    double c2, s2;
    if (qi == 0) { c2 = cs; s2 = sn; } else if (qi == 1) { c2 = -sn; s2 = cs; } else if (qi == 2) { c2 = -cs; s2 = -sn; } else { c2 = sn; s2 = -cs; }
    tab[idx] = (f32x2){(float)c2, (float)s2};
}

__global__ void __launch_bounds__(NTHREADS, 2) mega_fwd(Args args) {
    extern __shared__ __attribute__((aligned(16))) unsigned char lds_raw[];
    LAS unsigned char* lds = (LAS unsigned char*)lds_raw;
    cg::grid_group grid = cg::this_grid();
    const int G = gridDim.x, bx = blockIdx.x;
    volatile LAS unsigned* bst = (volatile LAS unsigned*)(lds + LDS_BYTES - 16);
    if (threadIdx.x < 4) bst[threadIdx.x] = 0u;
    __syncthreads();
    XcdBarrier xbar; xbar.bar = (unsigned*)(args.ws + WS_BAR); xbar.x = 0; xbar.st = bst;
    if (args.coop) xbar = xcd_barrier_post((unsigned*)(args.ws + WS_BAR), bst);
    unsigned char* ws = args.ws;
#define XIN (args.in[0])
#define norm0 (args.in[1])
#define w_in0 (args.in[2])
#define w_pool0 (args.in[3])
#define pool_scale0 (args.in[4])
#define w_out0 (args.in[5])
#define norm1 (args.in[6])
#define w_in1 (args.in[7])
#define q_norm1 (args.in[8])
#define k_norm1 (args.in[9])
#define w_out1 (args.in[10])
    float* out = args.out;
#define WIN0 ((bf16_t*)(ws + WS_WIN0))
#define WP ((bf16_t*)(ws + WS_WP))
#define WOUT0 ((bf16_t*)(ws + WS_WOUT0))
#define WIN1 ((bf16_t*)(ws + WS_WIN1))
#define WOUT1 ((bf16_t*)(ws + WS_WOUT1))
#define H0 ((bf16_t*)(ws + WS_H0))
#define POOLED ((bf16_t*)(ws + WS_POOLED))
#define U ((bf16_t*)(ws + WS_U))
#define SZ0 ((bf16_t*)(ws + WS_SZ0))
#define H1 ((bf16_t*)(ws + WS_H1))
#define QG ((bf16_t*)(ws + WS_QG))
#define KG ((bf16_t*)(ws + WS_KG))
#define VG ((bf16_t*)(ws + WS_VG))
#define SZG ((bf16_t*)(ws + WS_SZG))
#define OPART ((bf16_t*)(ws + WS_OPART))
#define AT ((bf16_t*)(ws + WS_A))
#define KMEAN ((float*)(ws + WS_KMEAN))
#define SEL ((unsigned*)(ws + WS_SEL))
#define LPART ((float*)(ws + WS_LPART))
#define TAB ((f32x2*)(ws + WS_TAB))
#define LIST ((unsigned short*)(ws + WS_LIST))
#define CNT ((unsigned*)(ws + WS_CTL))
    const int lo = args.ph_lo, hi = args.ph_hi;
#define IN(k) (lo <= (k) && (k) < hi)
#define SYNC(k) do { if (IN(k) && IN((k) + 1) && args.coop) { if (args.coop == 2) grid.sync(); else xcd_barrier(xbar); } } while (0)
    {
        if (IN(0) && (PH_MASK & 1)) {
            int tid = threadIdx.x; asm volatile("" : "+v"(tid)); const int lane = tid & 63, wave = __builtin_amdgcn_readfirstlane(tid >> 6); (void)lane; (void)wave;
            LAS float* scr = (LAS float*)(lds + wave * 16384);
            const int gw = bx * 8 + wave, NGW = G * 8;
            constexpr int I0 = (D / 64) * (2 * DI / 32), IP = (512 / 64) * (512 / 32), I1 = (DI / 64) * (D / 32), I2 = (D / 64) * (4 * DI / 32), I3 = I1;
            constexpr int NITEMS = I0 + 4 * IP + I1 + I2 + I3;
            for (int it = gw; it < NITEMS; it += NGW) {
                int r = it;
                if (r < I0) { transpose_item(w_in0, D, 2 * DI, WIN0, scr, r, lane); continue; } r -= I0;
                if (r < 4 * IP) { const int gp = r / IP; transpose_item(w_pool0 + (size_t)gp * 512 * 512, 512, 512, WP + (size_t)gp * 512 * 512, scr, r - gp * IP, lane); continue; } r -= 4 * IP;
                if (r < I1) { transpose_item(w_out0, DI, D, WOUT0, scr, r, lane); continue; } r -= I1;
                if (r < I2) { transpose_item(w_in1, D, 4 * DI, WIN1, scr, r, lane); continue; } r -= I2;
                transpose_item(w_out1, DI, D, WOUT1, scr, r, lane);
            }
            for (int idx = bx * NTHREADS + tid; idx < SEQ * 64; idx += G * NTHREADS) rope_entry(idx, TAB);
            for (int m = gw; m < M; m += NGW) rms_row(XIN + (size_t)m * D, norm0, H0 + (size_t)m * D, lane);
        }
        SYNC(0);
        if (IN(1) && (PH_MASK & 2)) {
            int tid = threadIdx.x; asm volatile("" : "+v"(tid)); const int lane = tid & 63, wave = __builtin_amdgcn_readfirstlane(tid >> 6); (void)lane; (void)wave;
            pg8::Gemm<D, D, D> g{H0, WIN0}; pg8::StaticOrder S; S.init(M, 2 * DI, G, bx);
            pg8::EpiSplit<DI, 8, 1> E{U, SZ0, U, U}; pg8::MapPlain<D, D> MP;
            pg8::gemm_phase(lds, g, S, MP, E);
        }
        SYNC(1);
        if (IN(2) && (PH_MASK & 4)) {
            int tid = threadIdx.x; asm volatile("" : "+v"(tid)); const int lane = tid & 63, wave = __builtin_amdgcn_readfirstlane(tid >> 6); (void)lane; (void)wave;
            const int cgp = tid & 255, hh = tid >> 8, col = cgp * 8, w = 2 << (cgp >> 6);
            for (int unit = bx; unit < M / 64; unit += G) {
                const int r0 = unit * 64 + hh * 32, p0 = r0 & (SEQ - 1);
                float sum[8];
#pragma unroll
                for (int e = 0; e < 8; ++e) sum[e] = 0.f;
                for (int i = 1; i < w; ++i) { if (p0 - i >= 0) { const u32x4 v = *(const u32x4*)(U + (size_t)(r0 - i) * DI + col);
                    sum[0] += bf_lo(v.x); sum[1] += bf_hi(v.x); sum[2] += bf_lo(v.y); sum[3] += bf_hi(v.y); sum[4] += bf_lo(v.z); sum[5] += bf_hi(v.z); sum[6] += bf_lo(v.w); sum[7] += bf_hi(v.w); } }
                for (int t = 0; t < 32; ++t) {
                    const int p = p0 + t; const u32x4 v = *(const u32x4*)(U + (size_t)(r0 + t) * DI + col);
                    float c[8] = {bf_lo(v.x), bf_hi(v.x), bf_lo(v.y), bf_hi(v.y), bf_lo(v.z), bf_hi(v.z), bf_lo(v.w), bf_hi(v.w)};
                    const float rc = 1.0f / (float)((p + 1) < w ? (p + 1) : w);
                    float o[8];
#pragma unroll
                    for (int e = 0; e < 8; ++e) { sum[e] += c[e]; o[e] = sum[e] * rc - c[e]; }
                    u32x4 wv; wv.x = cvt_pk_bf16(o[0], o[1]); wv.y = cvt_pk_bf16(o[2], o[3]); wv.z = cvt_pk_bf16(o[4], o[5]); wv.w = cvt_pk_bf16(o[6], o[7]);
                    *(u32x4*)(POOLED + (size_t)(r0 + t) * DI + col) = wv;
                    if (p - w + 1 >= 0) { const u32x4 q = *(const u32x4*)(U + (size_t)(r0 + t - w + 1) * DI + col);
                        sum[0] -= bf_lo(q.x); sum[1] -= bf_hi(q.x); sum[2] -= bf_lo(q.y); sum[3] -= bf_hi(q.y); sum[4] -= bf_lo(q.z); sum[5] -= bf_hi(q.z); sum[6] -= bf_lo(q.w); sum[7] -= bf_hi(q.w); }
                }
            }
        }
        SYNC(2);
        if (IN(3) && (PH_MASK & 8)) {
            int tid = threadIdx.x; asm volatile("" : "+v"(tid)); const int lane = tid & 63, wave = __builtin_amdgcn_readfirstlane(tid >> 6); (void)lane; (void)wave;
            pg8::Gemm<DI, 512, 512> g{POOLED, WP}; pg8::StaticOrder S; S.init(M, DI, G, bx);
            pg8::EpiGate E{U, SZ0, pool_scale0}; pg8::MapPool MP;
            pg8::gemm_phase(lds, g, S, MP, E);
        }
        SYNC(3);
        if (IN(4) && (PH_MASK & 16)) {
            int tid = threadIdx.x; asm volatile("" : "+v"(tid)); const int lane = tid & 63, wave = __builtin_amdgcn_readfirstlane(tid >> 6); (void)lane; (void)wave;
            pg8::Gemm<DI, DI, DI> g{U, WOUT0}; pg8::StaticOrder S; S.init(M, D, G, bx);
            pg8::EpiRes E{XIN, out}; pg8::MapPlain<DI, DI> MP;
            pg8::gemm_phase(lds, g, S, MP, E);
        }
        SYNC(4);
        if (IN(5) && (PH_MASK & 32)) {
            int tid = threadIdx.x; asm volatile("" : "+v"(tid)); const int lane = tid & 63, wave = __builtin_amdgcn_readfirstlane(tid >> 6); (void)lane; (void)wave;
            const int gw = bx * 8 + wave, NGW = G * 8;
            for (int m = gw; m < M; m += NGW) rms_row(out + (size_t)m * D, norm1, H1 + (size_t)m * D, lane);
        }
        SYNC(5);
#pragma unroll
        for (int g = 0; g < NG; ++g) {
            const int pb = 6 + 4 * g;
            if (IN(pb) && (PH_MASK & 64)) {
            int tid = threadIdx.x; asm volatile("" : "+v"(tid)); const int lane = tid & 63, wave = __builtin_amdgcn_readfirstlane(tid >> 6); (void)lane; (void)wave;
                if (g > 0) { const int gc = g - 1;
                for (int idx = bx * NTHREADS + tid; idx < M * HG * 16; idx += G * NTHREADS) {
                    const int pair = idx >> 4, ch = idx & 15, m = pair >> 2, hl = pair & 3;
                    const unsigned sel = SEL[(size_t)m * NH + gc * HG + hl];
                    float o[8]; float l = LPART[(size_t)pair * 4 + 3];
                    { const u32x4 v = *(const u32x4*)(OPART + ((size_t)pair * 4 + 3) * HD + ch * 8);
                      o[0] = bf_lo(v.x); o[1] = bf_hi(v.x); o[2] = bf_lo(v.y); o[3] = bf_hi(v.y); o[4] = bf_lo(v.z); o[5] = bf_hi(v.z); o[6] = bf_lo(v.w); o[7] = bf_hi(v.w); }
#pragma unroll
                    for (int e = 0; e < 3; ++e) if (((sel >> (8 * e)) & 0xffu) != 0xffu) {
                        const u32x4 v = *(const u32x4*)(OPART + ((size_t)pair * 4 + e) * HD + ch * 8); l += LPART[(size_t)pair * 4 + e];
                        o[0] += bf_lo(v.x); o[1] += bf_hi(v.x); o[2] += bf_lo(v.y); o[3] += bf_hi(v.y); o[4] += bf_lo(v.z); o[5] += bf_hi(v.z); o[6] += bf_lo(v.w); o[7] += bf_hi(v.w); }
                    const float rl = 1.0f / l;
                                        u32x4 w; w.x = cvt_pk_bf16(o[0] * rl, o[1] * rl); w.y = cvt_pk_bf16(o[2] * rl, o[3] * rl);
                    w.z = cvt_pk_bf16(o[4] * rl, o[5] * rl); w.w = cvt_pk_bf16(o[6] * rl, o[7] * rl);
                    *(u32x4*)(AT + (size_t)m * DI + gc * GW + hl * HD + ch * 8) = w;
                }
                }
                pg8::Gemm<D, D, D> gm{H1, WIN1}; pg8::StaticOrder S; S.init(M, 4 * GW, G, bx);
                pg8::EpiSplit<GW, 2, 3> E{QG, KG, VG, SZG}; pg8::MapQkvz MP{g};
                pg8::gemm_phase(lds, gm, S, MP, E);
            }
            SYNC(pb);
            if (IN(pb + 1) && (PH_MASK & 128)) {
            int tid = threadIdx.x; asm volatile("" : "+v"(tid)); const int lane = tid & 63, wave = __builtin_amdgcn_readfirstlane(tid >> 6); (void)lane; (void)wave;
                LAS float* wsum = (LAS float*)lds;
                const int j8 = (lane & 7) * 8, rsub = lane >> 3;
                f32x4 gq[4], gk[4];
                gq[0] = *(const f32x4*)(q_norm1 + j8); gq[1] = *(const f32x4*)(q_norm1 + j8 + 4); gq[2] = *(const f32x4*)(q_norm1 + 64 + j8); gq[3] = *(const f32x4*)(q_norm1 + 68 + j8);
                gk[0] = *(const f32x4*)(k_norm1 + j8); gk[1] = *(const f32x4*)(k_norm1 + j8 + 4); gk[2] = *(const f32x4*)(k_norm1 + 64 + j8); gk[3] = *(const f32x4*)(k_norm1 + 68 + j8);
#pragma unroll 1
                for (int unit = bx; unit < 8 * NB; unit += G) {
                    const int bh = unit >> 5, n = unit & 31, b = bh >> 2, hl = bh & 3;
                    float ks[16];
#pragma unroll
                    for (int e = 0; e < 16; ++e) ks[e] = 0.f;
#pragma unroll 1
                    for (int hb = 0; hb < 2; ++hb) {
                    u32x4 ka[2], kc[2], qa[2], qc[2]; f32x4 tb[2][4];
#pragma unroll
                    for (int it = 0; it < 2; ++it) {
                        const int pos = n * BLK + wave * 32 + (hb * 2 + it) * 8 + rsub;
                        const size_t off = (size_t)(b * SEQ + pos) * GW + hl * HD + j8;
                        ka[it] = *(const u32x4*)(KG + off); kc[it] = *(const u32x4*)(KG + off + 64);
                        qa[it] = *(const u32x4*)(QG + off); qc[it] = *(const u32x4*)(QG + off + 64);
                        const f32x4* tp = (const f32x4*)(TAB + pos * 64 + j8);
                        tb[it][0] = tp[0]; tb[it][1] = tp[1]; tb[it][2] = tp[2]; tb[it][3] = tp[3];
                    }
#pragma unroll
                    for (int it = 0; it < 2; ++it) {
                        const int pos = n * BLK + wave * 32 + (hb * 2 + it) * 8 + rsub;
                        const size_t off = (size_t)(b * SEQ + pos) * GW + hl * HD + j8;
                        float cs[8], sn[8];
#pragma unroll
                        for (int e = 0; e < 4; ++e) { cs[2 * e] = tb[it][e].x; sn[2 * e] = tb[it][e].y; cs[2 * e + 1] = tb[it][e].z; sn[2 * e + 1] = tb[it][e].w; }
#pragma unroll
                        for (int which = 0; which < 2; ++which) {
                            const u32x4 va = which == 0 ? ka[it] : qa[it], vc = which == 0 ? kc[it] : qc[it];
                            float x1[8] = {bf_lo(va.x), bf_hi(va.x), bf_lo(va.y), bf_hi(va.y), bf_lo(va.z), bf_hi(va.z), bf_lo(va.w), bf_hi(va.w)};
                            float x2[8] = {bf_lo(vc.x), bf_hi(vc.x), bf_lo(vc.y), bf_hi(vc.y), bf_lo(vc.z), bf_hi(vc.z), bf_lo(vc.w), bf_hi(vc.w)};
                            float ss = 0.f;
#pragma unroll
                            for (int e = 0; e < 8; ++e) ss += x1[e] * x1[e] + x2[e] * x2[e];
                            ss += __shfl_xor(ss, 1); ss += __shfl_xor(ss, 2); ss += __shfl_xor(ss, 4);
                            const float rstd = (which == 0 ? 1.0f : QSCALE) / sqrtf(ss * (1.f / HD) + EPS);
                            float o1[8], o2[8];
#pragma unroll
                            for (int e = 0; e < 8; ++e) {
                                const float g1 = which == 0 ? gk[e >> 2][e & 3] : gq[e >> 2][e & 3], g2 = which == 0 ? gk[2 + (e >> 2)][e & 3] : gq[2 + (e >> 2)][e & 3];
                                const float y1 = x1[e] * rstd * g1, y2 = x2[e] * rstd * g2;
                                o1[e] = y1 * cs[e] - y2 * sn[e]; o2[e] = y2 * cs[e] + y1 * sn[e];
                                if (which == 0) { ks[e] += o1[e]; ks[8 + e] += o2[e]; }
                            }
                            u32x4 w1, w2;
                            w1.x = cvt_pk_bf16(o1[0], o1[1]); w1.y = cvt_pk_bf16(o1[2], o1[3]); w1.z = cvt_pk_bf16(o1[4], o1[5]); w1.w = cvt_pk_bf16(o1[6], o1[7]);
                            w2.x = cvt_pk_bf16(o2[0], o2[1]); w2.y = cvt_pk_bf16(o2[2], o2[3]); w2.z = cvt_pk_bf16(o2[4], o2[5]); w2.w = cvt_pk_bf16(o2[6], o2[7]);
                            bf16_t* dstp = which == 0 ? KG : QG;
                            *(u32x4*)(dstp + off) = w1; *(u32x4*)(dstp + off + 64) = w2;
                        }
                    }
                    }
#pragma unroll
                    for (int e = 0; e < 16; ++e) { float v = ks[e]; v += __shfl_xor(v, 8); v += __shfl_xor(v, 16); v += __shfl_xor(v, 32); ks[e] = v; }
                    if (lane < 8) {
#pragma unroll
                        for (int e = 0; e < 8; ++e) { wsum[wave * 128 + j8 + e] = ks[e]; wsum[wave * 128 + 64 + j8 + e] = ks[8 + e]; }
                    }
                    __syncthreads();
                    if (tid < 128) { float sv = 0.f;
#pragma unroll
                        for (int w8 = 0; w8 < 8; ++w8) sv += wsum[w8 * 128 + tid];
                        KMEAN[((size_t)(g * 8 + bh) * NB + n) * HD + tid] = sv * (1.f / BLK); }
                    __syncthreads();
                }
            }
            SYNC(pb + 1);
            if (IN(pb + 2) && (PH_MASK & 256)) {
            int tid = threadIdx.x; asm volatile("" : "+v"(tid)); const int lane = tid & 63, wave = __builtin_amdgcn_readfirstlane(tid >> 6); (void)lane; (void)wave;
                LAS float* km = (LAS float*)lds;
                LAS float* mv = (LAS float*)(lds + 16384);
                LAS int* mi = (LAS int*)(lds + 16384 + 3072);
                LAS unsigned* lcnt = (LAS unsigned*)(lds + 16384 + 6144);
                LAS unsigned* lbase = lcnt + 32;
                if (tid < 32) lcnt[tid] = 0u;
                __syncthreads();
#pragma unroll 1
                for (int unit = bx; unit < 8 * NB; unit += G) {
                    const int bh = unit >> 5, qb = unit & 31, b = bh >> 2, hl = bh & 3;
                    const int qi = tid & 255, hf = tid >> 8;
                    const int s = qb * BLK + qi; const size_t mrow = (size_t)b * SEQ + s;
                    if (qb > 0) {
                        u32x4 qv[16];
#pragma unroll
                        for (int c = 0; c < 16; ++c) qv[c] = *(const u32x4*)(QG + mrow * GW + hl * HD + c * 8);
                        for (int c = tid; c < qb * 32; c += NTHREADS) *(LAS f32x4*)(km + c * 4) = *(const f32x4*)(KMEAN + (size_t)(g * 8 + bh) * NB * HD + c * 4);
                        __syncthreads();
                        float v0 = -INFINITY, v1 = -INFINITY, v2 = -INFINITY; int i0 = 255, i1 = 255, i2 = 255;
#pragma unroll 1
                        for (int n = hf; n < qb; n += 2) {
                            float acc = 0.f;
#pragma unroll
                            for (int c = 0; c < 16; ++c) { const f32x4 ka = *(const LAS f32x4*)(km + n * 128 + c * 8), kb = *(const LAS f32x4*)(km + n * 128 + c * 8 + 4);
                                acc += bf_lo(qv[c].x) * ka.x + bf_hi(qv[c].x) * ka.y + bf_lo(qv[c].y) * ka.z + bf_hi(qv[c].y) * ka.w + bf_lo(qv[c].z) * kb.x + bf_hi(qv[c].z) * kb.y + bf_lo(qv[c].w) * kb.z + bf_hi(qv[c].w) * kb.w; }
                            if (acc > v0) { v2 = v1; i2 = i1; v1 = v0; i1 = i0; v0 = acc; i0 = n; }
                            else if (acc > v1) { v2 = v1; i2 = i1; v1 = acc; i1 = n; }
                            else if (acc > v2) { v2 = acc; i2 = n; }
                        }
                        if (hf == 1) { mv[qi * 3] = v0; mv[qi * 3 + 1] = v1; mv[qi * 3 + 2] = v2; mi[qi * 3] = i0; mi[qi * 3 + 1] = i1; mi[qi * 3 + 2] = i2; }
                        __syncthreads();
                        unsigned rk0 = 0, rk1 = 0, rk2 = 0;
                        if (hf == 0) {
#pragma unroll
                            for (int e = 0; e < 3; ++e) { const float acc = mv[qi * 3 + e]; const int n = mi[qi * 3 + e];
                                if (n < 255) {
                                    const bool g0 = acc > v0 || (acc == v0 && n < i0), g1 = acc > v1 || (acc == v1 && n < i1), g2 = acc > v2 || (acc == v2 && n < i2);
                                    if (g0) { v2 = v1; i2 = i1; v1 = v0; i1 = i0; v0 = acc; i0 = n; }
                                    else if (g1) { v2 = v1; i2 = i1; v1 = acc; i1 = n; }
                                    else if (g2) { v2 = acc; i2 = n; }
                                } }
                            SEL[mrow * NH + g * HG + hl] = (unsigned)i0 | ((unsigned)i1 << 8) | ((unsigned)i2 << 16);
                            if (i0 < 255) rk0 = atomicAdd((unsigned*)&lcnt[i0], 1u);
                            if (i1 < 255) rk1 = atomicAdd((unsigned*)&lcnt[i1], 1u);
                            if (i2 < 255) rk2 = atomicAdd((unsigned*)&lcnt[i2], 1u);
                        }
                        __syncthreads();
                        if (tid < 32) { const unsigned c = lcnt[tid]; lbase[tid] = c ? atomicAdd(&CNT[g * 256 + bh * NB + tid], c) : 0u; lcnt[tid] = 0u; }
                        __syncthreads();
                        if (hf == 0) {
                            if (i0 < 255) LIST[(size_t)(bh * NB + i0) * SEQ + lbase[i0] + rk0] = (unsigned short)(s | (0 << 13));
                            if (i1 < 255) LIST[(size_t)(bh * NB + i1) * SEQ + lbase[i1] + rk1] = (unsigned short)(s | (1 << 13));
                            if (i2 < 255) LIST[(size_t)(bh * NB + i2) * SEQ + lbase[i2] + rk2] = (unsigned short)(s | (2 << 13));
                        }
                        __syncthreads();
                    } else if (hf == 0) {
                        SEL[mrow * NH + g * HG + hl] = 0x00ffffffu;
                    }
                }
            }
            SYNC(pb + 2);
            if (IN(pb + 3) && (PH_MASK & 512)) {
            int tid = threadIdx.x; asm volatile("" : "+v"(tid)); const int lane = tid & 63, wave = __builtin_amdgcn_readfirstlane(tid >> 6); (void)lane; (void)wave;
                LAS unsigned char* Ks = lds;
                LAS unsigned char* Vt = lds + 256 * 272;
                LAS int* pre = (LAS int*)(lds + 256 * 272 + 128 * 528);
                LAS float* red = (LAS float*)(lds + 256 * 272 + 128 * 528 + 2048);
                {
                    float mq = 0.f, mk = 0.f;
                    if (tid < 128) { mq = fabsf(q_norm1[tid]); mk = fabsf(k_norm1[tid]); }
#pragma unroll
                    for (int o = 1; o < 64; o <<= 1) { mq = fmaxf(mq, __shfl_xor(mq, o)); mk = fmaxf(mk, __shfl_xor(mk, o)); }
                    if (lane == 0) { red[wave * 2] = mq; red[wave * 2 + 1] = mk; }
                    if (tid < 256) pre[tid + 1] = 1 + (int)((CNT[g * 256 + tid] + 255u) >> 8);
                    if (tid == 0) pre[0] = 0;
                    __syncthreads();
                    if (tid == 0) { int a = 0; for (int i = 1; i <= 256; ++i) { a += pre[i]; pre[i] = a; } }
                    __syncthreads();
                }
                const float MSH = 128.0f * QSCALE * fmaxf(red[0], red[2]) * fmaxf(red[1], red[3]) * 1.02f;
                const int total = pre[256];
                const int fr = lane & 15, fq = lane >> 4;
                const int istart = (int)(((long)total * bx) / G), iend = (int)(((long)total * (bx + 1)) / G);
                int cur_li = -1;
#pragma unroll 1
                for (int item = istart; item < iend; ++item) {
                    int loi = 0, hii = 256;
                    while (hii - loi > 1) { const int mid = (loi + hii) >> 1; if (pre[mid] <= item) loi = mid; else hii = mid; }
                    const int li = loi, c = item - pre[li], bh = li >> 5, n = li & 31, b = bh >> 2, hl = bh & 3;
                    const int cnt = (int)CNT[g * 256 + li];
                    const size_t rowbase = (size_t)b * SEQ;
                    const bool restage = (li != cur_li); cur_li = li;
                    if (restage) {
                    __syncthreads();
                    for (int cc = tid; cc < 256 * 16; cc += NTHREADS) { const int r = cc >> 4, c16 = cc & 15;
                        *(LAS u32x4*)(Ks + r * 272 + c16 * 16) = *(const u32x4*)(KG + (rowbase + n * BLK + r) * GW + hl * HD + c16 * 8); }
                    for (int task = tid; task < 1024; task += NTHREADS) {
                        const int a = (task & 15) | ((task >> 5) & 3) << 4, cch = ((task >> 4) & 1) | ((task >> 7) << 1);
                        u32x4 v[4];
#pragma unroll
                        for (int kk = 0; kk < 4; ++kk) v[kk] = *(const u32x4*)(VG + (rowbase + n * BLK + a * 4 + kk) * GW + hl * HD + cch * 8);
#pragma unroll
                        for (int e = 0; e < 4; ++e) {
                            const unsigned w0 = e == 0 ? v[0].x : e == 1 ? v[0].y : e == 2 ? v[0].z : v[0].w, w1 = e == 0 ? v[1].x : e == 1 ? v[1].y : e == 2 ? v[1].z : v[1].w;
                            const unsigned w2 = e == 0 ? v[2].x : e == 1 ? v[2].y : e == 2 ? v[2].z : v[2].w, w3 = e == 0 ? v[3].x : e == 1 ? v[3].y : e == 2 ? v[3].z : v[3].w;
                            u32x2 lo2, hi2;
                            lo2.x = (w0 & 0xffffu) | (w1 << 16); lo2.y = (w2 & 0xffffu) | (w3 << 16);
                            hi2.x = (w0 >> 16) | (w1 & 0xffff0000u); hi2.y = (w2 >> 16) | (w3 & 0xffff0000u);
                            *(LAS u32x2*)(Vt + (cch * 8 + 2 * e) * 528 + a * 8) = lo2;
                            *(LAS u32x2*)(Vt + (cch * 8 + 2 * e + 1) * 528 + a * 8) = hi2;
                        }
                    }
                    }
                    int qpos[2], qslot[2]; bool qok[2];
                    bf16x8 qf[2][4];
#pragma unroll
                    for (int t = 0; t < 2; ++t) {
                        const int ridx = wave * 32 + t * 16 + fr;
                        if (c == 0) { qpos[t] = n * BLK + ridx; qslot[t] = 3; qok[t] = true; }
                        else { const int lidx = (c - 1) * 256 + ridx; qok[t] = lidx < cnt; const unsigned e = LIST[(size_t)li * SEQ + (qok[t] ? lidx : 0)]; qpos[t] = e & 8191; qslot[t] = e >> 13; }
                        const bf16_t* qp = QG + (rowbase + qpos[t]) * GW + hl * HD + fq * 8;
#pragma unroll
                        for (int ks = 0; ks < 4; ++ks) qf[t][ks] = *(const bf16x8*)(qp + ks * 32);
                    }
                    if (restage) __syncthreads();
                    f32x4 oacc[2][8], lacc[2];
#pragma unroll
                    for (int t = 0; t < 2; ++t) { lacc[t] = (f32x4){0.f, 0.f, 0.f, 0.f};
#pragma unroll
                        for (int dt = 0; dt < 8; ++dt) oacc[t][dt] = (f32x4){0.f, 0.f, 0.f, 0.f}; }
                    const int qrel0 = qpos[0] - n * BLK, qrel1 = qpos[1] - n * BLK;
                    const int kg_end = (c == 0) ? wave + 1 : 8;
                    const bf16x8 ones = {0x3F80, 0x3F80, 0x3F80, 0x3F80, 0x3F80, 0x3F80, 0x3F80, 0x3F80};
                    bf16x8 kf[2][4];
#pragma unroll
                    for (int kt = 0; kt < 2; ++kt)
#pragma unroll
                        for (int ks = 0; ks < 4; ++ks) kf[kt][ks] = *(const LAS bf16x8*)(Ks + (kt * 16 + fr) * 272 + ks * 64 + fq * 16);
#pragma unroll 1
                    for (int kg = 0; kg < kg_end; ++kg) {
                        u32x2 va[8], vb[8];
#pragma unroll
                        for (int dt = 0; dt < 8; ++dt) { va[dt] = *(const LAS u32x2*)(Vt + (dt * 16 + fr) * 528 + kg * 64 + fq * 8); vb[dt] = *(const LAS u32x2*)(Vt + (dt * 16 + fr) * 528 + kg * 64 + 32 + fq * 8); }
                        __builtin_amdgcn_sched_barrier(0);
                        f32x4 sacc[2][2];
#pragma unroll
                        for (int kt = 0; kt < 2; ++kt) { sacc[kt][0] = (f32x4){-MSH, -MSH, -MSH, -MSH}; sacc[kt][1] = (f32x4){-MSH, -MSH, -MSH, -MSH}; }
#pragma unroll
                        for (int ks = 0; ks < 4; ++ks)
#pragma unroll
                            for (int kt = 0; kt < 2; ++kt) {
                                sacc[kt][0] = __builtin_amdgcn_mfma_f32_16x16x32_bf16(kf[kt][ks], qf[0][ks], sacc[kt][0], 0, 0, 0);
                                sacc[kt][1] = __builtin_amdgcn_mfma_f32_16x16x32_bf16(kf[kt][ks], qf[1][ks], sacc[kt][1], 0, 0, 0); }
                        __builtin_amdgcn_sched_barrier(0);
                        if (kg + 1 < kg_end) {
#pragma unroll
                            for (int kt = 0; kt < 2; ++kt)
#pragma unroll
                                for (int ks = 0; ks < 4; ++ks) kf[kt][ks] = *(const LAS bf16x8*)(Ks + ((kg + 1) * 32 + kt * 16 + fr) * 272 + ks * 64 + fq * 16);
                        }
                        bf16x8 pb[2];
                        if (c == 0 && kg == wave) {
#pragma unroll
                            for (int t = 0; t < 2; ++t) {
                                float p[8];
#pragma unroll
                                for (int kt = 0; kt < 2; ++kt)
#pragma unroll
                                    for (int j = 0; j < 4; ++j) { float pv = __builtin_amdgcn_exp2f(sacc[kt][t][j]);
                                        const int key = kg * 32 + kt * 16 + fq * 4 + j; if (key > (t == 0 ? qrel0 : qrel1)) pv = 0.f;
                                        p[kt * 4 + j] = pv; }
                                u32x4 w; w.x = cvt_pk_bf16(p[0], p[1]); w.y = cvt_pk_bf16(p[2], p[3]); w.z = cvt_pk_bf16(p[4], p[5]); w.w = cvt_pk_bf16(p[6], p[7]);
                                pb[t] = __builtin_bit_cast(bf16x8, w);
                            }
                        } else {
#pragma unroll
                            for (int t = 0; t < 2; ++t) {
                                u32x4 w;
                                w.x = cvt_pk_bf16(__builtin_amdgcn_exp2f(sacc[0][t][0]), __builtin_amdgcn_exp2f(sacc[0][t][1])); w.y = cvt_pk_bf16(__builtin_amdgcn_exp2f(sacc[0][t][2]), __builtin_amdgcn_exp2f(sacc[0][t][3]));
                                w.z = cvt_pk_bf16(__builtin_amdgcn_exp2f(sacc[1][t][0]), __builtin_amdgcn_exp2f(sacc[1][t][1])); w.w = cvt_pk_bf16(__builtin_amdgcn_exp2f(sacc[1][t][2]), __builtin_amdgcn_exp2f(sacc[1][t][3]));
                                pb[t] = __builtin_bit_cast(bf16x8, w);
                            }
                        }
                        __builtin_amdgcn_sched_barrier(0);
                        lacc[0] = __builtin_amdgcn_mfma_f32_16x16x32_bf16(ones, pb[0], lacc[0], 0, 0, 0);
                        lacc[1] = __builtin_amdgcn_mfma_f32_16x16x32_bf16(ones, pb[1], lacc[1], 0, 0, 0);
#pragma unroll
                        for (int dt = 0; dt < 8; ++dt) {
                            u32x4 vv; vv.x = va[dt].x; vv.y = va[dt].y; vv.z = vb[dt].x; vv.w = vb[dt].y; const bf16x8 vf = __builtin_bit_cast(bf16x8, vv);
                            oacc[0][dt] = __builtin_amdgcn_mfma_f32_16x16x32_bf16(vf, pb[0], oacc[0][dt], 0, 0, 0);
                            oacc[1][dt] = __builtin_amdgcn_mfma_f32_16x16x32_bf16(vf, pb[1], oacc[1][dt], 0, 0, 0);
                        }
                    }
#pragma unroll
                    for (int t = 0; t < 2; ++t) {
                        const float l = lacc[t][0];
                        if (qok[t]) {
                            const size_t pair = (rowbase + qpos[t]) * HG + hl;
                            bf16_t* op = OPART + (pair * 4 + qslot[t]) * HD + fq * 4;
                            const bf16_t* zp = SZG + (rowbase + qpos[t]) * GW + hl * HD + fq * 4;
                            u32x2 zz[8];
#pragma unroll
                            for (int dt = 0; dt < 8; ++dt) zz[dt] = *(const u32x2*)(zp + dt * 16);
#pragma unroll
                            for (int dt = 0; dt < 8; ++dt) { u32x2 w; w.x = cvt_pk_bf16(oacc[t][dt][0] * bf_lo(zz[dt].x), oacc[t][dt][1] * bf_hi(zz[dt].x)); w.y = cvt_pk_bf16(oacc[t][dt][2] * bf_lo(zz[dt].y), oacc[t][dt][3] * bf_hi(zz[dt].y)); *(u32x2*)(op + dt * 16) = w; }
                            if (fq == 0) LPART[pair * 4 + qslot[t]] = l;
                        }
                    }
                }
            }
            SYNC(pb + 3);
        }
        if (IN(6 + 4 * NG) && (PH_MASK & 1024)) {
            int tid = threadIdx.x; asm volatile("" : "+v"(tid)); const int lane = tid & 63, wave = __builtin_amdgcn_readfirstlane(tid >> 6); (void)lane; (void)wave;
            { const int gc = NG - 1;
                for (int idx = bx * NTHREADS + tid; idx < M * HG * 16; idx += G * NTHREADS) {
                    const int pair = idx >> 4, ch = idx & 15, m = pair >> 2, hl = pair & 3;
                    const unsigned sel = SEL[(size_t)m * NH + gc * HG + hl];
                    float o[8]; float l = LPART[(size_t)pair * 4 + 3];
                    { const u32x4 v = *(const u32x4*)(OPART + ((size_t)pair * 4 + 3) * HD + ch * 8);
                      o[0] = bf_lo(v.x); o[1] = bf_hi(v.x); o[2] = bf_lo(v.y); o[3] = bf_hi(v.y); o[4] = bf_lo(v.z); o[5] = bf_hi(v.z); o[6] = bf_lo(v.w); o[7] = bf_hi(v.w); }
#pragma unroll
                    for (int e = 0; e < 3; ++e) if (((sel >> (8 * e)) & 0xffu) != 0xffu) {
                        const u32x4 v = *(const u32x4*)(OPART + ((size_t)pair * 4 + e) * HD + ch * 8); l += LPART[(size_t)pair * 4 + e];
                        o[0] += bf_lo(v.x); o[1] += bf_hi(v.x); o[2] += bf_lo(v.y); o[3] += bf_hi(v.y); o[4] += bf_lo(v.z); o[5] += bf_hi(v.z); o[6] += bf_lo(v.w); o[7] += bf_hi(v.w); }
                    const float rl = 1.0f / l;
                                        u32x4 w; w.x = cvt_pk_bf16(o[0] * rl, o[1] * rl); w.y = cvt_pk_bf16(o[2] * rl, o[3] * rl);
                    w.z = cvt_pk_bf16(o[4] * rl, o[5] * rl); w.w = cvt_pk_bf16(o[6] * rl, o[7] * rl);
                    *(u32x4*)(AT + (size_t)m * DI + gc * GW + hl * HD + ch * 8) = w;
                }
            }
        }
        SYNC(6 + 4 * NG);
        if (IN(7 + 4 * NG) && (PH_MASK & 2048)) {
            int tid = threadIdx.x; asm volatile("" : "+v"(tid)); const int lane = tid & 63, wave = __builtin_amdgcn_readfirstlane(tid >> 6); (void)lane; (void)wave;
            pg8::Gemm<DI, DI, DI> gm{AT, WOUT1}; pg8::StaticOrder S; S.init(M, D, G, bx);
            pg8::EpiRes E{out, out}; pg8::MapPlain<DI, DI> MP;
            pg8::gemm_phase(lds, gm, S, MP, E);
        }
    }
}

constexpr int NPHASES = 6 + 4 * NG + 2;

extern "C" void kernel_launch(void* const* d_in, const int* in_sizes, int n_in, void* d_out, int out_size, void* d_ws, size_t ws_size, hipStream_t stream) {
    static int grid = 0;
    if (grid == 0) {
        int dev = 0, cus = 0, per_cu = 0;
        hipGetDevice(&dev);
        hipDeviceGetAttribute(&cus, hipDeviceAttributeMultiprocessorCount, dev);
        hipFuncSetAttribute((const void*)mega_fwd, hipFuncAttributeMaxDynamicSharedMemorySize, LDS_BYTES);
        hipOccupancyMaxActiveBlocksPerMultiprocessor(&per_cu, (const void*)mega_fwd, NTHREADS, LDS_BYTES);
        if (per_cu < 1) { fprintf(stderr, "kernel_launch: occupancy query says %d blocks per CU\n", per_cu); per_cu = 1; }
        grid = cus;
        if (ws_size < WS_END) fprintf(stderr, "kernel_launch: workspace too small: %zu < %zu\n", ws_size, (size_t)WS_END);
    }
    hipMemsetAsync((char*)d_ws + WS_CTL, 0, CTL_BYTES, stream);
    Args a{};
    for (int i = 0; i < 11; ++i) a.in[i] = (const float*)d_in[i];
    a.out = (float*)d_out; a.ws = (unsigned char*)d_ws; a.pad = 0;
#if defined(MK_PER_PHASE)
    for (int ph = 0; ph < NPHASES; ++ph) { a.ph_lo = ph; a.ph_hi = ph + 1; a.coop = 0; hipLaunchKernelGGL(mega_fwd, dim3(grid), dim3(NTHREADS), LDS_BYTES, stream, a); }
#else
    a.ph_lo = 0; a.ph_hi = NPHASES; a.coop = 1;
    void* kargs[] = {&a};
    hipError_t e = hipLaunchCooperativeKernel((const void*)mega_fwd, dim3(grid), dim3(NTHREADS), kargs, LDS_BYTES, stream);
    if (e != hipSuccess) fprintf(stderr, "cooperative launch failed: %s (grid %d)\n", hipGetErrorString(e), grid);
#endif
}
```

```cpp
#include <hip/hip_runtime.h>
#include <hip/hip_cooperative_groups.h>
#include <cstdio>
#include <cstdint>
namespace cg = cooperative_groups;

#define LAS __attribute__((address_space(3)))
typedef unsigned short bf16_t;
typedef short bf16x8 __attribute__((ext_vector_type(8)));
typedef float f32x4 __attribute__((ext_vector_type(4)));
typedef float f32x2 __attribute__((ext_vector_type(2)));
typedef unsigned u32x4 __attribute__((ext_vector_type(4)));
typedef unsigned u32x2 __attribute__((ext_vector_type(2)));

constexpr int SEQ = 8192, NBATCH = 2, M = NBATCH * SEQ, D = 1024, DI = 2048, NH = 16, HD = 128, BLK = 256, NB = SEQ / BLK;
constexpr int NG = 4, HG = NH / NG, GW = HG * HD;
constexpr float EPS = 1e-6f;
constexpr float QSCALE = 0.08838834764831845f * 1.4426950408889634f;

constexpr size_t MiB = 1u << 20;
constexpr size_t WS_CTL = 0, CTL_BYTES = 65536;
constexpr size_t WS_BAR = 8192;
constexpr size_t WS_KMEAN = 1 * MiB;
constexpr size_t WS_SEL = 2 * MiB;
constexpr size_t WS_LPART = 3 * MiB;
constexpr size_t WS_TAB = 4 * MiB;
constexpr size_t WS_WIN1 = 8 * MiB, WS_WOUT1 = 24 * MiB;
constexpr size_t WS_LIST = 28 * MiB;
constexpr size_t WS_WIN0 = 28 * MiB, WS_WP = 36 * MiB, WS_WOUT0 = 38 * MiB;
constexpr size_t WS_H0 = 42 * MiB, WS_POOLED = 42 * MiB, WS_U = 106 * MiB, WS_SZ0 = 170 * MiB;
constexpr size_t WS_H1 = 32 * MiB, WS_QG = 64 * MiB, WS_KG = 80 * MiB, WS_VG = 96 * MiB, WS_SZG = 112 * MiB;
constexpr size_t WS_OPART = 128 * MiB, WS_A = 192 * MiB, WS_END = 256 * MiB;

constexpr int LDS_BYTES = 140 * 1024;
constexpr int NTHREADS = 512;
#ifndef PH_MASK
#define PH_MASK 0xfff
#endif

__device__ __forceinline__ unsigned cvt_pk_bf16(float lo, float hi) { unsigned r; asm volatile("v_cvt_pk_bf16_f32 %0, %1, %2" : "=v"(r) : "v"(lo), "v"(hi)); return r; }
__device__ __forceinline__ float bf_lo(unsigned u) { return __uint_as_float(u << 16); }
__device__ __forceinline__ float bf_hi(unsigned u) { return __uint_as_float(u & 0xffff0000u); }
__device__ __forceinline__ float silu_f(float z) { return z * __builtin_amdgcn_rcpf(1.0f + __builtin_amdgcn_exp2f(-1.4426950408889634f * z)); }
__device__ __forceinline__ float wave_sum(float v) {
#pragma unroll
    for (int o = 1; o < 64; o <<= 1) v += __shfl_xor(v, o);
    return v;
}

namespace pg8 {
constexpr int BM = 256, BK = 64, HALF = 128, HTB = HALF * BK * 2, STAGE_BYTES = 8 * HTB, NXCD = 8, WGM = 8;
__host__ __device__ __forceinline__ int lds_byte(int r, int c) { const int st = (r >> 4) * 2 + (c >> 5), rr = r & 15, cc = c & 31, ob = rr * 64 + cc * 2; return st * 1024 + (ob ^ (((ob >> 9) & 1) << 5)); }
__host__ __device__ __forceinline__ void stage_rc(int b, int& R, int& C) { const int st = b / 1024, sb = b % 1024, swz = sb ^ (((sb >> 9) & 1) << 5); R = (st >> 1) * 16 + swz / 64; C = (st & 1) * 32 + (swz % 64) / 2; }
__host__ __device__ __forceinline__ int perm32(int rho) { const int n = rho >> 4, i = rho & 15; return 8 * (i >> 2) + 4 * n + (i & 3); }

struct Unit { int pm, pn; };
template <int LDA_, int LDB_, int K_> struct Gemm { const bf16_t* A; const bf16_t* Bt; static constexpr int lda = LDA_, ldb = LDB_, K = K_; };
struct StaticOrder {
    int nM, nN, nwg, G, c, base = 0, nr = 1 << 30;
    __device__ void init(int M_, int N_, int G_, int c_) { nM = M_ / BM; nN = N_ / BM; nwg = nM * nN; G = G_; c = c_; }
    __device__ bool next(int i, Unit& u) const {
        if (i >= nr) return false;
        const long L = (long)(base + i) * G + c; if (L >= nwg) return false;
        int wgid = (int)L; { const int q = nwg / NXCD, r = nwg % NXCD, xcd = wgid % NXCD, off = wgid / NXCD; wgid = (xcd < r ? xcd * (q + 1) : r * (q + 1) + (xcd - r) * q) + off; }
        const int nig = WGM * nN, gid = wgid / nig, fm = gid * WGM, gsz = (nM - fm) < WGM ? (nM - fm) : WGM;
        u.pm = fm + ((wgid % nig) % gsz); u.pn = (wgid % nig) / gsz; return true;
    }
};
template <class Epi, class Map, class GemmT>
__device__ __forceinline__ void gemm_phase(LAS unsigned char* lds, const GemmT g, const StaticOrder& S, const Map& MP, const Epi& E) {
    int tid_ = threadIdx.x; asm volatile("" : "+v"(tid_));
    const int tid = tid_, wid = __builtin_amdgcn_readfirstlane(tid >> 6), lane = tid & 63, wr = wid >> 2, wc = wid & 3, fr = lane & 15, fq = lane >> 4;
    constexpr int K = GemmT::K, nt = K / BK;
    unsigned voffA[2], voffB[2];
#pragma unroll
    for (int i = 0; i < 2; ++i) { int R, C; stage_rc(tid * 16 + i * 8192, R, C); const int Rb = Epi::PERM == 1 ? ((R & ~31) + perm32(R & 31)) : Epi::PERM == 2 ? (64 * ((R >> 4) & 1) + 16 * (R >> 5) + (R & 15)) : R;
        voffA[i] = (unsigned)(R * GemmT::lda + C) * 2u; voffB[i] = (unsigned)(Rb * GemmT::ldb + C) * 2u; }
    constexpr size_t kstep = (size_t)(BK * 2);
    constexpr size_t hstepA = (size_t)HALF * GemmT::lda * 2, hstepB = (size_t)HALF * GemmT::ldb * 2;
    const unsigned ldsw = (unsigned)wid * 1024u;
    const int aoff = lds_byte(wr * 64 + fr, fq * 8), boff = lds_byte(wc * 32 + fr, fq * 8);
#define PG8_SA(b, h) (((b) * 2 + (h)) * HTB)
#define PG8_SB(b, h) ((4 + (b) * 2 + (h)) * HTB)
#define PG8_STAGE(bufoff, gbase, voff) do { _Pragma("unroll") for (int _i = 0; _i < 2; ++_i) \
        __builtin_amdgcn_global_load_lds((const unsigned*)((const char*)(gbase) + (voff)[_i]), (LAS unsigned*)(lds + (bufoff) + ldsw + _i * 8192), 16, 0, 0); } while (0)
#define PG8_LDA(dst, b, h) do { _Pragma("unroll") for (int m = 0; m < 4; ++m) _Pragma("unroll") for (int k = 0; k < 2; ++k) dst[m][k] = *(const LAS bf16x8*)(lds + PG8_SA(b, h) + aoff + m * 2048 + k * 1024); } while (0)
#define PG8_LDB(dst, b, h) do { _Pragma("unroll") for (int n = 0; n < 2; ++n) _Pragma("unroll") for (int k = 0; k < 2; ++k) dst[n][k] = *(const LAS bf16x8*)(lds + PG8_SB(b, h) + boff + n * 2048 + k * 1024); } while (0)
#define PG8_MMA(ai, bj, At, Bt) do { __builtin_amdgcn_s_setprio(1); _Pragma("unroll") for (int m = 0; m < 4; ++m) _Pragma("unroll") for (int n = 0; n < 2; ++n) _Pragma("unroll") for (int k = 0; k < 2; ++k) \
        acc[ai][bj][m][n] = __builtin_amdgcn_mfma_f32_16x16x32_bf16(Bt[n][k], At[m][k], acc[ai][bj][m][n], 0, 0, 0); __builtin_amdgcn_s_setprio(0); } while (0)
#define PG8_WAIT_V(n) asm volatile("s_waitcnt vmcnt(" #n ")" ::: "memory")
#define PG8_WAIT_L(n) asm volatile("s_waitcnt lgkmcnt(" #n ")" ::: "memory")
#define PG8_BAR __builtin_amdgcn_s_barrier()
#define PG8_SCHED __builtin_amdgcn_sched_barrier(0)
    Unit cur, nxt; int ui = 0;
    if (!S.next(0, cur)) return;
    f32x4 acc[2][2][4][2];
#pragma unroll
    for (int a = 0; a < 2; ++a)
#pragma unroll
        for (int b = 0; b < 2; ++b)
#pragma unroll
            for (int m = 0; m < 4; ++m)
#pragma unroll
                for (int n = 0; n < 2; ++n) acc[a][b][m][n] = (f32x4){0.f, 0.f, 0.f, 0.f};
    bf16x8 At[4][2], B0[2][2], B1[2][2];
    const char* cA = (const char*)(g.A + MP.a_off(cur)); const char* cB = (const char*)(g.Bt + MP.b_off(cur));
    PG8_STAGE(PG8_SB(0, 0), cB, voffB); PG8_STAGE(PG8_SB(0, 1), cB + hstepB, voffB); PG8_STAGE(PG8_SA(0, 0), cA, voffA); PG8_STAGE(PG8_SA(0, 1), cA + hstepA, voffA);
    if (wr == 1) PG8_BAR;
    PG8_WAIT_V(2); PG8_BAR;
    PG8_STAGE(PG8_SB(1, 0), cB + kstep, voffB); PG8_STAGE(PG8_SA(1, 0), cA + kstep, voffA); PG8_STAGE(PG8_SB(1, 1), cB + hstepB + kstep, voffB);
    PG8_WAIT_V(6); PG8_BAR;
    for (;;) {
        const bool has_next = S.next(ui + 1, nxt);
        const char* nA = has_next ? (const char*)(g.A + MP.a_off(nxt)) : cA; const char* nB = has_next ? (const char*)(g.Bt + MP.b_off(nxt)) : cB;
        for (int t = 0; t < nt; t += 2) {
            const bool last = (t == nt - 2);
            const char* a1 = cA + (size_t)(t + 1) * kstep;
            const char* a2 = last ? nA : cA + (size_t)(t + 2) * kstep; const char* b2 = last ? nB : cB + (size_t)(t + 2) * kstep;
            const char* a3 = a2 + kstep; const char* b3 = b2 + kstep;
            PG8_LDB(B0, 0, 0); PG8_LDB(B1, 0, 1); PG8_SCHED; PG8_LDA(At, 0, 0); PG8_STAGE(PG8_SA(1, 1), a1 + hstepA, voffA);
            PG8_WAIT_V(8); PG8_WAIT_L(0); PG8_BAR; PG8_MMA(0, 0, At, B0); PG8_MMA(0, 1, At, B1); PG8_BAR; PG8_SCHED;
            PG8_LDA(At, 0, 1); PG8_STAGE(PG8_SB(0, 0), b2, voffB); PG8_STAGE(PG8_SB(0, 1), b2 + hstepB, voffB); PG8_STAGE(PG8_SA(0, 0), a2, voffA);
            PG8_WAIT_V(8); PG8_WAIT_L(0); PG8_BAR; PG8_MMA(1, 0, At, B0); PG8_MMA(1, 1, At, B1); PG8_BAR; PG8_SCHED;
            PG8_LDB(B0, 1, 0); PG8_LDB(B1, 1, 1); PG8_SCHED; PG8_LDA(At, 1, 0); PG8_STAGE(PG8_SA(0, 1), a2 + hstepA, voffA);
            PG8_WAIT_V(8); PG8_WAIT_L(0); PG8_BAR; PG8_MMA(0, 0, At, B0); PG8_MMA(0, 1, At, B1); PG8_BAR; PG8_SCHED;
            PG8_LDA(At, 1, 1); PG8_STAGE(PG8_SB(1, 0), b3, voffB); PG8_STAGE(PG8_SB(1, 1), b3 + hstepB, voffB); PG8_STAGE(PG8_SA(1, 0), a3, voffA);
            PG8_WAIT_V(8); PG8_WAIT_L(0); PG8_BAR; PG8_MMA(1, 0, At, B0); PG8_MMA(1, 1, At, B1); PG8_BAR; PG8_SCHED;
        }
        if (wr == 0) PG8_BAR;
        if constexpr (!Epi::AFTER_DRAIN) E(acc, cur, wr, wc, fr, fq);
        if (!has_next) break;
#pragma unroll
        for (int a = 0; a < 2; ++a)
#pragma unroll
            for (int b = 0; b < 2; ++b)
#pragma unroll
                for (int m = 0; m < 4; ++m)
#pragma unroll
                    for (int n = 0; n < 2; ++n) acc[a][b][m][n] = (f32x4){0.f, 0.f, 0.f, 0.f};
        cur = nxt; cA = nA; cB = nB; ++ui;
        if (wr == 1) PG8_BAR;
    }
    PG8_WAIT_V(0);
    PG8_BAR;
    if constexpr (Epi::AFTER_DRAIN) E(acc, cur, wr, wc, fr, fq);
#undef PG8_SA
#undef PG8_SB
#undef PG8_STAGE
#undef PG8_LDA
#undef PG8_LDB
#undef PG8_MMA
#undef PG8_WAIT_V
#undef PG8_WAIT_L
#undef PG8_BAR
#undef PG8_SCHED
}

template <int ldc, int tiles_per_dst, int silu_dst> struct EpiSplit {
    static constexpr int PERM = 1; static constexpr bool AFTER_DRAIN = false;
    bf16_t *d0, *d1, *d2, *d3;
    __device__ __forceinline__ void operator()(const f32x4 (&acc)[2][2][4][2], const Unit& u, int wr, int wc, int fr, int fq) const {
        const int di = u.pn / tiles_per_dst, ct = u.pn - di * tiles_per_dst;
        bf16_t* base = di == 0 ? d0 : di == 1 ? d1 : di == 2 ? d2 : d3; const bool act = (di == silu_dst);
        const int row0 = u.pm * BM + wr * 64 + fr, col0 = ct * BM + wc * 32 + 8 * fq;
#pragma unroll
        for (int ai = 0; ai < 2; ++ai)
#pragma unroll
            for (int m = 0; m < 4; ++m) { bf16_t* rowp = base + (size_t)(row0 + ai * HALF + m * 16) * ldc + col0;
#pragma unroll
                for (int bj = 0; bj < 2; ++bj) { f32x4 v0 = acc[ai][bj][m][0], v1 = acc[ai][bj][m][1];
                    if (act) { v0 = (f32x4){silu_f(v0[0]), silu_f(v0[1]), silu_f(v0[2]), silu_f(v0[3])}; v1 = (f32x4){silu_f(v1[0]), silu_f(v1[1]), silu_f(v1[2]), silu_f(v1[3])}; }
                    u32x4 w; w.x = cvt_pk_bf16(v0[0], v0[1]); w.y = cvt_pk_bf16(v0[2], v0[3]); w.z = cvt_pk_bf16(v1[0], v1[1]); w.w = cvt_pk_bf16(v1[2], v1[3]);
                    *(u32x4*)(rowp + bj * HALF) = w; } }
    }
};
struct EpiGate {
    static constexpr int PERM = 1; static constexpr bool AFTER_DRAIN = false; static constexpr int ldc = DI;
    bf16_t* Y; const bf16_t* SZ; const float* scale;
    __device__ __forceinline__ void operator()(const f32x4 (&acc)[2][2][4][2], const Unit& u, int wr, int wc, int fr, int fq) const {
        const int row0 = u.pm * BM + wr * 64 + fr, col0 = u.pn * BM + wc * 32 + 8 * fq;
        f32x4 sc[2][2];
#pragma unroll
        for (int bj = 0; bj < 2; ++bj) { sc[bj][0] = *(const f32x4*)(scale + col0 + bj * HALF); sc[bj][1] = *(const f32x4*)(scale + col0 + bj * HALF + 4); }
#pragma unroll
        for (int ai = 0; ai < 2; ++ai)
#pragma unroll
            for (int m = 0; m < 4; ++m) { const size_t off = (size_t)(row0 + ai * HALF + m * 16) * ldc + col0;
#pragma unroll
                for (int bj = 0; bj < 2; ++bj) { const u32x4 z = *(const u32x4*)(SZ + off + bj * HALF);
                    const f32x4 v0 = acc[ai][bj][m][0] * sc[bj][0], v1 = acc[ai][bj][m][1] * sc[bj][1];
                    u32x4 w; w.x = cvt_pk_bf16(v0[0] * bf_lo(z.x), v0[1] * bf_hi(z.x)); w.y = cvt_pk_bf16(v0[2] * bf_lo(z.y), v0[3] * bf_hi(z.y));
                    w.z = cvt_pk_bf16(v1[0] * bf_lo(z.z), v1[1] * bf_hi(z.z)); w.w = cvt_pk_bf16(v1[2] * bf_lo(z.w), v1[3] * bf_hi(z.w));
                    *(u32x4*)(Y + off + bj * HALF) = w; } }
    }
};
struct EpiRes {
    static constexpr int PERM = 0; static constexpr bool AFTER_DRAIN = false; static constexpr int ldc = D;
    const float* base; float* out;
    __device__ __forceinline__ void operator()(const f32x4 (&acc)[2][2][4][2], const Unit& u, int wr, int wc, int fr, int fq) const {
        const int row0 = u.pm * BM + wr * 64 + fr, col0 = u.pn * BM + wc * 32 + 4 * fq;
#pragma unroll
        for (int ai = 0; ai < 2; ++ai)
#pragma unroll
            for (int m = 0; m < 4; ++m) { const size_t off = (size_t)(row0 + ai * HALF + m * 16) * ldc + col0;
#pragma unroll
                for (int bj = 0; bj < 2; ++bj)
#pragma unroll
                    for (int n = 0; n < 2; ++n) { const f32x4 b = *(const f32x4*)(base + off + bj * HALF + n * 16); *(f32x4*)(out + off + bj * HALF + n * 16) = b + acc[ai][bj][m][n]; } }
    }
};
struct EpiQkvz {
    static constexpr int PERM = 2; static constexpr bool AFTER_DRAIN = false;
    bf16_t *q, *k, *v, *sz; const float *gq, *gk; const f32x2* tab; float* kmean; LAS unsigned char* xl;
    __device__ __forceinline__ void operator()(const f32x4 (&acc)[2][2][4][2], const Unit& u, int wr_, int wc_, int fr_, int fq_) const {
        int wr = wr_, wc = wc_, fr = fr_, fq = fq_;
        asm volatile("" : "+s"(wr), "+s"(wc), "+v"(fr), "+v"(fq));
        const int part = u.pn >> 1, ct = u.pn & 1;
        const int row0 = u.pm * BM + wr * 64 + fr, colb = ct * BM + wc * 16 + fq * 4;
        if (part >= 2) {
            bf16_t* base = part == 2 ? v : sz;
#pragma unroll
            for (int ai = 0; ai < 2; ++ai)
#pragma unroll
                for (int m = 0; m < 4; ++m) { bf16_t* rowp = base + (size_t)(row0 + ai * HALF + m * 16) * GW + colb;
#pragma unroll
                    for (int bj = 0; bj < 2; ++bj)
#pragma unroll
                        for (int n = 0; n < 2; ++n) { f32x4 t = acc[ai][bj][m][n];
                            if (part == 3) t = (f32x4){silu_f(t[0]), silu_f(t[1]), silu_f(t[2]), silu_f(t[3])};
                            u32x2 w; w.x = cvt_pk_bf16(t[0], t[1]); w.y = cvt_pk_bf16(t[2], t[3]); *(u32x2*)(rowp + bj * HALF + n * 64) = w; } }
        } else {
            LAS float* P = (LAS float*)xl;
#pragma unroll
            for (int ai = 0; ai < 2; ++ai)
#pragma unroll
                for (int m = 0; m < 4; ++m)
#pragma unroll
                    for (int bj = 0; bj < 2; ++bj) { const f32x4 a = acc[ai][bj][m][0], b = acc[ai][bj][m][1];
                        float sq = (a[0] * a[0] + a[1] * a[1]) + (a[2] * a[2] + a[3] * a[3]) + (b[0] * b[0] + b[1] * b[1]) + (b[2] * b[2] + b[3] * b[3]);
                        sq += __shfl_xor(sq, 16); sq += __shfl_xor(sq, 32);
                        if (fq == 0) P[(ai * HALF + wr * 64 + m * 16 + fr) * 8 + bj * 4 + wc] = sq; }
            asm volatile("s_waitcnt lgkmcnt(0)" ::: "memory"); __builtin_amdgcn_s_barrier(); asm volatile("" ::: "memory");
            const float* gain = part == 0 ? gq : gk; const float sc = part == 0 ? QSCALE : 1.0f;
            const f32x4 g1 = *(const f32x4*)(gain + wc * 16 + fq * 4), g2 = *(const f32x4*)(gain + 64 + wc * 16 + fq * 4);
            bf16_t* base = part == 0 ? q : k;
            f32x4 ks[2][2];
#pragma unroll
            for (int bj = 0; bj < 2; ++bj) { ks[bj][0] = (f32x4){0.f, 0.f, 0.f, 0.f}; ks[bj][1] = (f32x4){0.f, 0.f, 0.f, 0.f}; }
#pragma unroll
            for (int ai = 0; ai < 2; ++ai)
#pragma unroll
                for (int m = 0; m < 4; ++m) { const int r = ai * HALF + wr * 64 + m * 16 + fr, R = u.pm * BM + r, pos = R & (SEQ - 1);
                    const f32x4* tp = (const f32x4*)(tab + pos * 64 + wc * 16 + fq * 4);
                    const f32x4 t0 = tp[0], t1 = tp[1];
                    const f32x4 cs = {t0.x, t0.z, t1.x, t1.z}, sn = {t0.y, t0.w, t1.y, t1.w};
                    bf16_t* rowp = base + (size_t)R * GW + colb;
#pragma unroll
                    for (int bj = 0; bj < 2; ++bj) { const f32x4 pp = *(const LAS f32x4*)(P + r * 8 + bj * 4);
                        const float rstd = sc / sqrtf(((pp.x + pp.y) + (pp.z + pp.w)) * (1.f / HD) + EPS);
                        const f32x4 x1 = acc[ai][bj][m][0] * rstd * g1, x2 = acc[ai][bj][m][1] * rstd * g2;
                        const f32x4 o1 = x1 * cs - x2 * sn, o2 = x2 * cs + x1 * sn;
                        ks[bj][0] += o1; ks[bj][1] += o2; asm volatile("" : "+v"(ks[bj][0]), "+v"(ks[bj][1]));
                        u32x2 w1, w2; w1.x = cvt_pk_bf16(o1[0], o1[1]); w1.y = cvt_pk_bf16(o1[2], o1[3]); w2.x = cvt_pk_bf16(o2[0], o2[1]); w2.y = cvt_pk_bf16(o2[2], o2[3]);
                        *(u32x2*)(rowp + bj * HALF) = w1; *(u32x2*)(rowp + bj * HALF + 64) = w2; }
                    asm volatile("" ::: "memory"); }
            if (part == 1) {
                LAS float* KS = (LAS float*)(xl + 8192);
#pragma unroll
                for (int bj = 0; bj < 2; ++bj)
#pragma unroll
                    for (int n = 0; n < 2; ++n)
#pragma unroll
                        for (int e = 0; e < 4; ++e) { float vsum = ks[bj][n][e]; vsum += __shfl_xor(vsum, 1); vsum += __shfl_xor(vsum, 2); vsum += __shfl_xor(vsum, 4); vsum += __shfl_xor(vsum, 8);
                            if (fr == 0) KS[wr * 256 + bj * HALF + n * 64 + wc * 16 + fq * 4 + e] = vsum; }
                asm volatile("s_waitcnt lgkmcnt(0)" ::: "memory"); __builtin_amdgcn_s_barrier(); asm volatile("" ::: "memory");
                const int t_ = threadIdx.x;
                if (t_ < 256) { const float vv = KS[t_] + KS[256 + t_]; const int hl = ct * 2 + (t_ >> 7), d = t_ & 127, b = u.pm >> 5, nb = u.pm & 31;
                    kmean[((size_t)(b * HG + hl) * NB + nb) * HD + d] = vv * (1.f / BLK); }
            }
        }
    }
};
struct MapPlain_marker_unused {};
template <int lda, int ldb> struct MapPlain { __device__ __forceinline__ size_t a_off(const Unit& u) const { return (size_t)u.pm * BM * lda; } __device__ __forceinline__ size_t b_off(const Unit& u) const { return (size_t)u.pn * BM * ldb; } };
struct MapPool { __device__ __forceinline__ size_t a_off(const Unit& u) const { return (size_t)u.pm * BM * DI + (size_t)(u.pn >> 1) * 512; } __device__ __forceinline__ size_t b_off(const Unit& u) const { return (size_t)u.pn * BM * 512; } };
struct MapQkvz { int g; __device__ __forceinline__ size_t a_off(const Unit& u) const { return (size_t)u.pm * BM * D; } __device__ __forceinline__ size_t b_off(const Unit& u) const { return (size_t)((u.pn >> 1) * DI + g * GW + (u.pn & 1) * BM) * D; } };
}

#define XB_TMO      128
#define XB_XCNT(j)  (256  + 64 * (j))
#define XB_XSUB(j)  (1280 + 64 * (j))
#define XB_XGEN(j)  (2304 + 64 * (j))
#define XB_TOP      3328
#define XB_TOPGEN   3392
#define XCD_BAR_WORDS 3456
#define XB_SPIN_CAP (1u << 18)
__device__ __forceinline__ unsigned xb_ld(unsigned* p)              { return __hip_atomic_load(p, __ATOMIC_RELAXED, __HIP_MEMORY_SCOPE_AGENT); }
__device__ __forceinline__ unsigned xb_add(unsigned* p, unsigned v) { return __hip_atomic_fetch_add(p, v, __ATOMIC_RELAXED, __HIP_MEMORY_SCOPE_AGENT); }
__device__ __forceinline__ unsigned xb_xcc_id() { return (unsigned)__builtin_amdgcn_s_getreg((3 << 11) | 20) & 0xFu; }
#define XB_SPIN(cond, bar) do { unsigned _sp = 0; while (cond) { __builtin_amdgcn_s_sleep(1); \
    if ((++_sp & 255u) == 0u) { if (xb_ld(&(bar)[XB_TMO])) break; if (_sp > XB_SPIN_CAP) { atomicAdd(&(bar)[XB_TMO], 1u); break; } } } } while (0)
struct XcdBarrier { unsigned* bar; unsigned x; volatile LAS unsigned* st; };
__device__ __forceinline__ XcdBarrier xcd_barrier_post(unsigned* bar, volatile LAS unsigned* st) {
    XcdBarrier b; b.bar = bar; b.x = xb_xcc_id(); b.st = st;
    if (threadIdx.x == 0) (void)xb_add(&bar[XB_XCNT(b.x)], 1u);
    return b;
}
__device__ __forceinline__ void xcd_barrier_complete(unsigned* bar, unsigned x, unsigned& nloc, unsigned& nx) {
    const unsigned G = gridDim.x * gridDim.y * gridDim.z;
    unsigned sum, cnt, mine, sp = 0u;
    for (;;) {
        sum = 0u; cnt = 0u; mine = 0u;
#pragma unroll
        for (unsigned j = 0; j < 16; ++j) { const unsigned c = xb_ld(&bar[XB_XCNT(j)]); sum += c; cnt += (c > 0u) ? 1u : 0u; mine = (j == x) ? c : mine; }
        if (sum == G) break;
        __builtin_amdgcn_s_sleep(1);
        if ((++sp & 255u) == 0u) { if (xb_ld(&bar[XB_TMO])) break; if (sp > XB_SPIN_CAP) { atomicAdd(&bar[XB_TMO], 1u); break; } }
    }
    nloc = mine > 0u ? mine : 1u; nx = cnt > 0u ? cnt : 1u;
}
__device__ __forceinline__ void xcd_barrier(const XcdBarrier& b) {
    asm volatile("s_waitcnt vmcnt(0)" ::: "memory");
    __syncthreads();
    if (threadIdx.x == 0) {
        unsigned* bar = b.bar;
        __builtin_amdgcn_s_waitcnt(0);
        unsigned nloc = b.st[0], nx = b.st[1];
        if (nloc == 0u) { xcd_barrier_complete(bar, b.x, nloc, nx); b.st[0] = nloc; b.st[1] = nx; }
        const unsigned old = xb_add(&bar[XB_XSUB(b.x)], 1u);
        const unsigned gen = old / nloc;
        if (old + 1u == (gen + 1u) * nloc) {
            __builtin_amdgcn_fence(__ATOMIC_RELEASE, "agent");
            asm volatile("s_waitcnt vmcnt(0)" ::: "memory");
            const unsigned og = xb_add(&bar[XB_TOP], 1u);
            const unsigned tg = og / nx;
            if (og + 1u == (tg + 1u) * nx) xb_add(&bar[XB_TOPGEN], 1u);
            else XB_SPIN(xb_ld(&bar[XB_TOPGEN]) == tg, bar);
            __builtin_amdgcn_fence(__ATOMIC_ACQUIRE, "agent");
            xb_add(&bar[XB_XGEN(b.x)], 1u);
            asm volatile("s_waitcnt vmcnt(0)" ::: "memory");
        } else {
            XB_SPIN(xb_ld(&bar[XB_XGEN(b.x)]) == gen, bar);
            __builtin_amdgcn_fence(__ATOMIC_ACQUIRE, "agent");
            asm volatile("s_waitcnt vmcnt(0)" ::: "memory");
        }
    }
    __syncthreads();
}

struct Args { const float* in[11]; float* out; unsigned char* ws; int ph_lo, ph_hi, coop, pad; };

__device__ __forceinline__ void transpose_item(const float* W, int K, int N, bf16_t* WT, LAS float* scr, int item, int lane) {
    const int nblk = N / 32, kb = item / nblk, nb = item % nblk, k0 = 64 * kb, n0 = 32 * nb;
#pragma unroll 8
    for (int i = 0; i < 32; ++i) { const int kk = 2 * i + (lane >> 5); scr[kk * 33 + (lane & 31)] = W[(size_t)(k0 + kk) * N + n0 + (lane & 31)]; }
    asm volatile("s_waitcnt lgkmcnt(0)" ::: "memory");
    const int c = lane & 7;
#pragma unroll
    for (int j = 0; j < 4; ++j) { const int n = (lane >> 3) + 8 * j; const LAS float* s = scr + (8 * c) * 33 + n;
        u32x4 o; o.x = cvt_pk_bf16(s[0 * 33], s[1 * 33]); o.y = cvt_pk_bf16(s[2 * 33], s[3 * 33]); o.z = cvt_pk_bf16(s[4 * 33], s[5 * 33]); o.w = cvt_pk_bf16(s[6 * 33], s[7 * 33]);
        *(u32x4*)(WT + (size_t)(n0 + n) * K + k0 + 8 * c) = o; }
    asm volatile("s_waitcnt lgkmcnt(0)" ::: "memory");
}
__device__ __forceinline__ void rms_row(const float* xrow, const float* gain, bf16_t* orow, int lane) {
    const f32x4* xr = (const f32x4*)xrow + lane; const f32x4* gr = (const f32x4*)gain + lane;
    f32x4 v[4]; float s = 0.f;
#pragma unroll
    for (int j = 0; j < 4; ++j) { v[j] = xr[64 * j]; s += (v[j].x * v[j].x + v[j].y * v[j].y) + (v[j].z * v[j].z + v[j].w * v[j].w); }
    const float rstd = 1.0f / sqrtf(wave_sum(s) * (1.f / D) + EPS);
    u32x2* o8 = (u32x2*)orow + lane;
#pragma unroll
    for (int j = 0; j < 4; ++j) { const f32x4 gg = gr[64 * j]; u32x2 w; w.x = cvt_pk_bf16(v[j].x * rstd * gg.x, v[j].y * rstd * gg.y); w.y = cvt_pk_bf16(v[j].z * rstd * gg.z, v[j].w * rstd * gg.w); o8[64 * j] = w; }
}
__device__ __forceinline__ void rope_entry(int idx, f32x2* tab) {
    const int pos = idx >> 6, i = idx & 63;
    const float inv = (float)exp2(-(double)(2 * i) * (13.287712379549449 / 128.0));
    const float angf = (float)pos * inv;
    const double a = (double)angf; const double q = rint(a * 0.6366197723675814); const double r = a - q * 1.5707963267948966;
    const double r2 = r * r;
    double sn = r * (1.0 - r2 / 6.0 * (1.0 - r2 / 20.0 * (1.0 - r2 / 42.0 * (1.0 - r2 / 72.0 * (1.0 - r2 / 110.0 * (1.0 - r2 / 156.0))))));
    double cs = 1.0 - r2 / 2.0 * (1.0 - r2 / 12.0 * (1.0 - r2 / 30.0 * (1.0 - r2 / 56.0 * (1.0 - r2 / 90.0 * (1.0 - r2 / 132.0)))));
    const int qi = ((int)q) & 3;
    double c2, s2;
    if (qi == 0) { c2 = cs; s2 = sn; } else if (qi == 1) { c2 = -sn; s2 = cs; } else if (qi == 2) { c2 = -cs; s2 = -sn; } else { c2 = sn; s2 = -cs; }
    tab[idx] = (f32x2){(float)c2, (float)s2};
}

__global__ void __launch_bounds__(NTHREADS, 2) mega_fwd(Args args) {
    extern __shared__ __attribute__((aligned(16))) unsigned char lds_raw[];
    LAS unsigned char* lds = (LAS unsigned char*)lds_raw;
    cg::grid_group grid = cg::this_grid();
    const int G = gridDim.x, bx = blockIdx.x;
    volatile LAS unsigned* bst = (volatile LAS unsigned*)(lds + LDS_BYTES - 16);
    if (threadIdx.x < 4) bst[threadIdx.x] = 0u;
    __syncthreads();
    XcdBarrier xbar; xbar.bar = (unsigned*)(args.ws + WS_BAR); xbar.x = 0; xbar.st = bst;
    if (args.coop) xbar = xcd_barrier_post((unsigned*)(args.ws + WS_BAR), bst);
    unsigned char* ws = args.ws;
#define XIN (args.in[0])
#define norm0 (args.in[1])
#define w_in0 (args.in[2])
#define w_pool0 (args.in[3])
#define pool_scale0 (args.in[4])
#define w_out0 (args.in[5])
#define norm1 (args.in[6])
#define w_in1 (args.in[7])
#define q_norm1 (args.in[8])
#define k_norm1 (args.in[9])
#define w_out1 (args.in[10])
    float* out = args.out;
#define WIN0 ((bf16_t*)(ws + WS_WIN0))
#define WP ((bf16_t*)(ws + WS_WP))
#define WOUT0 ((bf16_t*)(ws + WS_WOUT0))
#define WIN1 ((bf16_t*)(ws + WS_WIN1))
#define WOUT1 ((bf16_t*)(ws + WS_WOUT1))
#define H0 ((bf16_t*)(ws + WS_H0))
#define POOLED ((bf16_t*)(ws + WS_POOLED))
#define U ((bf16_t*)(ws + WS_U))
#define SZ0 ((bf16_t*)(ws + WS_SZ0))
#define H1 ((bf16_t*)(ws + WS_H1))
#define QG ((bf16_t*)(ws + WS_QG))
#define KG ((bf16_t*)(ws + WS_KG))
#define VG ((bf16_t*)(ws + WS_VG))
#define SZG ((bf16_t*)(ws + WS_SZG))
#define OPART ((bf16_t*)(ws + WS_OPART))
#define AT ((bf16_t*)(ws + WS_A))
#define KMEAN ((float*)(ws + WS_KMEAN))
#define SEL ((unsigned*)(ws + WS_SEL))
#define LPART ((float*)(ws + WS_LPART))
#define TAB ((f32x2*)(ws + WS_TAB))
#define LIST ((unsigned short*)(ws + WS_LIST))
#define CNT ((unsigned*)(ws + WS_CTL))
    const int lo = args.ph_lo, hi = args.ph_hi;
#define IN(k) (lo <= (k) && (k) < hi)
#define SYNC(k) do { if (IN(k) && IN((k) + 1) && args.coop) { if (args.coop == 2) grid.sync(); else xcd_barrier(xbar); } } while (0)
    {
        if (IN(0) && (PH_MASK & 1)) {
            int tid = threadIdx.x; asm volatile("" : "+v"(tid)); const int lane = tid & 63, wave = __builtin_amdgcn_readfirstlane(tid >> 6); (void)lane; (void)wave;
            LAS float* scr = (LAS float*)(lds + wave * 16384);
            const int gw = bx * 8 + wave, NGW = G * 8;
            constexpr int I0 = (D / 64) * (2 * DI / 32), IP = (512 / 64) * (512 / 32), I1 = (DI / 64) * (D / 32), I2 = (D / 64) * (4 * DI / 32), I3 = I1;
            constexpr int NITEMS = I0 + 4 * IP + I1 + I2 + I3;
            for (int it = gw; it < NITEMS; it += NGW) {
                int r = it;
                if (r < I0) { transpose_item(w_in0, D, 2 * DI, WIN0, scr, r, lane); continue; } r -= I0;
                if (r < 4 * IP) { const int gp = r / IP; transpose_item(w_pool0 + (size_t)gp * 512 * 512, 512, 512, WP + (size_t)gp * 512 * 512, scr, r - gp * IP, lane); continue; } r -= 4 * IP;
                if (r < I1) { transpose_item(w_out0, DI, D, WOUT0, scr, r, lane); continue; } r -= I1;
                if (r < I2) { transpose_item(w_in1, D, 4 * DI, WIN1, scr, r, lane); continue; } r -= I2;
                transpose_item(w_out1, DI, D, WOUT1, scr, r, lane);
            }
            for (int idx = bx * NTHREADS + tid; idx < SEQ * 64; idx += G * NTHREADS) rope_entry(idx, TAB);
            for (int m = gw; m < M; m += NGW) rms_row(XIN + (size_t)m * D, norm0, H0 + (size_t)m * D, lane);
        }
        SYNC(0);
        if (IN(1) && (PH_MASK & 2)) {
            int tid = threadIdx.x; asm volatile("" : "+v"(tid)); const int lane = tid & 63, wave = __builtin_amdgcn_readfirstlane(tid >> 6); (void)lane; (void)wave;
            pg8::Gemm<D, D, D> g{H0, WIN0}; pg8::StaticOrder S; S.init(M, 2 * DI, G, bx);
            pg8::EpiSplit<DI, 8, 1> E{U, SZ0, U, U}; pg8::MapPlain<D, D> MP;
            pg8::gemm_phase(lds, g, S, MP, E);
        }
        SYNC(1);
        if (IN(2) && (PH_MASK & 4)) {
            int tid = threadIdx.x; asm volatile("" : "+v"(tid)); const int lane = tid & 63, wave = __builtin_amdgcn_readfirstlane(tid >> 6); (void)lane; (void)wave;
            const int cgp = tid & 255, hh = tid >> 8, col = cgp * 8, w = 2 << (cgp >> 6);
            for (int unit = bx; unit < M / 64; unit += G) {
                const int r0 = unit * 64 + hh * 32, p0 = r0 & (SEQ - 1);
                float sum[8];
#pragma unroll
                for (int e = 0; e < 8; ++e) sum[e] = 0.f;
                for (int i = 1; i < w; ++i) { if (p0 - i >= 0) { const u32x4 v = *(const u32x4*)(U + (size_t)(r0 - i) * DI + col);
                    sum[0] += bf_lo(v.x); sum[1] += bf_hi(v.x); sum[2] += bf_lo(v.y); sum[3] += bf_hi(v.y); sum[4] += bf_lo(v.z); sum[5] += bf_hi(v.z); sum[6] += bf_lo(v.w); sum[7] += bf_hi(v.w); } }
                for (int t = 0; t < 32; ++t) {
                    const int p = p0 + t; const u32x4 v = *(const u32x4*)(U + (size_t)(r0 + t) * DI + col);
                    float c[8] = {bf_lo(v.x), bf_hi(v.x), bf_lo(v.y), bf_hi(v.y), bf_lo(v.z), bf_hi(v.z), bf_lo(v.w), bf_hi(v.w)};
                    const float rc = 1.0f / (float)((p + 1) < w ? (p + 1) : w);
                    float o[8];
#pragma unroll
                    for (int e = 0; e < 8; ++e) { sum[e] += c[e]; o[e] = sum[e] * rc - c[e]; }
                    u32x4 wv; wv.x = cvt_pk_bf16(o[0], o[1]); wv.y = cvt_pk_bf16(o[2], o[3]); wv.z = cvt_pk_bf16(o[4], o[5]); wv.w = cvt_pk_bf16(o[6], o[7]);
                    *(u32x4*)(POOLED + (size_t)(r0 + t) * DI + col) = wv;
                    if (p - w + 1 >= 0) { const u32x4 q = *(const u32x4*)(U + (size_t)(r0 + t - w + 1) * DI + col);
                        sum[0] -= bf_lo(q.x); sum[1] -= bf_hi(q.x); sum[2] -= bf_lo(q.y); sum[3] -= bf_hi(q.y); sum[4] -= bf_lo(q.z); sum[5] -= bf_hi(q.z); sum[6] -= bf_lo(q.w); sum[7] -= bf_hi(q.w); }
                }
            }
        }
        SYNC(2);
        if (IN(3) && (PH_MASK & 8)) {
            int tid = threadIdx.x; asm volatile("" : "+v"(tid)); const int lane = tid & 63, wave = __builtin_amdgcn_readfirstlane(tid >> 6); (void)lane; (void)wave;
            pg8::Gemm<DI, 512, 512> g{POOLED, WP}; pg8::StaticOrder S; S.init(M, DI, G, bx);
            pg8::EpiGate E{U, SZ0, pool_scale0}; pg8::MapPool MP;
            pg8::gemm_phase(lds, g, S, MP, E);
        }
        SYNC(3);
        if (IN(4) && (PH_MASK & 16)) {
            int tid = threadIdx.x; asm volatile("" : "+v"(tid)); const int lane = tid & 63, wave = __builtin_amdgcn_readfirstlane(tid >> 6); (void)lane; (void)wave;
            pg8::Gemm<DI, DI, DI> g{U, WOUT0}; pg8::StaticOrder S; S.init(M, D, G, bx);
            pg8::EpiRes E{XIN, out}; pg8::MapPlain<DI, DI> MP;
            pg8::gemm_phase(lds, g, S, MP, E);
        }
        SYNC(4);
        if (IN(5) && (PH_MASK & 32)) {
            int tid = threadIdx.x; asm volatile("" : "+v"(tid)); const int lane = tid & 63, wave = __builtin_amdgcn_readfirstlane(tid >> 6); (void)lane; (void)wave;
            const int gw = bx * 8 + wave, NGW = G * 8;
            for (int m = gw; m < M; m += NGW) rms_row(out + (size_t)m * D, norm1, H1 + (size_t)m * D, lane);
        }
        SYNC(5);
#pragma unroll
        for (int g = 0; g < NG; ++g) {
            const int pb = 6 + 3 * g;
            if (IN(pb) && (PH_MASK & 64)) {
            int tid = threadIdx.x; asm volatile("" : "+v"(tid)); const int lane = tid & 63, wave = __builtin_amdgcn_readfirstlane(tid >> 6); (void)lane; (void)wave;
                if (g > 0) { const int gc = g - 1;
                for (int idx = bx * NTHREADS + tid; idx < M * HG * 16; idx += G * NTHREADS) {
                    const int pair = idx >> 4, ch = idx & 15, m = pair >> 2, hl = pair & 3;
                    const unsigned sel = SEL[(size_t)m * NH + gc * HG + hl];
                    float o[8]; float l = LPART[(size_t)pair * 4 + 3];
                    { const u32x4 v = *(const u32x4*)(OPART + ((size_t)pair * 4 + 3) * HD + ch * 8);
                      o[0] = bf_lo(v.x); o[1] = bf_hi(v.x); o[2] = bf_lo(v.y); o[3] = bf_hi(v.y); o[4] = bf_lo(v.z); o[5] = bf_hi(v.z); o[6] = bf_lo(v.w); o[7] = bf_hi(v.w); }
#pragma unroll
                    for (int e = 0; e < 3; ++e) if (((sel >> (8 * e)) & 0xffu) != 0xffu) {
                        const u32x4 v = *(const u32x4*)(OPART + ((size_t)pair * 4 + e) * HD + ch * 8); l += LPART[(size_t)pair * 4 + e];
                        o[0] += bf_lo(v.x); o[1] += bf_hi(v.x); o[2] += bf_lo(v.y); o[3] += bf_hi(v.y); o[4] += bf_lo(v.z); o[5] += bf_hi(v.z); o[6] += bf_lo(v.w); o[7] += bf_hi(v.w); }
                    const float rl = 1.0f / l;
                                        u32x4 w; w.x = cvt_pk_bf16(o[0] * rl, o[1] * rl); w.y = cvt_pk_bf16(o[2] * rl, o[3] * rl);
                    w.z = cvt_pk_bf16(o[4] * rl, o[5] * rl); w.w = cvt_pk_bf16(o[6] * rl, o[7] * rl);
                    *(u32x4*)(AT + (size_t)m * DI + gc * GW + hl * HD + ch * 8) = w;
                }
                }
                pg8::Gemm<D, D, D> gm{H1, WIN1}; pg8::StaticOrder S; S.init(M, 4 * GW, G, bx);
                pg8::EpiQkvz E{QG, KG, VG, SZG, q_norm1, k_norm1, TAB, KMEAN + (size_t)g * 8 * NB * HD, lds + 131072}; pg8::MapQkvz MP{g};
                pg8::gemm_phase(lds, gm, S, MP, E);
            }
            SYNC(pb);
            if (IN(pb + 1) && (PH_MASK & 256)) {
            int tid = threadIdx.x; asm volatile("" : "+v"(tid)); const int lane = tid & 63, wave = __builtin_amdgcn_readfirstlane(tid >> 6); (void)lane; (void)wave;
                LAS float* km = (LAS float*)lds;
                LAS float* mv = (LAS float*)(lds + 16384);
                LAS int* mi = (LAS int*)(lds + 16384 + 3072);
                LAS unsigned* lcnt = (LAS unsigned*)(lds + 16384 + 6144);
                LAS unsigned* lbase = lcnt + 32;
                if (tid < 32) lcnt[tid] = 0u;
                __syncthreads();
#pragma unroll 1
                for (int unit = bx; unit < 8 * NB; unit += G) {
                    const int bh = unit >> 5, qb = unit & 31, b = bh >> 2, hl = bh & 3;
                    const int qi = tid & 255, hf = tid >> 8;
                    const int s = qb * BLK + qi; const size_t mrow = (size_t)b * SEQ + s;
                    if (qb > 0) {
                        u32x4 qv[16];
#pragma unroll
                        for (int c = 0; c < 16; ++c) qv[c] = *(const u32x4*)(QG + mrow * GW + hl * HD + c * 8);
                        for (int c = tid; c < qb * 32; c += NTHREADS) *(LAS f32x4*)(km + c * 4) = *(const f32x4*)(KMEAN + (size_t)(g * 8 + bh) * NB * HD + c * 4);
                        __syncthreads();
                        float v0 = -INFINITY, v1 = -INFINITY, v2 = -INFINITY; int i0 = 255, i1 = 255, i2 = 255;
#pragma unroll 1
                        for (int n = hf; n < qb; n += 2) {
                            float acc = 0.f;
#pragma unroll
                            for (int c = 0; c < 16; ++c) { const f32x4 ka = *(const LAS f32x4*)(km + n * 128 + c * 8), kb = *(const LAS f32x4*)(km + n * 128 + c * 8 + 4);
                                acc += bf_lo(qv[c].x) * ka.x + bf_hi(qv[c].x) * ka.y + bf_lo(qv[c].y) * ka.z + bf_hi(qv[c].y) * ka.w + bf_lo(qv[c].z) * kb.x + bf_hi(qv[c].z) * kb.y + bf_lo(qv[c].w) * kb.z + bf_hi(qv[c].w) * kb.w; }
                            if (acc > v0) { v2 = v1; i2 = i1; v1 = v0; i1 = i0; v0 = acc; i0 = n; }
                            else if (acc > v1) { v2 = v1; i2 = i1; v1 = acc; i1 = n; }
                            else if (acc > v2) { v2 = acc; i2 = n; }
                        }
                        if (hf == 1) { mv[qi * 3] = v0; mv[qi * 3 + 1] = v1; mv[qi * 3 + 2] = v2; mi[qi * 3] = i0; mi[qi * 3 + 1] = i1; mi[qi * 3 + 2] = i2; }
                        __syncthreads();
                        unsigned rk0 = 0, rk1 = 0, rk2 = 0;
                        if (hf == 0) {
#pragma unroll
                            for (int e = 0; e < 3; ++e) { const float acc = mv[qi * 3 + e]; const int n = mi[qi * 3 + e];
                                if (n < 255) {
                                    const bool g0 = acc > v0 || (acc == v0 && n < i0), g1 = acc > v1 || (acc == v1 && n < i1), g2 = acc > v2 || (acc == v2 && n < i2);
                                    if (g0) { v2 = v1; i2 = i1; v1 = v0; i1 = i0; v0 = acc; i0 = n; }
                                    else if (g1) { v2 = v1; i2 = i1; v1 = acc; i1 = n; }
                                    else if (g2) { v2 = acc; i2 = n; }
                                } }
                            SEL[mrow * NH + g * HG + hl] = (unsigned)i0 | ((unsigned)i1 << 8) | ((unsigned)i2 << 16);
                            if (i0 < 255) rk0 = atomicAdd((unsigned*)&lcnt[i0], 1u);
                            if (i1 < 255) rk1 = atomicAdd((unsigned*)&lcnt[i1], 1u);
                            if (i2 < 255) rk2 = atomicAdd((unsigned*)&lcnt[i2], 1u);
                        }
                        __syncthreads();
                        if (tid < 32) { const unsigned c = lcnt[tid]; lbase[tid] = c ? atomicAdd(&CNT[g * 256 + bh * NB + tid], c) : 0u; lcnt[tid] = 0u; }
                        __syncthreads();
                        if (hf == 0) {
                            if (i0 < 255) LIST[(size_t)(bh * NB + i0) * SEQ + lbase[i0] + rk0] = (unsigned short)(s | (0 << 13));
                            if (i1 < 255) LIST[(size_t)(bh * NB + i1) * SEQ + lbase[i1] + rk1] = (unsigned short)(s | (1 << 13));
                            if (i2 < 255) LIST[(size_t)(bh * NB + i2) * SEQ + lbase[i2] + rk2] = (unsigned short)(s | (2 << 13));
                        }
                        __syncthreads();
                    } else if (hf == 0) {
                        SEL[mrow * NH + g * HG + hl] = 0x00ffffffu;
                    }
                }
            }
            SYNC(pb + 1);
            if (IN(pb + 2) && (PH_MASK & 512)) {
            int tid = threadIdx.x; asm volatile("" : "+v"(tid)); const int lane = tid & 63, wave = __builtin_amdgcn_readfirstlane(tid >> 6); (void)lane; (void)wave;
                LAS unsigned char* Ks = lds;
                LAS unsigned char* Vt = lds + 256 * 272;
                LAS int* pre = (LAS int*)(lds + 256 * 272 + 128 * 528);
                LAS float* red = (LAS float*)(lds + 256 * 272 + 128 * 528 + 2048);
                {
                    float mq = 0.f, mk = 0.f;
                    if (tid < 128) { mq = fabsf(q_norm1[tid]); mk = fabsf(k_norm1[tid]); }
#pragma unroll
                    for (int o = 1; o < 64; o <<= 1) { mq = fmaxf(mq, __shfl_xor(mq, o)); mk = fmaxf(mk, __shfl_xor(mk, o)); }
                    if (lane == 0) { red[wave * 2] = mq; red[wave * 2 + 1] = mk; }
                    if (tid < 256) pre[tid + 1] = 1 + (int)((CNT[g * 256 + tid] + 255u) >> 8);
                    if (tid == 0) pre[0] = 0;
                    __syncthreads();
                    if (tid == 0) { int a = 0; for (int i = 1; i <= 256; ++i) { a += pre[i]; pre[i] = a; } }
                    __syncthreads();
                }
                const float MSH = 128.0f * QSCALE * fmaxf(red[0], red[2]) * fmaxf(red[1], red[3]) * 1.02f;
                const int total = pre[256];
                const int fr = lane & 15, fq = lane >> 4;
                const int istart = (int)(((long)total * bx) / G), iend = (int)(((long)total * (bx + 1)) / G);
                int cur_li = -1;
#pragma unroll 1
                for (int item = istart; item < iend; ++item) {
                    int loi = 0, hii = 256;
                    while (hii - loi > 1) { const int mid = (loi + hii) >> 1; if (pre[mid] <= item) loi = mid; else hii = mid; }
                    const int li = loi, c = item - pre[li], bh = li >> 5, n = li & 31, b = bh >> 2, hl = bh & 3;
                    const int cnt = (int)CNT[g * 256 + li];
                    const size_t rowbase = (size_t)b * SEQ;
                    const bool restage = (li != cur_li); cur_li = li;
                    if (restage) {
                    __syncthreads();
                    for (int cc = tid; cc < 256 * 16; cc += NTHREADS) { const int r = cc >> 4, c16 = cc & 15;
                        *(LAS u32x4*)(Ks + r * 272 + c16 * 16) = *(const u32x4*)(KG + (rowbase + n * BLK + r) * GW + hl * HD + c16 * 8); }
                    for (int task = tid; task < 1024; task += NTHREADS) {
                        const int a = (task & 15) | ((task >> 5) & 3) << 4, cch = ((task >> 4) & 1) | ((task >> 7) << 1);
                        u32x4 v[4];
#pragma unroll
                        for (int kk = 0; kk < 4; ++kk) v[kk] = *(const u32x4*)(VG + (rowbase + n * BLK + a * 4 + kk) * GW + hl * HD + cch * 8);
#pragma unroll
                        for (int e = 0; e < 4; ++e) {
                            const unsigned w0 = e == 0 ? v[0].x : e == 1 ? v[0].y : e == 2 ? v[0].z : v[0].w, w1 = e == 0 ? v[1].x : e == 1 ? v[1].y : e == 2 ? v[1].z : v[1].w;
                            const unsigned w2 = e == 0 ? v[2].x : e == 1 ? v[2].y : e == 2 ? v[2].z : v[2].w, w3 = e == 0 ? v[3].x : e == 1 ? v[3].y : e == 2 ? v[3].z : v[3].w;
                            u32x2 lo2, hi2;
                            lo2.x = (w0 & 0xffffu) | (w1 << 16); lo2.y = (w2 & 0xffffu) | (w3 << 16);
                            hi2.x = (w0 >> 16) | (w1 & 0xffff0000u); hi2.y = (w2 >> 16) | (w3 & 0xffff0000u);
                            *(LAS u32x2*)(Vt + (cch * 8 + 2 * e) * 528 + a * 8) = lo2;
                            *(LAS u32x2*)(Vt + (cch * 8 + 2 * e + 1) * 528 + a * 8) = hi2;
                        }
                    }
                    }
                    int qpos[2], qslot[2]; bool qok[2];
                    bf16x8 qf[2][4];
#pragma unroll
                    for (int t = 0; t < 2; ++t) {
                        const int ridx = wave * 32 + t * 16 + fr;
                        if (c == 0) { qpos[t] = n * BLK + ridx; qslot[t] = 3; qok[t] = true; }
                        else { const int lidx = (c - 1) * 256 + ridx; qok[t] = lidx < cnt; const unsigned e = LIST[(size_t)li * SEQ + (qok[t] ? lidx : 0)]; qpos[t] = e & 8191; qslot[t] = e >> 13; }
                        const bf16_t* qp = QG + (rowbase + qpos[t]) * GW + hl * HD + fq * 8;
#pragma unroll
                        for (int ks = 0; ks < 4; ++ks) qf[t][ks] = *(const bf16x8*)(qp + ks * 32);
                    }
                    if (restage) __syncthreads();
                    f32x4 oacc[2][8], lacc[2];
#pragma unroll
                    for (int t = 0; t < 2; ++t) { lacc[t] = (f32x4){0.f, 0.f, 0.f, 0.f};
#pragma unroll
                        for (int dt = 0; dt < 8; ++dt) oacc[t][dt] = (f32x4){0.f, 0.f, 0.f, 0.f}; }
                    const int qrel0 = qpos[0] - n * BLK, qrel1 = qpos[1] - n * BLK;
                    const int kg_end = (c == 0) ? wave + 1 : 8;
                    const bf16x8 ones = {0x3F80, 0x3F80, 0x3F80, 0x3F80, 0x3F80, 0x3F80, 0x3F80, 0x3F80};
                    bf16x8 kf[2][4];
#pragma unroll
                    for (int kt = 0; kt < 2; ++kt)
#pragma unroll
                        for (int ks = 0; ks < 4; ++ks) kf[kt][ks] = *(const LAS bf16x8*)(Ks + (kt * 16 + fr) * 272 + ks * 64 + fq * 16);
#pragma unroll 1
                    for (int kg = 0; kg < kg_end; ++kg) {
                        u32x2 va[8], vb[8];
#pragma unroll
                        for (int dt = 0; dt < 8; ++dt) { va[dt] = *(const LAS u32x2*)(Vt + (dt * 16 + fr) * 528 + kg * 64 + fq * 8); vb[dt] = *(const LAS u32x2*)(Vt + (dt * 16 + fr) * 528 + kg * 64 + 32 + fq * 8); }
                        __builtin_amdgcn_sched_barrier(0);
                        f32x4 sacc[2][2];
#pragma unroll
                        for (int kt = 0; kt < 2; ++kt) { sacc[kt][0] = (f32x4){-MSH, -MSH, -MSH, -MSH}; sacc[kt][1] = (f32x4){-MSH, -MSH, -MSH, -MSH}; }
#pragma unroll
                        for (int ks = 0; ks < 4; ++ks)
#pragma unroll
                            for (int kt = 0; kt < 2; ++kt) {
                                sacc[kt][0] = __builtin_amdgcn_mfma_f32_16x16x32_bf16(kf[kt][ks], qf[0][ks], sacc[kt][0], 0, 0, 0);
                                sacc[kt][1] = __builtin_amdgcn_mfma_f32_16x16x32_bf16(kf[kt][ks], qf[1][ks], sacc[kt][1], 0, 0, 0); }
                        __builtin_amdgcn_sched_barrier(0);
                        if (kg + 1 < kg_end) {
#pragma unroll
                            for (int kt = 0; kt < 2; ++kt)
#pragma unroll
                                for (int ks = 0; ks < 4; ++ks) kf[kt][ks] = *(const LAS bf16x8*)(Ks + ((kg + 1) * 32 + kt * 16 + fr) * 272 + ks * 64 + fq * 16);
                        }
                        bf16x8 pb[2];
                        if (c == 0 && kg == wave) {
#pragma unroll
                            for (int t = 0; t < 2; ++t) {
                                float p[8];
#pragma unroll
                                for (int kt = 0; kt < 2; ++kt)
#pragma unroll
                                    for (int j = 0; j < 4; ++j) { float pv = __builtin_amdgcn_exp2f(sacc[kt][t][j]);
                                        const int key = kg * 32 + kt * 16 + fq * 4 + j; if (key > (t == 0 ? qrel0 : qrel1)) pv = 0.f;
                                        p[kt * 4 + j] = pv; }
                                u32x4 w; w.x = cvt_pk_bf16(p[0], p[1]); w.y = cvt_pk_bf16(p[2], p[3]); w.z = cvt_pk_bf16(p[4], p[5]); w.w = cvt_pk_bf16(p[6], p[7]);
                                pb[t] = __builtin_bit_cast(bf16x8, w);
                            }
                        } else {
#pragma unroll
                            for (int t = 0; t < 2; ++t) {
                                u32x4 w;
                                w.x = cvt_pk_bf16(__builtin_amdgcn_exp2f(sacc[0][t][0]), __builtin_amdgcn_exp2f(sacc[0][t][1])); w.y = cvt_pk_bf16(__builtin_amdgcn_exp2f(sacc[0][t][2]), __builtin_amdgcn_exp2f(sacc[0][t][3]));
                                w.z = cvt_pk_bf16(__builtin_amdgcn_exp2f(sacc[1][t][0]), __builtin_amdgcn_exp2f(sacc[1][t][1])); w.w = cvt_pk_bf16(__builtin_amdgcn_exp2f(sacc[1][t][2]), __builtin_amdgcn_exp2f(sacc[1][t][3]));
                                pb[t] = __builtin_bit_cast(bf16x8, w);
                            }
                        }
                        __builtin_amdgcn_sched_barrier(0);
                        lacc[0] = __builtin_amdgcn_mfma_f32_16x16x32_bf16(ones, pb[0], lacc[0], 0, 0, 0);
                        lacc[1] = __builtin_amdgcn_mfma_f32_16x16x32_bf16(ones, pb[1], lacc[1], 0, 0, 0);
#pragma unroll
                        for (int dt = 0; dt < 8; ++dt) {
                            u32x4 vv; vv.x = va[dt].x; vv.y = va[dt].y; vv.z = vb[dt].x; vv.w = vb[dt].y; const bf16x8 vf = __builtin_bit_cast(bf16x8, vv);
                            oacc[0][dt] = __builtin_amdgcn_mfma_f32_16x16x32_bf16(vf, pb[0], oacc[0][dt], 0, 0, 0);
                            oacc[1][dt] = __builtin_amdgcn_mfma_f32_16x16x32_bf16(vf, pb[1], oacc[1][dt], 0, 0, 0);
                        }
                    }
#pragma unroll
                    for (int t = 0; t < 2; ++t) {
                        const float l = lacc[t][0];
                        if (qok[t]) {
                            const size_t pair = (rowbase + qpos[t]) * HG + hl;
                            bf16_t* op = OPART + (pair * 4 + qslot[t]) * HD + fq * 4;
                            const bf16_t* zp = SZG + (rowbase + qpos[t]) * GW + hl * HD + fq * 4;
                            u32x2 zz[8];
#pragma unroll
                            for (int dt = 0; dt < 8; ++dt) zz[dt] = *(const u32x2*)(zp + dt * 16);
#pragma unroll
                            for (int dt = 0; dt < 8; ++dt) { u32x2 w; w.x = cvt_pk_bf16(oacc[t][dt][0] * bf_lo(zz[dt].x), oacc[t][dt][1] * bf_hi(zz[dt].x)); w.y = cvt_pk_bf16(oacc[t][dt][2] * bf_lo(zz[dt].y), oacc[t][dt][3] * bf_hi(zz[dt].y)); *(u32x2*)(op + dt * 16) = w; }
                            if (fq == 0) LPART[pair * 4 + qslot[t]] = l;
                        }
                    }
                }
            }
            SYNC(pb + 2);
        }
        if (IN(6 + 3 * NG) && (PH_MASK & 1024)) {
            int tid = threadIdx.x; asm volatile("" : "+v"(tid)); const int lane = tid & 63, wave = __builtin_amdgcn_readfirstlane(tid >> 6); (void)lane; (void)wave;
            { const int gc = NG - 1;
                for (int idx = bx * NTHREADS + tid; idx < M * HG * 16; idx += G * NTHREADS) {
                    const int pair = idx >> 4, ch = idx & 15, m = pair >> 2, hl = pair & 3;
                    const unsigned sel = SEL[(size_t)m * NH + gc * HG + hl];
                    float o[8]; float l = LPART[(size_t)pair * 4 + 3];
                    { const u32x4 v = *(const u32x4*)(OPART + ((size_t)pair * 4 + 3) * HD + ch * 8);
                      o[0] = bf_lo(v.x); o[1] = bf_hi(v.x); o[2] = bf_lo(v.y); o[3] = bf_hi(v.y); o[4] = bf_lo(v.z); o[5] = bf_hi(v.z); o[6] = bf_lo(v.w); o[7] = bf_hi(v.w); }
#pragma unroll
                    for (int e = 0; e < 3; ++e) if (((sel >> (8 * e)) & 0xffu) != 0xffu) {
                        const u32x4 v = *(const u32x4*)(OPART + ((size_t)pair * 4 + e) * HD + ch * 8); l += LPART[(size_t)pair * 4 + e];
                        o[0] += bf_lo(v.x); o[1] += bf_hi(v.x); o[2] += bf_lo(v.y); o[3] += bf_hi(v.y); o[4] += bf_lo(v.z); o[5] += bf_hi(v.z); o[6] += bf_lo(v.w); o[7] += bf_hi(v.w); }
                    const float rl = 1.0f / l;
                                        u32x4 w; w.x = cvt_pk_bf16(o[0] * rl, o[1] * rl); w.y = cvt_pk_bf16(o[2] * rl, o[3] * rl);
                    w.z = cvt_pk_bf16(o[4] * rl, o[5] * rl); w.w = cvt_pk_bf16(o[6] * rl, o[7] * rl);
                    *(u32x4*)(AT + (size_t)m * DI + gc * GW + hl * HD + ch * 8) = w;
                }
            }
        }
        SYNC(6 + 3 * NG);
        if (IN(7 + 3 * NG) && (PH_MASK & 2048)) {
            int tid = threadIdx.x; asm volatile("" : "+v"(tid)); const int lane = tid & 63, wave = __builtin_amdgcn_readfirstlane(tid >> 6); (void)lane; (void)wave;
            pg8::Gemm<DI, DI, DI> gm{AT, WOUT1}; pg8::StaticOrder S; S.init(M, D, G, bx);
            pg8::EpiRes E{out, out}; pg8::MapPlain<DI, DI> MP;
            pg8::gemm_phase(lds, gm, S, MP, E);
        }
    }
}

constexpr int NPHASES = 6 + 3 * NG + 2;

extern "C" void kernel_launch(void* const* d_in, const int* in_sizes, int n_in, void* d_out, int out_size, void* d_ws, size_t ws_size, hipStream_t stream) {
    static int grid = 0;
    if (grid == 0) {
        int dev = 0, cus = 0, per_cu = 0;
        hipGetDevice(&dev);
        hipDeviceGetAttribute(&cus, hipDeviceAttributeMultiprocessorCount, dev);
        hipFuncSetAttribute((const void*)mega_fwd, hipFuncAttributeMaxDynamicSharedMemorySize, LDS_BYTES);
        hipOccupancyMaxActiveBlocksPerMultiprocessor(&per_cu, (const void*)mega_fwd, NTHREADS, LDS_BYTES);
        if (per_cu < 1) { fprintf(stderr, "kernel_launch: occupancy query says %d blocks per CU\n", per_cu); per_cu = 1; }
        grid = cus;
        if (ws_size < WS_END) fprintf(stderr, "kernel_launch: workspace too small: %zu < %zu\n", ws_size, (size_t)WS_END);
    }
    hipMemsetAsync((char*)d_ws + WS_CTL, 0, CTL_BYTES, stream);
    Args a{};
    for (int i = 0; i < 11; ++i) a.in[i] = (const float*)d_in[i];
    a.out = (float*)d_out; a.ws = (unsigned char*)d_ws; a.pad = 0;
#if defined(MK_PER_PHASE)
    for (int ph = 0; ph < NPHASES; ++ph) { a.ph_lo = ph; a.ph_hi = ph + 1; a.coop = 0; hipLaunchKernelGGL(mega_fwd, dim3(grid), dim3(NTHREADS), LDS_BYTES, stream, a); }
#else
    a.ph_lo = 0; a.ph_hi = NPHASES; a.coop = 1;
    void* kargs[] = {&a};
    hipError_t e = hipLaunchCooperativeKernel((const void*)mega_fwd, dim3(grid), dim3(NTHREADS), kargs, LDS_BYTES, stream);
    if (e != hipSuccess) fprintf(stderr, "cooperative launch failed: %s (grid %d)\n", hipGetErrorString(e), grid);
#endif
}
```

```cpp
#include <hip/hip_runtime.h>
#include <hip/hip_cooperative_groups.h>
#include <cstdio>
#include <cstdint>
namespace cg = cooperative_groups;

#define LAS __attribute__((address_space(3)))
typedef unsigned short bf16_t;
typedef short bf16x8 __attribute__((ext_vector_type(8)));
typedef float f32x4 __attribute__((ext_vector_type(4)));
typedef float f32x2 __attribute__((ext_vector_type(2)));
typedef unsigned u32x4 __attribute__((ext_vector_type(4)));
typedef unsigned u32x2 __attribute__((ext_vector_type(2)));

constexpr int SEQ = 8192, NBATCH = 2, M = NBATCH * SEQ, D = 1024, DI = 2048, NH = 16, HD = 128, BLK = 256, NB = SEQ / BLK;
constexpr int NG = 4, HG = NH / NG, GW = HG * HD;
constexpr float EPS = 1e-6f;
constexpr float QSCALE = 0.08838834764831845f * 1.4426950408889634f;

constexpr size_t MiB = 1u << 20;
constexpr size_t WS_CTL = 0, CTL_BYTES = 65536;
constexpr size_t WS_BAR = 8192;
constexpr size_t WS_KMEAN = 1 * MiB;
constexpr size_t WS_SEL = 2 * MiB;
constexpr size_t WS_LPART = 3 * MiB;
constexpr size_t WS_TAB = 4 * MiB;
constexpr size_t WS_WIN1 = 8 * MiB, WS_WOUT1 = 24 * MiB;
constexpr size_t WS_LIST = 28 * MiB;
constexpr size_t WS_WIN0 = 28 * MiB, WS_WP = 36 * MiB, WS_WOUT0 = 38 * MiB;
constexpr size_t WS_H0 = 42 * MiB, WS_POOLED = 42 * MiB, WS_U = 106 * MiB, WS_SZ0 = 170 * MiB;
constexpr size_t WS_H1 = 32 * MiB, WS_QG = 64 * MiB, WS_KG = 80 * MiB, WS_VG = 96 * MiB, WS_SZG = 112 * MiB;
constexpr size_t WS_OPART = 128 * MiB, WS_A = 192 * MiB, WS_END = 256 * MiB;

constexpr int LDS_BYTES = 140 * 1024;
constexpr int NTHREADS = 512;
#ifndef PH_MASK
#define PH_MASK 0xfff
#endif

__device__ __forceinline__ unsigned cvt_pk_bf16(float lo, float hi) { unsigned r; asm volatile("v_cvt_pk_bf16_f32 %0, %1, %2" : "=v"(r) : "v"(lo), "v"(hi)); return r; }
__device__ __forceinline__ float bf_lo(unsigned u) { return __uint_as_float(u << 16); }
__device__ __forceinline__ float bf_hi(unsigned u) { return __uint_as_float(u & 0xffff0000u); }
__device__ __forceinline__ float silu_f(float z) { return z * __builtin_amdgcn_rcpf(1.0f + __builtin_amdgcn_exp2f(-1.4426950408889634f * z)); }
__device__ __forceinline__ float wave_sum(float v) {
#pragma unroll
    for (int o = 1; o < 64; o <<= 1) v += __shfl_xor(v, o);
    return v;
}

namespace pg8 {
constexpr int BM = 256, BK = 64, HALF = 128, HTB = HALF * BK * 2, STAGE_BYTES = 8 * HTB, NXCD = 8, WGM = 8;
__host__ __device__ __forceinline__ int lds_byte(int r, int c) { const int st = (r >> 4) * 2 + (c >> 5), rr = r & 15, cc = c & 31, ob = rr * 64 + cc * 2; return st * 1024 + (ob ^ (((ob >> 9) & 1) << 5)); }
__host__ __device__ __forceinline__ void stage_rc(int b, int& R, int& C) { const int st = b / 1024, sb = b % 1024, swz = sb ^ (((sb >> 9) & 1) << 5); R = (st >> 1) * 16 + swz / 64; C = (st & 1) * 32 + (swz % 64) / 2; }
__host__ __device__ __forceinline__ int perm32(int rho) { const int n = rho >> 4, i = rho & 15; return 8 * (i >> 2) + 4 * n + (i & 3); }

struct Unit { int pm, pn; };
template <int LDA_, int LDB_, int K_> struct Gemm { const bf16_t* A; const bf16_t* Bt; static constexpr int lda = LDA_, ldb = LDB_, K = K_; };
struct StaticOrder {
    int nM, nN, nwg, G, c, base = 0, nr = 1 << 30;
    __device__ void init(int M_, int N_, int G_, int c_) { nM = M_ / BM; nN = N_ / BM; nwg = nM * nN; G = G_; c = c_; }
    __device__ bool next(int i, Unit& u) const {
        if (i >= nr) return false;
        const long L = (long)(base + i) * G + c; if (L >= nwg) return false;
        int wgid = (int)L; { const int q = nwg / NXCD, r = nwg % NXCD, xcd = wgid % NXCD, off = wgid / NXCD; wgid = (xcd < r ? xcd * (q + 1) : r * (q + 1) + (xcd - r) * q) + off; }
        const int nig = WGM * nN, gid = wgid / nig, fm = gid * WGM, gsz = (nM - fm) < WGM ? (nM - fm) : WGM;
        u.pm = fm + ((wgid % nig) % gsz); u.pn = (wgid % nig) / gsz; return true;
    }
};
template <class Epi, class Map, class GemmT>
__device__ __forceinline__ void gemm_phase(LAS unsigned char* lds, const GemmT g, const StaticOrder& S, const Map& MP, const Epi& E) {
    int tid_ = threadIdx.x; asm volatile("" : "+v"(tid_));
    const int tid = tid_, wid = __builtin_amdgcn_readfirstlane(tid >> 6), lane = tid & 63, wr = wid >> 2, wc = wid & 3, fr = lane & 15, fq = lane >> 4;
    constexpr int K = GemmT::K, nt = K / BK;
    unsigned voffA[2], voffB[2];
#pragma unroll
    for (int i = 0; i < 2; ++i) { int R, C; stage_rc(tid * 16 + i * 8192, R, C); const int Rb = Epi::PERM == 1 ? ((R & ~31) + perm32(R & 31)) : Epi::PERM == 2 ? (64 * ((R >> 4) & 1) + 16 * (R >> 5) + (R & 15)) : R;
        voffA[i] = (unsigned)(R * GemmT::lda + C) * 2u; voffB[i] = (unsigned)(Rb * GemmT::ldb + C) * 2u; }
    constexpr size_t kstep = (size_t)(BK * 2);
    constexpr size_t hstepA = (size_t)HALF * GemmT::lda * 2, hstepB = (size_t)HALF * GemmT::ldb * 2;
    const unsigned ldsw = (unsigned)wid * 1024u;
    const int aoff = lds_byte(wr * 64 + fr, fq * 8), boff = lds_byte(wc * 32 + fr, fq * 8);
#define PG8_SA(b, h) (((b) * 2 + (h)) * HTB)
#define PG8_SB(b, h) ((4 + (b) * 2 + (h)) * HTB)
#define PG8_STAGE(bufoff, gbase, voff) do { _Pragma("unroll") for (int _i = 0; _i < 2; ++_i) \
        __builtin_amdgcn_global_load_lds((const unsigned*)((const char*)(gbase) + (voff)[_i]), (LAS unsigned*)(lds + (bufoff) + ldsw + _i * 8192), 16, 0, 0); } while (0)
#define PG8_LDA(dst, b, h) do { _Pragma("unroll") for (int m = 0; m < 4; ++m) _Pragma("unroll") for (int k = 0; k < 2; ++k) dst[m][k] = *(const LAS bf16x8*)(lds + PG8_SA(b, h) + aoff + m * 2048 + k * 1024); } while (0)
#define PG8_LDB(dst, b, h) do { _Pragma("unroll") for (int n = 0; n < 2; ++n) _Pragma("unroll") for (int k = 0; k < 2; ++k) dst[n][k] = *(const LAS bf16x8*)(lds + PG8_SB(b, h) + boff + n * 2048 + k * 1024); } while (0)
#define PG8_MMA(ai, bj, At, Bt) do { __builtin_amdgcn_s_setprio(1); _Pragma("unroll") for (int m = 0; m < 4; ++m) _Pragma("unroll") for (int n = 0; n < 2; ++n) _Pragma("unroll") for (int k = 0; k < 2; ++k) \
        acc[ai][bj][m][n] = __builtin_amdgcn_mfma_f32_16x16x32_bf16(Bt[n][k], At[m][k], acc[ai][bj][m][n], 0, 0, 0); __builtin_amdgcn_s_setprio(0); } while (0)
#define PG8_WAIT_V(n) asm volatile("s_waitcnt vmcnt(" #n ")" ::: "memory")
#define PG8_WAIT_L(n) asm volatile("s_waitcnt lgkmcnt(" #n ")" ::: "memory")
#define PG8_BAR __builtin_amdgcn_s_barrier()
#define PG8_SCHED __builtin_amdgcn_sched_barrier(0)
    Unit cur, nxt; int ui = 0;
    if (!S.next(0, cur)) return;
    f32x4 acc[2][2][4][2];
#pragma unroll
    for (int a = 0; a < 2; ++a)
#pragma unroll
        for (int b = 0; b < 2; ++b)
#pragma unroll
            for (int m = 0; m < 4; ++m)
#pragma unroll
                for (int n = 0; n < 2; ++n) acc[a][b][m][n] = (f32x4){0.f, 0.f, 0.f, 0.f};
    bf16x8 At[4][2], B0[2][2], B1[2][2];
    const char* cA = (const char*)(g.A + MP.a_off(cur)); const char* cB = (const char*)(g.Bt + MP.b_off(cur));
    PG8_STAGE(PG8_SB(0, 0), cB, voffB); PG8_STAGE(PG8_SB(0, 1), cB + hstepB, voffB); PG8_STAGE(PG8_SA(0, 0), cA, voffA); PG8_STAGE(PG8_SA(0, 1), cA + hstepA, voffA);
    if (wr == 1) PG8_BAR;
    PG8_WAIT_V(2); PG8_BAR;
    PG8_STAGE(PG8_SB(1, 0), cB + kstep, voffB); PG8_STAGE(PG8_SA(1, 0), cA + kstep, voffA); PG8_STAGE(PG8_SB(1, 1), cB + hstepB + kstep, voffB);
    PG8_WAIT_V(6); PG8_BAR;
    for (;;) {
        const bool has_next = S.next(ui + 1, nxt);
        const char* nA = has_next ? (const char*)(g.A + MP.a_off(nxt)) : cA; const char* nB = has_next ? (const char*)(g.Bt + MP.b_off(nxt)) : cB;
        for (int t = 0; t < nt; t += 2) {
            const bool last = (t == nt - 2);
            const char* a1 = cA + (size_t)(t + 1) * kstep;
            const char* a2 = last ? nA : cA + (size_t)(t + 2) * kstep; const char* b2 = last ? nB : cB + (size_t)(t + 2) * kstep;
            const char* a3 = a2 + kstep; const char* b3 = b2 + kstep;
            PG8_LDB(B0, 0, 0); PG8_LDB(B1, 0, 1); PG8_SCHED; PG8_LDA(At, 0, 0); PG8_STAGE(PG8_SA(1, 1), a1 + hstepA, voffA);
            PG8_WAIT_V(8); PG8_WAIT_L(0); PG8_BAR; PG8_MMA(0, 0, At, B0); PG8_MMA(0, 1, At, B1); PG8_BAR; PG8_SCHED;
            PG8_LDA(At, 0, 1); PG8_STAGE(PG8_SB(0, 0), b2, voffB); PG8_STAGE(PG8_SB(0, 1), b2 + hstepB, voffB); PG8_STAGE(PG8_SA(0, 0), a2, voffA);
            PG8_WAIT_V(8); PG8_WAIT_L(0); PG8_BAR; PG8_MMA(1, 0, At, B0); PG8_MMA(1, 1, At, B1); PG8_BAR; PG8_SCHED;
            PG8_LDB(B0, 1, 0); PG8_LDB(B1, 1, 1); PG8_SCHED; PG8_LDA(At, 1, 0); PG8_STAGE(PG8_SA(0, 1), a2 + hstepA, voffA);
            PG8_WAIT_V(8); PG8_WAIT_L(0); PG8_BAR; PG8_MMA(0, 0, At, B0); PG8_MMA(0, 1, At, B1); PG8_BAR; PG8_SCHED;
            PG8_LDA(At, 1, 1); PG8_STAGE(PG8_SB(1, 0), b3, voffB); PG8_STAGE(PG8_SB(1, 1), b3 + hstepB, voffB); PG8_STAGE(PG8_SA(1, 0), a3, voffA);
            PG8_WAIT_V(8); PG8_WAIT_L(0); PG8_BAR; PG8_MMA(1, 0, At, B0); PG8_MMA(1, 1, At, B1); PG8_BAR; PG8_SCHED;
        }
        if (wr == 0) PG8_BAR;
        if constexpr (!Epi::AFTER_DRAIN) E(acc, cur, wr, wc, fr, fq);
        if (!has_next) break;
#pragma unroll
        for (int a = 0; a < 2; ++a)
#pragma unroll
            for (int b = 0; b < 2; ++b)
#pragma unroll
                for (int m = 0; m < 4; ++m)
#pragma unroll
                    for (int n = 0; n < 2; ++n) acc[a][b][m][n] = (f32x4){0.f, 0.f, 0.f, 0.f};
        cur = nxt; cA = nA; cB = nB; ++ui;
        if (wr == 1) PG8_BAR;
    }
    PG8_WAIT_V(0);
    PG8_BAR;
    if constexpr (Epi::AFTER_DRAIN) E(acc, cur, wr, wc, fr, fq);
#undef PG8_SA
#undef PG8_SB
#undef PG8_STAGE
#undef PG8_LDA
#undef PG8_LDB
#undef PG8_MMA
#undef PG8_WAIT_V
#undef PG8_WAIT_L
#undef PG8_BAR
#undef PG8_SCHED
}

template <int ldc, int tiles_per_dst, int silu_dst> struct EpiSplit {
    static constexpr int PERM = 1; static constexpr bool AFTER_DRAIN = false;
    bf16_t *d0, *d1, *d2, *d3;
    __device__ __forceinline__ void operator()(const f32x4 (&acc)[2][2][4][2], const Unit& u, int wr, int wc, int fr, int fq) const {
        const int di = u.pn / tiles_per_dst, ct = u.pn - di * tiles_per_dst;
        bf16_t* base = di == 0 ? d0 : di == 1 ? d1 : di == 2 ? d2 : d3; const bool act = (di == silu_dst);
        const int row0 = u.pm * BM + wr * 64 + fr, col0 = ct * BM + wc * 32 + 8 * fq;
#pragma unroll
        for (int ai = 0; ai < 2; ++ai)
#pragma unroll
            for (int m = 0; m < 4; ++m) { bf16_t* rowp = base + (size_t)(row0 + ai * HALF + m * 16) * ldc + col0;
#pragma unroll
                for (int bj = 0; bj < 2; ++bj) { f32x4 v0 = acc[ai][bj][m][0], v1 = acc[ai][bj][m][1];
                    if (act) { v0 = (f32x4){silu_f(v0[0]), silu_f(v0[1]), silu_f(v0[2]), silu_f(v0[3])}; v1 = (f32x4){silu_f(v1[0]), silu_f(v1[1]), silu_f(v1[2]), silu_f(v1[3])}; }
                    u32x4 w; w.x = cvt_pk_bf16(v0[0], v0[1]); w.y = cvt_pk_bf16(v0[2], v0[3]); w.z = cvt_pk_bf16(v1[0], v1[1]); w.w = cvt_pk_bf16(v1[2], v1[3]);
                    *(u32x4*)(rowp + bj * HALF) = w; } }
    }
};
struct EpiGate {
    static constexpr int PERM = 1; static constexpr bool AFTER_DRAIN = false; static constexpr int ldc = DI;
    bf16_t* Y; const bf16_t* SZ; const float* scale;
    __device__ __forceinline__ void operator()(const f32x4 (&acc)[2][2][4][2], const Unit& u, int wr, int wc, int fr, int fq) const {
        const int row0 = u.pm * BM + wr * 64 + fr, col0 = u.pn * BM + wc * 32 + 8 * fq;
        f32x4 sc[2][2];
#pragma unroll
        for (int bj = 0; bj < 2; ++bj) { sc[bj][0] = *(const f32x4*)(scale + col0 + bj * HALF); sc[bj][1] = *(const f32x4*)(scale + col0 + bj * HALF + 4); }
#pragma unroll
        for (int ai = 0; ai < 2; ++ai)
#pragma unroll
            for (int m = 0; m < 4; ++m) { const size_t off = (size_t)(row0 + ai * HALF + m * 16) * ldc + col0;
#pragma unroll
                for (int bj = 0; bj < 2; ++bj) { const u32x4 z = *(const u32x4*)(SZ + off + bj * HALF);
                    const f32x4 v0 = acc[ai][bj][m][0] * sc[bj][0], v1 = acc[ai][bj][m][1] * sc[bj][1];
                    u32x4 w; w.x = cvt_pk_bf16(v0[0] * bf_lo(z.x), v0[1] * bf_hi(z.x)); w.y = cvt_pk_bf16(v0[2] * bf_lo(z.y), v0[3] * bf_hi(z.y));
                    w.z = cvt_pk_bf16(v1[0] * bf_lo(z.z), v1[1] * bf_hi(z.z)); w.w = cvt_pk_bf16(v1[2] * bf_lo(z.w), v1[3] * bf_hi(z.w));
                    *(u32x4*)(Y + off + bj * HALF) = w; } }
    }
};
struct EpiRes {
    static constexpr int PERM = 0; static constexpr bool AFTER_DRAIN = false; static constexpr int ldc = D;
    const float* base; float* out;
    __device__ __forceinline__ void operator()(const f32x4 (&acc)[2][2][4][2], const Unit& u, int wr, int wc, int fr, int fq) const {
        const int row0 = u.pm * BM + wr * 64 + fr, col0 = u.pn * BM + wc * 32 + 4 * fq;
#pragma unroll
        for (int ai = 0; ai < 2; ++ai)
#pragma unroll
            for (int m = 0; m < 4; ++m) { const size_t off = (size_t)(row0 + ai * HALF + m * 16) * ldc + col0;
#pragma unroll
                for (int bj = 0; bj < 2; ++bj)
#pragma unroll
                    for (int n = 0; n < 2; ++n) { const f32x4 b = *(const f32x4*)(base + off + bj * HALF + n * 16); *(f32x4*)(out + off + bj * HALF + n * 16) = b + acc[ai][bj][m][n]; } }
    }
};
struct EpiQkvz {
    static constexpr int PERM = 2; static constexpr bool AFTER_DRAIN = false;
    bf16_t *q, *k, *v, *sz; const float *gq, *gk; const f32x2* tab; float* kmean; LAS unsigned char* xl;
    __device__ __forceinline__ void operator()(const f32x4 (&acc)[2][2][4][2], const Unit& u, int wr_, int wc_, int fr_, int fq_) const {
        int wr = wr_, wc = wc_, fr = fr_, fq = fq_;
        asm volatile("" : "+s"(wr), "+s"(wc), "+v"(fr), "+v"(fq));
        const int part = u.pn >> 1, ct = u.pn & 1;
        const int row0 = u.pm * BM + wr * 64 + fr, colb = ct * BM + wc * 16 + fq * 4;
        if (part >= 2) {
            bf16_t* base = part == 2 ? v : sz;
#pragma unroll
            for (int ai = 0; ai < 2; ++ai)
#pragma unroll
                for (int m = 0; m < 4; ++m) { bf16_t* rowp = base + (size_t)(row0 + ai * HALF + m * 16) * GW + colb;
#pragma unroll
                    for (int bj = 0; bj < 2; ++bj)
#pragma unroll
                        for (int n = 0; n < 2; ++n) { f32x4 t = acc[ai][bj][m][n];
                            if (part == 3) t = (f32x4){silu_f(t[0]), silu_f(t[1]), silu_f(t[2]), silu_f(t[3])};
                            u32x2 w; w.x = cvt_pk_bf16(t[0], t[1]); w.y = cvt_pk_bf16(t[2], t[3]); *(u32x2*)(rowp + bj * HALF + n * 64) = w; } }
        } else {
            LAS float* P = (LAS float*)xl;
#pragma unroll
            for (int ai = 0; ai < 2; ++ai)
#pragma unroll
                for (int m = 0; m < 4; ++m)
#pragma unroll
                    for (int bj = 0; bj < 2; ++bj) { const f32x4 a = acc[ai][bj][m][0], b = acc[ai][bj][m][1];
                        float sq = (a[0] * a[0] + a[1] * a[1]) + (a[2] * a[2] + a[3] * a[3]) + (b[0] * b[0] + b[1] * b[1]) + (b[2] * b[2] + b[3] * b[3]);
                        sq += __shfl_xor(sq, 16); sq += __shfl_xor(sq, 32);
                        if (fq == 0) P[(ai * HALF + wr * 64 + m * 16 + fr) * 8 + bj * 4 + wc] = sq; }
            asm volatile("s_waitcnt lgkmcnt(0)" ::: "memory"); __builtin_amdgcn_s_barrier(); asm volatile("" ::: "memory");
            const float* gain = part == 0 ? gq : gk; const float sc = part == 0 ? QSCALE : 1.0f;
            const f32x4 g1 = *(const f32x4*)(gain + wc * 16 + fq * 4), g2 = *(const f32x4*)(gain + 64 + wc * 16 + fq * 4);
            bf16_t* base = part == 0 ? q : k;
            f32x4 ks[2][2];
#pragma unroll
            for (int bj = 0; bj < 2; ++bj) { ks[bj][0] = (f32x4){0.f, 0.f, 0.f, 0.f}; ks[bj][1] = (f32x4){0.f, 0.f, 0.f, 0.f}; }
#pragma unroll
            for (int ai = 0; ai < 2; ++ai)
#pragma unroll
                for (int m = 0; m < 4; ++m) { const int r = ai * HALF + wr * 64 + m * 16 + fr, R = u.pm * BM + r, pos = R & (SEQ - 1);
                    const f32x4* tp = (const f32x4*)(tab + pos * 64 + wc * 16 + fq * 4);
                    const f32x4 t0 = tp[0], t1 = tp[1];
                    const f32x4 cs = {t0.x, t0.z, t1.x, t1.z}, sn = {t0.y, t0.w, t1.y, t1.w};
                    bf16_t* rowp = base + (size_t)R * GW + colb;
#pragma unroll
                    for (int bj = 0; bj < 2; ++bj) { const f32x4 pp = *(const LAS f32x4*)(P + r * 8 + bj * 4);
                        const float rstd = sc / sqrtf(((pp.x + pp.y) + (pp.z + pp.w)) * (1.f / HD) + EPS);
                        const f32x4 x1 = acc[ai][bj][m][0] * rstd * g1, x2 = acc[ai][bj][m][1] * rstd * g2;
                        const f32x4 o1 = x1 * cs - x2 * sn, o2 = x2 * cs + x1 * sn;
                        ks[bj][0] += o1; ks[bj][1] += o2; asm volatile("" : "+v"(ks[bj][0]), "+v"(ks[bj][1]));
                        u32x2 w1, w2; w1.x = cvt_pk_bf16(o1[0], o1[1]); w1.y = cvt_pk_bf16(o1[2], o1[3]); w2.x = cvt_pk_bf16(o2[0], o2[1]); w2.y = cvt_pk_bf16(o2[2], o2[3]);
                        *(u32x2*)(rowp + bj * HALF) = w1; *(u32x2*)(rowp + bj * HALF + 64) = w2; }
                    asm volatile("" ::: "memory"); }
            if (part == 1) {
                LAS float* KS = (LAS float*)(xl + 8192);
#pragma unroll
                for (int bj = 0; bj < 2; ++bj)
#pragma unroll
                    for (int n = 0; n < 2; ++n)
#pragma unroll
                        for (int e = 0; e < 4; ++e) { float vsum = ks[bj][n][e]; vsum += __shfl_xor(vsum, 1); vsum += __shfl_xor(vsum, 2); vsum += __shfl_xor(vsum, 4); vsum += __shfl_xor(vsum, 8);
                            if (fr == 0) KS[wr * 256 + bj * HALF + n * 64 + wc * 16 + fq * 4 + e] = vsum; }
                asm volatile("s_waitcnt lgkmcnt(0)" ::: "memory"); __builtin_amdgcn_s_barrier(); asm volatile("" ::: "memory");
                const int t_ = threadIdx.x;
                if (t_ < 256) { const float vv = KS[t_] + KS[256 + t_]; const int hl = ct * 2 + (t_ >> 7), d = t_ & 127, b = u.pm >> 5, nb = u.pm & 31;
                    kmean[((size_t)(b * HG + hl) * NB + nb) * HD + d] = vv * (1.f / BLK); }
            }
        }
    }
};
struct MapPlain_marker_unused {};
template <int lda, int ldb> struct MapPlain { __device__ __forceinline__ size_t a_off(const Unit& u) const { return (size_t)u.pm * BM * lda; } __device__ __forceinline__ size_t b_off(const Unit& u) const { return (size_t)u.pn * BM * ldb; } };
struct MapPool { __device__ __forceinline__ size_t a_off(const Unit& u) const { return (size_t)u.pm * BM * DI + (size_t)(u.pn >> 1) * 512; } __device__ __forceinline__ size_t b_off(const Unit& u) const { return (size_t)u.pn * BM * 512; } };
struct MapQkvz { int g; __device__ __forceinline__ size_t a_off(const Unit& u) const { return (size_t)u.pm * BM * D; } __device__ __forceinline__ size_t b_off(const Unit& u) const { return (size_t)((u.pn >> 1) * DI + g * GW + (u.pn & 1) * BM) * D; } };
}

#define XB_TMO      128
#define XB_XCNT(j)  (256  + 64 * (j))
#define XB_XSUB(j)  (1280 + 64 * (j))
#define XB_XGEN(j)  (2304 + 64 * (j))
#define XB_TOP      3328
#define XB_TOPGEN   3392
#define XCD_BAR_WORDS 3456
#define XB_SPIN_CAP (1u << 18)
__device__ __forceinline__ unsigned xb_ld(unsigned* p)              { return __hip_atomic_load(p, __ATOMIC_RELAXED, __HIP_MEMORY_SCOPE_AGENT); }
__device__ __forceinline__ unsigned xb_add(unsigned* p, unsigned v) { return __hip_atomic_fetch_add(p, v, __ATOMIC_RELAXED, __HIP_MEMORY_SCOPE_AGENT); }
__device__ __forceinline__ unsigned xb_xcc_id() { return (unsigned)__builtin_amdgcn_s_getreg((3 << 11) | 20) & 0xFu; }
#define XB_SPIN(cond, bar) do { unsigned _sp = 0; while (cond) { __builtin_amdgcn_s_sleep(1); \
    if ((++_sp & 255u) == 0u) { if (xb_ld(&(bar)[XB_TMO])) break; if (_sp > XB_SPIN_CAP) { atomicAdd(&(bar)[XB_TMO], 1u); break; } } } } while (0)
struct XcdBarrier { unsigned* bar; unsigned x; volatile LAS unsigned* st; };
__device__ __forceinline__ XcdBarrier xcd_barrier_post(unsigned* bar, volatile LAS unsigned* st) {
    XcdBarrier b; b.bar = bar; b.x = xb_xcc_id(); b.st = st;
    if (threadIdx.x == 0) (void)xb_add(&bar[XB_XCNT(b.x)], 1u);
    return b;
}
__device__ __forceinline__ void xcd_barrier_complete(unsigned* bar, unsigned x, unsigned& nloc, unsigned& nx) {
    const unsigned G = gridDim.x * gridDim.y * gridDim.z;
    unsigned sum, cnt, mine, sp = 0u;
    for (;;) {
        sum = 0u; cnt = 0u; mine = 0u;
#pragma unroll
        for (unsigned j = 0; j < 16; ++j) { const unsigned c = xb_ld(&bar[XB_XCNT(j)]); sum += c; cnt += (c > 0u) ? 1u : 0u; mine = (j == x) ? c : mine; }
        if (sum == G) break;
        __builtin_amdgcn_s_sleep(1);
        if ((++sp & 255u) == 0u) { if (xb_ld(&bar[XB_TMO])) break; if (sp > XB_SPIN_CAP) { atomicAdd(&bar[XB_TMO], 1u); break; } }
    }
    nloc = mine > 0u ? mine : 1u; nx = cnt > 0u ? cnt : 1u;
}
__device__ __forceinline__ void xcd_barrier(const XcdBarrier& b) {
    asm volatile("s_waitcnt vmcnt(0)" ::: "memory");
    __syncthreads();
    if (threadIdx.x == 0) {
        unsigned* bar = b.bar;
        __builtin_amdgcn_s_waitcnt(0);
        unsigned nloc = b.st[0], nx = b.st[1];
        if (nloc == 0u) { xcd_barrier_complete(bar, b.x, nloc, nx); b.st[0] = nloc; b.st[1] = nx; }
        const unsigned old = xb_add(&bar[XB_XSUB(b.x)], 1u);
        const unsigned gen = old / nloc;
        if (old + 1u == (gen + 1u) * nloc) {
            __builtin_amdgcn_fence(__ATOMIC_RELEASE, "agent");
            asm volatile("s_waitcnt vmcnt(0)" ::: "memory");
            const unsigned og = xb_add(&bar[XB_TOP], 1u);
            const unsigned tg = og / nx;
            if (og + 1u == (tg + 1u) * nx) xb_add(&bar[XB_TOPGEN], 1u);
            else XB_SPIN(xb_ld(&bar[XB_TOPGEN]) == tg, bar);
            __builtin_amdgcn_fence(__ATOMIC_ACQUIRE, "agent");
            xb_add(&bar[XB_XGEN(b.x)], 1u);
            asm volatile("s_waitcnt vmcnt(0)" ::: "memory");
        } else {
            XB_SPIN(xb_ld(&bar[XB_XGEN(b.x)]) == gen, bar);
            __builtin_amdgcn_fence(__ATOMIC_ACQUIRE, "agent");
            asm volatile("s_waitcnt vmcnt(0)" ::: "memory");
        }
    }
    __syncthreads();
}

struct Args { const float* in[11]; float* out; unsigned char* ws; int ph_lo, ph_hi, coop, pad; };

__device__ __forceinline__ void transpose_item(const float* W, int K, int N, bf16_t* WT, LAS float* scr, int item, int lane) {
    const int nblk = N / 32, kb = item / nblk, nb = item % nblk, k0 = 64 * kb, n0 = 32 * nb;
#pragma unroll 8
    for (int i = 0; i < 32; ++i) { const int kk = 2 * i + (lane >> 5); scr[kk * 33 + (lane & 31)] = W[(size_t)(k0 + kk) * N + n0 + (lane & 31)]; }
    asm volatile("s_waitcnt lgkmcnt(0)" ::: "memory");
    const int c = lane & 7;
#pragma unroll
    for (int j = 0; j < 4; ++j) { const int n = (lane >> 3) + 8 * j; const LAS float* s = scr + (8 * c) * 33 + n;
        u32x4 o; o.x = cvt_pk_bf16(s[0 * 33], s[1 * 33]); o.y = cvt_pk_bf16(s[2 * 33], s[3 * 33]); o.z = cvt_pk_bf16(s[4 * 33], s[5 * 33]); o.w = cvt_pk_bf16(s[6 * 33], s[7 * 33]);
        *(u32x4*)(WT + (size_t)(n0 + n) * K + k0 + 8 * c) = o; }
    asm volatile("s_waitcnt lgkmcnt(0)" ::: "memory");
}
template <int NR>
__device__ __forceinline__ void rms_rows(const float* xbase, const float* gain, bf16_t* obase, int m, int stride, int lane) {
    f32x4 v[NR][4]; float s[NR];
#pragma unroll
    for (int r = 0; r < NR; ++r) { const f32x4* xr = (const f32x4*)(xbase + (size_t)(m + r * stride) * D) + lane;
#pragma unroll
        for (int j = 0; j < 4; ++j) v[r][j] = xr[64 * j]; }
#pragma unroll
    for (int r = 0; r < NR; ++r) { float a = 0.f;
#pragma unroll
        for (int j = 0; j < 4; ++j) a += (v[r][j].x * v[r][j].x + v[r][j].y * v[r][j].y) + (v[r][j].z * v[r][j].z + v[r][j].w * v[r][j].w);
        s[r] = 1.0f / sqrtf(wave_sum(a) * (1.f / D) + EPS); }
    const f32x4* gr = (const f32x4*)gain + lane;
#pragma unroll
    for (int j = 0; j < 4; ++j) { const f32x4 gg = gr[64 * j];
#pragma unroll
        for (int r = 0; r < NR; ++r) { u32x2 w; w.x = cvt_pk_bf16(v[r][j].x * s[r] * gg.x, v[r][j].y * s[r] * gg.y); w.y = cvt_pk_bf16(v[r][j].z * s[r] * gg.z, v[r][j].w * s[r] * gg.w);
            ((u32x2*)(obase + (size_t)(m + r * stride) * D) + lane)[64 * j] = w; } }
}
__device__ __forceinline__ void rope_entry(int idx, f32x2* tab) {
    const int pos = idx >> 6, i = idx & 63;
    const float inv = (float)exp2(-(double)(2 * i) * (13.287712379549449 / 128.0));
    const float angf = (float)pos * inv;
    const double a = (double)angf; const double q = rint(a * 0.6366197723675814); const double r = a - q * 1.5707963267948966;
    const double r2 = r * r;
    double sn = r * (1.0 - r2 / 6.0 * (1.0 - r2 / 20.0 * (1.0 - r2 / 42.0 * (1.0 - r2 / 72.0 * (1.0 - r2 / 110.0 * (1.0 - r2 / 156.0))))));
    double cs = 1.0 - r2 / 2.0 * (1.0 - r2 / 12.0 * (1.0 - r2 / 30.0 * (1.0 - r2 / 56.0 * (1.0 - r2 / 90.0 * (1.0 - r2 / 132.0)))));
    const int qi = ((int)q) & 3;
    double c2, s2;
    if (qi == 0) { c2 = cs; s2 = sn; } else if (qi == 1) { c2 = -sn; s2 = cs; } else if (qi == 2) { c2 = -cs; s2 = -sn; } else { c2 = sn; s2 = -cs; }
    tab[idx] = (f32x2){(float)c2, (float)s2};
}

__global__ void __launch_bounds__(NTHREADS, 2) mega_fwd(Args args) {
    extern __shared__ __attribute__((aligned(16))) unsigned char lds_raw[];
    LAS unsigned char* lds = (LAS unsigned char*)lds_raw;
    cg::grid_group grid = cg::this_grid();
    const int G = gridDim.x, bx = blockIdx.x;
    volatile LAS unsigned* bst = (volatile LAS unsigned*)(lds + LDS_BYTES - 16);
    if (threadIdx.x < 4) bst[threadIdx.x] = 0u;
    __syncthreads();
    XcdBarrier xbar; xbar.bar = (unsigned*)(args.ws + WS_BAR); xbar.x = 0; xbar.st = bst;
    if (args.coop) xbar = xcd_barrier_post((unsigned*)(args.ws + WS_BAR), bst);
    unsigned char* ws = args.ws;
#define XIN (args.in[0])
#define norm0 (args.in[1])
#define w_in0 (args.in[2])
#define w_pool0 (args.in[3])
#define pool_scale0 (args.in[4])
#define w_out0 (args.in[5])
#define norm1 (args.in[6])
#define w_in1 (args.in[7])
#define q_norm1 (args.in[8])
#define k_norm1 (args.in[9])
#define w_out1 (args.in[10])
    float* out = args.out;
#define WIN0 ((bf16_t*)(ws + WS_WIN0))
#define WP ((bf16_t*)(ws + WS_WP))
#define WOUT0 ((bf16_t*)(ws + WS_WOUT0))
#define WIN1 ((bf16_t*)(ws + WS_WIN1))
#define WOUT1 ((bf16_t*)(ws + WS_WOUT1))
#define H0 ((bf16_t*)(ws + WS_H0))
#define POOLED ((bf16_t*)(ws + WS_POOLED))
#define U ((bf16_t*)(ws + WS_U))
#define SZ0 ((bf16_t*)(ws + WS_SZ0))
#define H1 ((bf16_t*)(ws + WS_H1))
#define QG ((bf16_t*)(ws + WS_QG))
#define KG ((bf16_t*)(ws + WS_KG))
#define VG ((bf16_t*)(ws + WS_VG))
#define SZG ((bf16_t*)(ws + WS_SZG))
#define OPART ((bf16_t*)(ws + WS_OPART))
#define AT ((bf16_t*)(ws + WS_A))
#define KMEAN ((float*)(ws + WS_KMEAN))
#define SEL ((unsigned*)(ws + WS_SEL))
#define LPART ((float*)(ws + WS_LPART))
#define TAB ((f32x2*)(ws + WS_TAB))
#define LIST ((unsigned short*)(ws + WS_LIST))
#define CNT ((unsigned*)(ws + WS_CTL))
    const int lo = args.ph_lo, hi = args.ph_hi;
#define IN(k) (lo <= (k) && (k) < hi)
#define SYNC(k) do { if (IN(k) && IN((k) + 1) && args.coop) { if (args.coop == 2) grid.sync(); else xcd_barrier(xbar); } } while (0)
    {
        if (IN(0) && (PH_MASK & 1)) {
            int tid = threadIdx.x; asm volatile("" : "+v"(tid)); const int lane = tid & 63, wave = __builtin_amdgcn_readfirstlane(tid >> 6); (void)lane; (void)wave;
            LAS float* scr = (LAS float*)(lds + wave * 16384);
            const int gw = bx * 8 + wave, NGW = G * 8;
            constexpr int I0 = (D / 64) * (2 * DI / 32), IP = (512 / 64) * (512 / 32), I1 = (DI / 64) * (D / 32), I2 = (D / 64) * (4 * DI / 32), I3 = I1;
            constexpr int NITEMS = I0 + 4 * IP + I1 + I2 + I3;
            for (int it = gw; it < NITEMS; it += NGW) {
                int r = it;
                if (r < I0) { transpose_item(w_in0, D, 2 * DI, WIN0, scr, r, lane); continue; } r -= I0;
                if (r < 4 * IP) { const int gp = r / IP; transpose_item(w_pool0 + (size_t)gp * 512 * 512, 512, 512, WP + (size_t)gp * 512 * 512, scr, r - gp * IP, lane); continue; } r -= 4 * IP;
                if (r < I1) { transpose_item(w_out0, DI, D, WOUT0, scr, r, lane); continue; } r -= I1;
                if (r < I2) { transpose_item(w_in1, D, 4 * DI, WIN1, scr, r, lane); continue; } r -= I2;
                transpose_item(w_out1, DI, D, WOUT1, scr, r, lane);
            }
            for (int idx = bx * NTHREADS + tid; idx < SEQ * 64; idx += G * NTHREADS) rope_entry(idx, TAB);
            for (int m = gw; m < M; m += 4 * NGW) { if (m + 3 * NGW < M) rms_rows<4>(XIN, norm0, H0, m, NGW, lane); else for (int r = 0; r < 4; ++r) if (m + r * NGW < M) rms_rows<1>(XIN, norm0, H0, m + r * NGW, 0, lane); }
        }
        SYNC(0);
        if (IN(1) && (PH_MASK & 2)) {
            int tid = threadIdx.x; asm volatile("" : "+v"(tid)); const int lane = tid & 63, wave = __builtin_amdgcn_readfirstlane(tid >> 6); (void)lane; (void)wave;
            pg8::Gemm<D, D, D> g{H0, WIN0}; pg8::StaticOrder S; S.init(M, 2 * DI, G, bx);
            pg8::EpiSplit<DI, 8, 1> E{U, SZ0, U, U}; pg8::MapPlain<D, D> MP;
            pg8::gemm_phase(lds, g, S, MP, E);
        }
        SYNC(1);
        if (IN(2) && (PH_MASK & 4)) {
            int tid = threadIdx.x; asm volatile("" : "+v"(tid)); const int lane = tid & 63, wave = __builtin_amdgcn_readfirstlane(tid >> 6); (void)lane; (void)wave;
            const int cgp = tid & 255, hh = tid >> 8, col = cgp * 8, w = 2 << (cgp >> 6);
            for (int unit = bx; unit < M / 64; unit += G) {
                const int r0 = unit * 64 + hh * 32, p0 = r0 & (SEQ - 1);
                float sum[8];
#pragma unroll
                for (int e = 0; e < 8; ++e) sum[e] = 0.f;
                for (int i = 1; i < w; ++i) { if (p0 - i >= 0) { const u32x4 v = *(const u32x4*)(U + (size_t)(r0 - i) * DI + col);
                    sum[0] += bf_lo(v.x); sum[1] += bf_hi(v.x); sum[2] += bf_lo(v.y); sum[3] += bf_hi(v.y); sum[4] += bf_lo(v.z); sum[5] += bf_hi(v.z); sum[6] += bf_lo(v.w); sum[7] += bf_hi(v.w); } }
#pragma unroll 1
                for (int tb = 0; tb < 32; tb += 8) {
                    u32x4 nw[8], tr[8];
#pragma unroll
                    for (int t = 0; t < 8; ++t) nw[t] = *(const u32x4*)(U + (size_t)(r0 + tb + t) * DI + col);
#pragma unroll
                    for (int t = 0; t < 8; ++t) { const int pl = p0 + tb + t - w + 1; tr[t] = (u32x4){0u, 0u, 0u, 0u}; if (pl >= 0) tr[t] = *(const u32x4*)(U + (size_t)(r0 + tb + t - w + 1) * DI + col); }
#pragma unroll
                    for (int t = 0; t < 8; ++t) {
                        const int p = p0 + tb + t; const u32x4 v = nw[t];
                        float c[8] = {bf_lo(v.x), bf_hi(v.x), bf_lo(v.y), bf_hi(v.y), bf_lo(v.z), bf_hi(v.z), bf_lo(v.w), bf_hi(v.w)};
                        const float rc = 1.0f / (float)((p + 1) < w ? (p + 1) : w);
                        float o[8];
#pragma unroll
                        for (int e = 0; e < 8; ++e) { sum[e] += c[e]; o[e] = sum[e] * rc - c[e]; }
                        u32x4 wv; wv.x = cvt_pk_bf16(o[0], o[1]); wv.y = cvt_pk_bf16(o[2], o[3]); wv.z = cvt_pk_bf16(o[4], o[5]); wv.w = cvt_pk_bf16(o[6], o[7]);
                        *(u32x4*)(POOLED + (size_t)(r0 + tb + t) * DI + col) = wv;
                        const u32x4 q = tr[t];
                        sum[0] -= bf_lo(q.x); sum[1] -= bf_hi(q.x); sum[2] -= bf_lo(q.y); sum[3] -= bf_hi(q.y); sum[4] -= bf_lo(q.z); sum[5] -= bf_hi(q.z); sum[6] -= bf_lo(q.w); sum[7] -= bf_hi(q.w);
                    }
                }
            }
        }
        SYNC(2);
        if (IN(3) && (PH_MASK & 8)) {
            int tid = threadIdx.x; asm volatile("" : "+v"(tid)); const int lane = tid & 63, wave = __builtin_amdgcn_readfirstlane(tid >> 6); (void)lane; (void)wave;
            pg8::Gemm<DI, 512, 512> g{POOLED, WP}; pg8::StaticOrder S; S.init(M, DI, G, bx);
            pg8::EpiGate E{U, SZ0, pool_scale0}; pg8::MapPool MP;
            pg8::gemm_phase(lds, g, S, MP, E);
        }
        SYNC(3);
        if (IN(4) && (PH_MASK & 16)) {
            int tid = threadIdx.x; asm volatile("" : "+v"(tid)); const int lane = tid & 63, wave = __builtin_amdgcn_readfirstlane(tid >> 6); (void)lane; (void)wave;
            pg8::Gemm<DI, DI, DI> g{U, WOUT0}; pg8::StaticOrder S; S.init(M, D, G, bx);
            pg8::EpiRes E{XIN, out}; pg8::MapPlain<DI, DI> MP;
            pg8::gemm_phase(lds, g, S, MP, E);
        }
        SYNC(4);
        if (IN(5) && (PH_MASK & 32)) {
            int tid = threadIdx.x; asm volatile("" : "+v"(tid)); const int lane = tid & 63, wave = __builtin_amdgcn_readfirstlane(tid >> 6); (void)lane; (void)wave;
            const int gw = bx * 8 + wave, NGW = G * 8;
            for (int m = gw; m < M; m += 4 * NGW) { if (m + 3 * NGW < M) rms_rows<4>(out, norm1, H1, m, NGW, lane); else for (int r = 0; r < 4; ++r) if (m + r * NGW < M) rms_rows<1>(out, norm1, H1, m + r * NGW, 0, lane); }
        }
        SYNC(5);
#pragma unroll
        for (int g = 0; g < NG; ++g) {
            const int pb = 6 + 3 * g;
            if (IN(pb) && (PH_MASK & 64)) {
            int tid = threadIdx.x; asm volatile("" : "+v"(tid)); const int lane = tid & 63, wave = __builtin_amdgcn_readfirstlane(tid >> 6); (void)lane; (void)wave;
                if (g > 0) { const int gc = g - 1;
#pragma unroll 2
                for (int idx = bx * NTHREADS + tid; idx < M * HG * 16; idx += G * NTHREADS) {
                    const int pair = idx >> 4, ch = idx & 15, m = pair >> 2, hl = pair & 3;
                    const unsigned sel = SEL[(size_t)m * NH + gc * HG + hl];
                    const f32x4 lp = *(const f32x4*)(LPART + (size_t)pair * 4);
                    u32x4 pv[4];
#pragma unroll
                    for (int e = 0; e < 4; ++e) pv[e] = *(const u32x4*)(OPART + ((size_t)pair * 4 + e) * HD + ch * 8);
                    float o[8]; float l = lp.w;
                    o[0] = bf_lo(pv[3].x); o[1] = bf_hi(pv[3].x); o[2] = bf_lo(pv[3].y); o[3] = bf_hi(pv[3].y); o[4] = bf_lo(pv[3].z); o[5] = bf_hi(pv[3].z); o[6] = bf_lo(pv[3].w); o[7] = bf_hi(pv[3].w);
#pragma unroll
                    for (int e = 0; e < 3; ++e) { const bool ok = ((sel >> (8 * e)) & 0xffu) != 0xffu; const u32x4 v = pv[e];
                        l += ok ? lp[e] : 0.f;
                        o[0] += ok ? bf_lo(v.x) : 0.f; o[1] += ok ? bf_hi(v.x) : 0.f; o[2] += ok ? bf_lo(v.y) : 0.f; o[3] += ok ? bf_hi(v.y) : 0.f;
                        o[4] += ok ? bf_lo(v.z) : 0.f; o[5] += ok ? bf_hi(v.z) : 0.f; o[6] += ok ? bf_lo(v.w) : 0.f; o[7] += ok ? bf_hi(v.w) : 0.f; }
                    const float rl = 1.0f / l;
                    u32x4 w; w.x = cvt_pk_bf16(o[0] * rl, o[1] * rl); w.y = cvt_pk_bf16(o[2] * rl, o[3] * rl);
                    w.z = cvt_pk_bf16(o[4] * rl, o[5] * rl); w.w = cvt_pk_bf16(o[6] * rl, o[7] * rl);
                    *(u32x4*)(AT + (size_t)m * DI + gc * GW + hl * HD + ch * 8) = w;
                }
                }
                pg8::Gemm<D, D, D> gm{H1, WIN1}; pg8::StaticOrder S; S.init(M, 4 * GW, G, bx);
                pg8::EpiQkvz E{QG, KG, VG, SZG, q_norm1, k_norm1, TAB, KMEAN + (size_t)g * 8 * NB * HD, lds + 131072}; pg8::MapQkvz MP{g};
                pg8::gemm_phase(lds, gm, S, MP, E);
            }
            SYNC(pb);
            if (IN(pb + 1) && (PH_MASK & 256)) {
            int tid = threadIdx.x; asm volatile("" : "+v"(tid)); const int lane = tid & 63, wave = __builtin_amdgcn_readfirstlane(tid >> 6); (void)lane; (void)wave;
                LAS unsigned char* kmh = lds;
                LAS unsigned char* kml = lds + 32 * 272;
                LAS unsigned* lcnt = (LAS unsigned*)(lds + 2 * 32 * 272);
                LAS unsigned* lbase = lcnt + 32;
                if (tid < 32) lcnt[tid] = 0u;
                __syncthreads();
                const int fr = lane & 15, fq = lane >> 4;
#define TOP3_INS(val, idx) do { const float v_ = (val); const int n_ = (idx); \
        if (v_ > v0 || (v_ == v0 && n_ < i0)) { v2 = v1; i2 = i1; v1 = v0; i1 = i0; v0 = v_; i0 = n_; } \
        else if (v_ > v1 || (v_ == v1 && n_ < i1)) { v2 = v1; i2 = i1; v1 = v_; i1 = n_; } \
        else if (v_ > v2 || (v_ == v2 && n_ < i2)) { v2 = v_; i2 = n_; } } while (0)
#pragma unroll 1
                for (int unit = bx; unit < 8 * NB; unit += G) {
                    const int bh = unit >> 5, qb = unit & 31, b = bh >> 2, hl = bh & 3;
                    if (qb > 0) {
                        for (int idx = tid; idx < qb * 32; idx += NTHREADS) { const int n = idx >> 5, c4 = idx & 31;
                            const f32x4 v = *(const f32x4*)(KMEAN + ((size_t)(g * 8 + bh) * NB + n) * HD + c4 * 4);
                            u32x2 h; h.x = cvt_pk_bf16(v.x, v.y); h.y = cvt_pk_bf16(v.z, v.w);
                            u32x2 l; l.x = cvt_pk_bf16(v.x - bf_lo(h.x), v.y - bf_hi(h.x)); l.y = cvt_pk_bf16(v.z - bf_lo(h.y), v.w - bf_hi(h.y));
                            *(LAS u32x2*)(kmh + n * 272 + c4 * 8) = h; *(LAS u32x2*)(kml + n * 272 + c4 * 8) = l; }
                        bf16x8 qf[2][4];
#pragma unroll
                        for (int t = 0; t < 2; ++t) { const bf16_t* qp = QG + ((size_t)b * SEQ + qb * BLK + wave * 32 + t * 16 + fr) * GW + hl * HD + fq * 8;
#pragma unroll
                            for (int ks = 0; ks < 4; ++ks) qf[t][ks] = *(const bf16x8*)(qp + ks * 32); }
                        __syncthreads();
                        f32x4 sacc[2][2];
#pragma unroll
                        for (int nt = 0; nt < 2; ++nt) { sacc[nt][0] = (f32x4){0.f, 0.f, 0.f, 0.f}; sacc[nt][1] = (f32x4){0.f, 0.f, 0.f, 0.f}; }
#pragma unroll
                        for (int nt = 0; nt < 2; ++nt) if (nt * 16 < qb) {
#pragma unroll
                            for (int ks = 0; ks < 4; ++ks) { const bf16x8 ah = *(const LAS bf16x8*)(kmh + (nt * 16 + fr) * 272 + ks * 64 + fq * 16), al = *(const LAS bf16x8*)(kml + (nt * 16 + fr) * 272 + ks * 64 + fq * 16);
#pragma unroll
                                for (int t = 0; t < 2; ++t) { sacc[nt][t] = __builtin_amdgcn_mfma_f32_16x16x32_bf16(ah, qf[t][ks], sacc[nt][t], 0, 0, 0); sacc[nt][t] = __builtin_amdgcn_mfma_f32_16x16x32_bf16(al, qf[t][ks], sacc[nt][t], 0, 0, 0); } } }
                        float tv[2][3]; int ti[2][3];
#pragma unroll
                        for (int t = 0; t < 2; ++t) {
                            float v0 = -INFINITY, v1 = -INFINITY, v2 = -INFINITY; int i0 = 255, i1 = 255, i2 = 255;
#pragma unroll
                            for (int nt = 0; nt < 2; ++nt)
#pragma unroll
                                for (int j = 0; j < 4; ++j) { const int n = nt * 16 + fq * 4 + j; if (n < qb) TOP3_INS(sacc[nt][t][j], n); }
#pragma unroll
                            for (int st = 16; st <= 32; st <<= 1) {
                                const float a0 = __shfl_xor(v0, st), a1 = __shfl_xor(v1, st), a2 = __shfl_xor(v2, st); const int b0 = __shfl_xor(i0, st), b1 = __shfl_xor(i1, st), b2 = __shfl_xor(i2, st);
                                if (b0 < 255) TOP3_INS(a0, b0); if (b1 < 255) TOP3_INS(a1, b1); if (b2 < 255) TOP3_INS(a2, b2);
                            }
                            tv[t][0] = v0; tv[t][1] = v1; tv[t][2] = v2; ti[t][0] = i0; ti[t][1] = i1; ti[t][2] = i2;
                        }
                        const int i0 = fq == 0 ? ti[0][0] : ti[1][0], i1 = fq == 0 ? ti[0][1] : ti[1][1], i2 = fq == 0 ? ti[0][2] : ti[1][2];
                        const int s = qb * BLK + wave * 32 + lane; const size_t mrow = (size_t)b * SEQ + s;
                        unsigned rk0 = 0, rk1 = 0, rk2 = 0;
                        if (lane < 32) {
                            SEL[mrow * NH + g * HG + hl] = (unsigned)i0 | ((unsigned)i1 << 8) | ((unsigned)i2 << 16);
                            if (i0 < 255) rk0 = atomicAdd((unsigned*)&lcnt[i0], 1u);
                            if (i1 < 255) rk1 = atomicAdd((unsigned*)&lcnt[i1], 1u);
                            if (i2 < 255) rk2 = atomicAdd((unsigned*)&lcnt[i2], 1u);
                        }
                        __syncthreads();
                        if (tid < 32) { const unsigned c = lcnt[tid]; lbase[tid] = c ? atomicAdd(&CNT[g * 256 + bh * NB + tid], c) : 0u; lcnt[tid] = 0u; }
                        __syncthreads();
                        if (lane < 32) {
                            if (i0 < 255) LIST[(size_t)(bh * NB + i0) * SEQ + lbase[i0] + rk0] = (unsigned short)(s | (0 << 13));
                            if (i1 < 255) LIST[(size_t)(bh * NB + i1) * SEQ + lbase[i1] + rk1] = (unsigned short)(s | (1 << 13));
                            if (i2 < 255) LIST[(size_t)(bh * NB + i2) * SEQ + lbase[i2] + rk2] = (unsigned short)(s | (2 << 13));
                        }
                        __syncthreads();
                    } else if (tid < 256) {
                        SEL[((size_t)b * SEQ + tid) * NH + g * HG + hl] = 0x00ffffffu;
                    }
                }
#undef TOP3_INS
            }
            SYNC(pb + 1);
            if (IN(pb + 2) && (PH_MASK & 512)) {
            int tid = threadIdx.x; asm volatile("" : "+v"(tid)); const int lane = tid & 63, wave = __builtin_amdgcn_readfirstlane(tid >> 6); (void)lane; (void)wave;
                LAS unsigned char* Ks = lds;
                LAS unsigned char* Vt = lds + 256 * 272;
                LAS int* pre = (LAS int*)(lds + 256 * 272 + 128 * 528);
                LAS float* red = (LAS float*)(lds + 256 * 272 + 128 * 528 + 2048);
                {
                    float mq = 0.f, mk = 0.f;
                    if (tid < 128) { mq = fabsf(q_norm1[tid]); mk = fabsf(k_norm1[tid]); }
#pragma unroll
                    for (int o = 1; o < 64; o <<= 1) { mq = fmaxf(mq, __shfl_xor(mq, o)); mk = fmaxf(mk, __shfl_xor(mk, o)); }
                    if (lane == 0) { red[wave * 2] = mq; red[wave * 2 + 1] = mk; }
                    if (tid < 256) pre[tid + 1] = 1 + (int)((CNT[g * 256 + tid] + 255u) >> 8);
                    if (tid == 0) pre[0] = 0;
                    __syncthreads();
                    if (tid == 0) { int a = 0; for (int i = 1; i <= 256; ++i) { a += pre[i]; pre[i] = a; } }
                    __syncthreads();
                }
                const float MSH = 128.0f * QSCALE * fmaxf(red[0], red[2]) * fmaxf(red[1], red[3]) * 1.02f;
                const int total = pre[256];
                const int fr = lane & 15, fq = lane >> 4;
                const int istart = (int)(((long)total * bx) / G), iend = (int)(((long)total * (bx + 1)) / G);
                int cur_li = -1;
#pragma unroll 1
                for (int item = istart; item < iend; ++item) {
                    int loi = 0, hii = 256;
                    while (hii - loi > 1) { const int mid = (loi + hii) >> 1; if (pre[mid] <= item) loi = mid; else hii = mid; }
                    const int li = loi, c = item - pre[li], bh = li >> 5, n = li & 31, b = bh >> 2, hl = bh & 3;
                    const int cnt = (int)CNT[g * 256 + li];
                    const size_t rowbase = (size_t)b * SEQ;
                    const bool restage = (li != cur_li); cur_li = li;
                    if (restage) {
                    __syncthreads();
                    for (int cc = tid; cc < 256 * 16; cc += NTHREADS) { const int r = cc >> 4, c16 = cc & 15;
                        *(LAS u32x4*)(Ks + r * 272 + c16 * 16) = *(const u32x4*)(KG + (rowbase + n * BLK + r) * GW + hl * HD + c16 * 8); }
                    for (int task = tid; task < 1024; task += NTHREADS) {
                        const int a = (task & 15) | ((task >> 5) & 3) << 4, cch = ((task >> 4) & 1) | ((task >> 7) << 1);
                        u32x4 v[4];
#pragma unroll
                        for (int kk = 0; kk < 4; ++kk) v[kk] = *(const u32x4*)(VG + (rowbase + n * BLK + a * 4 + kk) * GW + hl * HD + cch * 8);
#pragma unroll
                        for (int e = 0; e < 4; ++e) {
                            const unsigned w0 = e == 0 ? v[0].x : e == 1 ? v[0].y : e == 2 ? v[0].z : v[0].w, w1 = e == 0 ? v[1].x : e == 1 ? v[1].y : e == 2 ? v[1].z : v[1].w;
                            const unsigned w2 = e == 0 ? v[2].x : e == 1 ? v[2].y : e == 2 ? v[2].z : v[2].w, w3 = e == 0 ? v[3].x : e == 1 ? v[3].y : e == 2 ? v[3].z : v[3].w;
                            u32x2 lo2, hi2;
                            lo2.x = (w0 & 0xffffu) | (w1 << 16); lo2.y = (w2 & 0xffffu) | (w3 << 16);
                            hi2.x = (w0 >> 16) | (w1 & 0xffff0000u); hi2.y = (w2 >> 16) | (w3 & 0xffff0000u);
                            *(LAS u32x2*)(Vt + (cch * 8 + 2 * e) * 528 + a * 8) = lo2;
                            *(LAS u32x2*)(Vt + (cch * 8 + 2 * e + 1) * 528 + a * 8) = hi2;
                        }
                    }
                    }
                    int qpos[2], qslot[2]; bool qok[2];
                    bf16x8 qf[2][4];
#pragma unroll
                    for (int t = 0; t < 2; ++t) {
                        const int ridx = wave * 32 + t * 16 + fr;
                        if (c == 0) { qpos[t] = n * BLK + ridx; qslot[t] = 3; qok[t] = true; }
                        else { const int lidx = (c - 1) * 256 + ridx; qok[t] = lidx < cnt; const unsigned e = LIST[(size_t)li * SEQ + (qok[t] ? lidx : 0)]; qpos[t] = e & 8191; qslot[t] = e >> 13; }
                        const bf16_t* qp = QG + (rowbase + qpos[t]) * GW + hl * HD + fq * 8;
#pragma unroll
                        for (int ks = 0; ks < 4; ++ks) qf[t][ks] = *(const bf16x8*)(qp + ks * 32);
                    }
                    if (restage) __syncthreads();
                    f32x4 oacc[2][8], lacc[2];
#pragma unroll
                    for (int t = 0; t < 2; ++t) { lacc[t] = (f32x4){0.f, 0.f, 0.f, 0.f};
#pragma unroll
                        for (int dt = 0; dt < 8; ++dt) oacc[t][dt] = (f32x4){0.f, 0.f, 0.f, 0.f}; }
                    const int qrel0 = qpos[0] - n * BLK, qrel1 = qpos[1] - n * BLK;
                    const int kg_end = (c == 0) ? wave + 1 : 8;
                    const bf16x8 ones = {0x3F80, 0x3F80, 0x3F80, 0x3F80, 0x3F80, 0x3F80, 0x3F80, 0x3F80};
                    bf16x8 kf[2][4];
#pragma unroll
                    for (int kt = 0; kt < 2; ++kt)
#pragma unroll
                        for (int ks = 0; ks < 4; ++ks) kf[kt][ks] = *(const LAS bf16x8*)(Ks + (kt * 16 + fr) * 272 + ks * 64 + fq * 16);
#pragma unroll 1
                    for (int kg = 0; kg < kg_end; ++kg) {
                        u32x2 va[8], vb[8];
#pragma unroll
                        for (int dt = 0; dt < 8; ++dt) { va[dt] = *(const LAS u32x2*)(Vt + (dt * 16 + fr) * 528 + kg * 64 + fq * 8); vb[dt] = *(const LAS u32x2*)(Vt + (dt * 16 + fr) * 528 + kg * 64 + 32 + fq * 8); }
                        __builtin_amdgcn_sched_barrier(0);
                        f32x4 sacc[2][2];
#pragma unroll
                        for (int kt = 0; kt < 2; ++kt) { sacc[kt][0] = (f32x4){-MSH, -MSH, -MSH, -MSH}; sacc[kt][1] = (f32x4){-MSH, -MSH, -MSH, -MSH}; }
#pragma unroll
                        for (int ks = 0; ks < 4; ++ks)
#pragma unroll
                            for (int kt = 0; kt < 2; ++kt) {
                                sacc[kt][0] = __builtin_amdgcn_mfma_f32_16x16x32_bf16(kf[kt][ks], qf[0][ks], sacc[kt][0], 0, 0, 0);
                                sacc[kt][1] = __builtin_amdgcn_mfma_f32_16x16x32_bf16(kf[kt][ks], qf[1][ks], sacc[kt][1], 0, 0, 0); }
                        __builtin_amdgcn_sched_barrier(0);
                        if (kg + 1 < kg_end) {
#pragma unroll
                            for (int kt = 0; kt < 2; ++kt)
#pragma unroll
                                for (int ks = 0; ks < 4; ++ks) kf[kt][ks] = *(const LAS bf16x8*)(Ks + ((kg + 1) * 32 + kt * 16 + fr) * 272 + ks * 64 + fq * 16);
                        }
                        bf16x8 pb[2];
                        if (c == 0 && kg == wave) {
#pragma unroll
                            for (int t = 0; t < 2; ++t) {
                                float p[8];
#pragma unroll
                                for (int kt = 0; kt < 2; ++kt)
#pragma unroll
                                    for (int j = 0; j < 4; ++j) { float pv = __builtin_amdgcn_exp2f(sacc[kt][t][j]);
                                        const int key = kg * 32 + kt * 16 + fq * 4 + j; if (key > (t == 0 ? qrel0 : qrel1)) pv = 0.f;
                                        p[kt * 4 + j] = pv; }
                                u32x4 w; w.x = cvt_pk_bf16(p[0], p[1]); w.y = cvt_pk_bf16(p[2], p[3]); w.z = cvt_pk_bf16(p[4], p[5]); w.w = cvt_pk_bf16(p[6], p[7]);
                                pb[t] = __builtin_bit_cast(bf16x8, w);
                            }
                        } else {
#pragma unroll
                            for (int t = 0; t < 2; ++t) {
                                u32x4 w;
                                w.x = cvt_pk_bf16(__builtin_amdgcn_exp2f(sacc[0][t][0]), __builtin_amdgcn_exp2f(sacc[0][t][1])); w.y = cvt_pk_bf16(__builtin_amdgcn_exp2f(sacc[0][t][2]), __builtin_amdgcn_exp2f(sacc[0][t][3]));
                                w.z = cvt_pk_bf16(__builtin_amdgcn_exp2f(sacc[1][t][0]), __builtin_amdgcn_exp2f(sacc[1][t][1])); w.w = cvt_pk_bf16(__builtin_amdgcn_exp2f(sacc[1][t][2]), __builtin_amdgcn_exp2f(sacc[1][t][3]));
                                pb[t] = __builtin_bit_cast(bf16x8, w);
                            }
                        }
                        __builtin_amdgcn_sched_barrier(0);
                        lacc[0] = __builtin_amdgcn_mfma_f32_16x16x32_bf16(ones, pb[0], lacc[0], 0, 0, 0);
                        lacc[1] = __builtin_amdgcn_mfma_f32_16x16x32_bf16(ones, pb[1], lacc[1], 0, 0, 0);
#pragma unroll
                        for (int dt = 0; dt < 8; ++dt) {
                            u32x4 vv; vv.x = va[dt].x; vv.y = va[dt].y; vv.z = vb[dt].x; vv.w = vb[dt].y; const bf16x8 vf = __builtin_bit_cast(bf16x8, vv);
                            oacc[0][dt] = __builtin_amdgcn_mfma_f32_16x16x32_bf16(vf, pb[0], oacc[0][dt], 0, 0, 0);
                            oacc[1][dt] = __builtin_amdgcn_mfma_f32_16x16x32_bf16(vf, pb[1], oacc[1][dt], 0, 0, 0);
                        }
                    }
#pragma unroll
                    for (int t = 0; t < 2; ++t) {
                        const float l = lacc[t][0];
                        if (qok[t]) {
                            const size_t pair = (rowbase + qpos[t]) * HG + hl;
                            bf16_t* op = OPART + (pair * 4 + qslot[t]) * HD + fq * 4;
                            const bf16_t* zp = SZG + (rowbase + qpos[t]) * GW + hl * HD + fq * 4;
                            u32x2 zz[8];
#pragma unroll
                            for (int dt = 0; dt < 8; ++dt) zz[dt] = *(const u32x2*)(zp + dt * 16);
#pragma unroll
                            for (int dt = 0; dt < 8; ++dt) { u32x2 w; w.x = cvt_pk_bf16(oacc[t][dt][0] * bf_lo(zz[dt].x), oacc[t][dt][1] * bf_hi(zz[dt].x)); w.y = cvt_pk_bf16(oacc[t][dt][2] * bf_lo(zz[dt].y), oacc[t][dt][3] * bf_hi(zz[dt].y)); *(u32x2*)(op + dt * 16) = w; }
                            if (fq == 0) LPART[pair * 4 + qslot[t]] = l;
                        }
                    }
                }
            }
            SYNC(pb + 2);
        }
        if (IN(6 + 3 * NG) && (PH_MASK & 1024)) {
            int tid = threadIdx.x; asm volatile("" : "+v"(tid)); const int lane = tid & 63, wave = __builtin_amdgcn_readfirstlane(tid >> 6); (void)lane; (void)wave;
            { const int gc = NG - 1;
#pragma unroll 2
                for (int idx = bx * NTHREADS + tid; idx < M * HG * 16; idx += G * NTHREADS) {
                    const int pair = idx >> 4, ch = idx & 15, m = pair >> 2, hl = pair & 3;
                    const unsigned sel = SEL[(size_t)m * NH + gc * HG + hl];
                    const f32x4 lp = *(const f32x4*)(LPART + (size_t)pair * 4);
                    u32x4 pv[4];
#pragma unroll
                    for (int e = 0; e < 4; ++e) pv[e] = *(const u32x4*)(OPART + ((size_t)pair * 4 + e) * HD + ch * 8);
                    float o[8]; float l = lp.w;
                    o[0] = bf_lo(pv[3].x); o[1] = bf_hi(pv[3].x); o[2] = bf_lo(pv[3].y); o[3] = bf_hi(pv[3].y); o[4] = bf_lo(pv[3].z); o[5] = bf_hi(pv[3].z); o[6] = bf_lo(pv[3].w); o[7] = bf_hi(pv[3].w);
#pragma unroll
                    for (int e = 0; e < 3; ++e) { const bool ok = ((sel >> (8 * e)) & 0xffu) != 0xffu; const u32x4 v = pv[e];
                        l += ok ? lp[e] : 0.f;
                        o[0] += ok ? bf_lo(v.x) : 0.f; o[1] += ok ? bf_hi(v.x) : 0.f; o[2] += ok ? bf_lo(v.y) : 0.f; o[3] += ok ? bf_hi(v.y) : 0.f;
                        o[4] += ok ? bf_lo(v.z) : 0.f; o[5] += ok ? bf_hi(v.z) : 0.f; o[6] += ok ? bf_lo(v.w) : 0.f; o[7] += ok ? bf_hi(v.w) : 0.f; }
                    const float rl = 1.0f / l;
                    u32x4 w; w.x = cvt_pk_bf16(o[0] * rl, o[1] * rl); w.y = cvt_pk_bf16(o[2] * rl, o[3] * rl);
                    w.z = cvt_pk_bf16(o[4] * rl, o[5] * rl); w.w = cvt_pk_bf16(o[6] * rl, o[7] * rl);
                    *(u32x4*)(AT + (size_t)m * DI + gc * GW + hl * HD + ch * 8) = w;
                }
            }
        }
        SYNC(6 + 3 * NG);
        if (IN(7 + 3 * NG) && (PH_MASK & 2048)) {
            int tid = threadIdx.x; asm volatile("" : "+v"(tid)); const int lane = tid & 63, wave = __builtin_amdgcn_readfirstlane(tid >> 6); (void)lane; (void)wave;
            pg8::Gemm<DI, DI, DI> gm{AT, WOUT1}; pg8::StaticOrder S; S.init(M, D, G, bx);
            pg8::EpiRes E{out, out}; pg8::MapPlain<DI, DI> MP;
            pg8::gemm_phase(lds, gm, S, MP, E);
        }
    }
}

constexpr int NPHASES = 6 + 3 * NG + 2;

extern "C" void kernel_launch(void* const* d_in, const int* in_sizes, int n_in, void* d_out, int out_size, void* d_ws, size_t ws_size, hipStream_t stream) {
    static int grid = 0;
    if (grid == 0) {
        int dev = 0, cus = 0, per_cu = 0;
        hipGetDevice(&dev);
        hipDeviceGetAttribute(&cus, hipDeviceAttributeMultiprocessorCount, dev);
        hipFuncSetAttribute((const void*)mega_fwd, hipFuncAttributeMaxDynamicSharedMemorySize, LDS_BYTES);
        hipOccupancyMaxActiveBlocksPerMultiprocessor(&per_cu, (const void*)mega_fwd, NTHREADS, LDS_BYTES);
        if (per_cu < 1) { fprintf(stderr, "kernel_launch: occupancy query says %d blocks per CU\n", per_cu); per_cu = 1; }
        grid = cus;
        if (ws_size < WS_END) fprintf(stderr, "kernel_launch: workspace too small: %zu < %zu\n", ws_size, (size_t)WS_END);
    }
    hipMemsetAsync((char*)d_ws + WS_CTL, 0, CTL_BYTES, stream);
    Args a{};
    for (int i = 0; i < 11; ++i) a.in[i] = (const float*)d_in[i];
    a.out = (float*)d_out; a.ws = (unsigned char*)d_ws; a.pad = 0;
#if defined(MK_PER_PHASE)
    for (int ph = 0; ph < NPHASES; ++ph) { a.ph_lo = ph; a.ph_hi = ph + 1; a.coop = 0; hipLaunchKernelGGL(mega_fwd, dim3(grid), dim3(NTHREADS), LDS_BYTES, stream, a); }
#else
    a.ph_lo = 0; a.ph_hi = NPHASES; a.coop = 1;
    void* kargs[] = {&a};
    hipError_t e = hipLaunchCooperativeKernel((const void*)mega_fwd, dim3(grid), dim3(NTHREADS), kargs, LDS_BYTES, stream);
    if (e != hipSuccess) fprintf(stderr, "cooperative launch failed: %s (grid %d)\n", hipGetErrorString(e), grid);
#endif
}
```

```cpp
#include <hip/hip_runtime.h>
#include <hip/hip_cooperative_groups.h>
#include <cstdio>
#include <cstdint>
namespace cg = cooperative_groups;

#define LAS __attribute__((address_space(3)))
typedef unsigned short bf16_t;
typedef short bf16x8 __attribute__((ext_vector_type(8)));
typedef float f32x4 __attribute__((ext_vector_type(4)));
typedef float f32x2 __attribute__((ext_vector_type(2)));
typedef unsigned u32x4 __attribute__((ext_vector_type(4)));
typedef unsigned u32x2 __attribute__((ext_vector_type(2)));

constexpr int SEQ = 8192, NBATCH = 2, M = NBATCH * SEQ, D = 1024, DI = 2048, NH = 16, HD = 128, BLK = 256, NB = SEQ / BLK;
constexpr int NG = 4, HG = NH / NG, GW = HG * HD;
constexpr float EPS = 1e-6f;
constexpr float QSCALE = 0.08838834764831845f * 1.4426950408889634f;

constexpr size_t MiB = 1u << 20;
constexpr size_t WS_CTL = 0, CTL_BYTES = 65536;
constexpr size_t WS_BAR = 8192;
constexpr size_t WS_KMEAN = 1 * MiB;
constexpr size_t WS_SEL = 2 * MiB;
constexpr size_t WS_LPART = 3 * MiB;
constexpr size_t WS_TAB = 4 * MiB;
constexpr size_t WS_WIN1 = 8 * MiB, WS_WOUT1 = 24 * MiB;
constexpr size_t WS_LIST = 28 * MiB;
constexpr size_t WS_WIN0 = 28 * MiB, WS_WP = 36 * MiB, WS_WOUT0 = 38 * MiB;
constexpr size_t WS_H0 = 42 * MiB, WS_POOLED = 42 * MiB, WS_U = 106 * MiB, WS_SZ0 = 170 * MiB;
constexpr size_t WS_H1 = 32 * MiB, WS_QG = 64 * MiB, WS_KG = 80 * MiB, WS_VG = 96 * MiB, WS_SZG = 112 * MiB;
constexpr size_t WS_OPART = 128 * MiB, WS_A = 192 * MiB, WS_END = 256 * MiB;

constexpr int LDS_BYTES = 140 * 1024;
constexpr int NTHREADS = 512;
#ifndef PH_MASK
#define PH_MASK 0xfff
#endif

__device__ __forceinline__ unsigned cvt_pk_bf16(float lo, float hi) { unsigned r; asm volatile("v_cvt_pk_bf16_f32 %0, %1, %2" : "=v"(r) : "v"(lo), "v"(hi)); return r; }
__device__ __forceinline__ float bf_lo(unsigned u) { return __uint_as_float(u << 16); }
__device__ __forceinline__ float bf_hi(unsigned u) { return __uint_as_float(u & 0xffff0000u); }
__device__ __forceinline__ float silu_f(float z) { return z * __builtin_amdgcn_rcpf(1.0f + __builtin_amdgcn_exp2f(-1.4426950408889634f * z)); }
__device__ __forceinline__ float wave_sum(float v) {
#pragma unroll
    for (int o = 1; o < 64; o <<= 1) v += __shfl_xor(v, o);
    return v;
}

namespace pg8 {
constexpr int BM = 256, BK = 64, HALF = 128, HTB = HALF * BK * 2, STAGE_BYTES = 8 * HTB, NXCD = 8, WGM = 8;
__host__ __device__ __forceinline__ int lds_byte(int r, int c) { const int st = (r >> 4) * 2 + (c >> 5), rr = r & 15, cc = c & 31, ob = rr * 64 + cc * 2; return st * 1024 + (ob ^ (((ob >> 9) & 1) << 5)); }
__host__ __device__ __forceinline__ void stage_rc(int b, int& R, int& C) { const int st = b / 1024, sb = b % 1024, swz = sb ^ (((sb >> 9) & 1) << 5); R = (st >> 1) * 16 + swz / 64; C = (st & 1) * 32 + (swz % 64) / 2; }
__host__ __device__ __forceinline__ int perm32(int rho) { const int n = rho >> 4, i = rho & 15; return 8 * (i >> 2) + 4 * n + (i & 3); }

struct Unit { int pm, pn; };
template <int LDA_, int LDB_, int K_> struct Gemm { const bf16_t* A; const bf16_t* Bt; static constexpr int lda = LDA_, ldb = LDB_, K = K_; };
struct StaticOrder {
    int nM, nN, nwg, G, c, base = 0, nr = 1 << 30;
    __device__ void init(int M_, int N_, int G_, int c_) { nM = M_ / BM; nN = N_ / BM; nwg = nM * nN; G = G_; c = c_; }
    __device__ bool next(int i, Unit& u) const {
        if (i >= nr) return false;
        const long L = (long)(base + i) * G + c; if (L >= nwg) return false;
        int wgid = (int)L; { const int q = nwg / NXCD, r = nwg % NXCD, xcd = wgid % NXCD, off = wgid / NXCD; wgid = (xcd < r ? xcd * (q + 1) : r * (q + 1) + (xcd - r) * q) + off; }
        const int nig = WGM * nN, gid = wgid / nig, fm = gid * WGM, gsz = (nM - fm) < WGM ? (nM - fm) : WGM;
        u.pm = fm + ((wgid % nig) % gsz); u.pn = (wgid % nig) / gsz; return true;
    }
};
template <class Epi, class Map, class GemmT>
__device__ __forceinline__ void gemm_phase(LAS unsigned char* lds, const GemmT g, const StaticOrder& S, const Map& MP, const Epi& E) {
    int tid_ = threadIdx.x; asm volatile("" : "+v"(tid_));
    const int tid = tid_, wid = __builtin_amdgcn_readfirstlane(tid >> 6), lane = tid & 63, wr = wid >> 2, wc = wid & 3, fr = lane & 15, fq = lane >> 4;
    constexpr int K = GemmT::K, nt = K / BK;
    unsigned voffA[2], voffB[2];
#pragma unroll
    for (int i = 0; i < 2; ++i) { int R, C; stage_rc(tid * 16 + i * 8192, R, C); const int Rb = Epi::PERM == 1 ? ((R & ~31) + perm32(R & 31)) : Epi::PERM == 2 ? (64 * ((R >> 4) & 1) + 16 * (R >> 5) + (R & 15)) : R;
        voffA[i] = (unsigned)(R * GemmT::lda + C) * 2u; voffB[i] = (unsigned)(Rb * GemmT::ldb + C) * 2u; }
    constexpr size_t kstep = (size_t)(BK * 2);
    constexpr size_t hstepA = (size_t)HALF * GemmT::lda * 2, hstepB = (size_t)HALF * GemmT::ldb * 2;
    const unsigned ldsw = (unsigned)wid * 1024u;
    const int aoff = lds_byte(wr * 64 + fr, fq * 8), boff = lds_byte(wc * 32 + fr, fq * 8);
#define PG8_SA(b, h) (((b) * 2 + (h)) * HTB)
#define PG8_SB(b, h) ((4 + (b) * 2 + (h)) * HTB)
#define PG8_STAGE(bufoff, gbase, voff) do { _Pragma("unroll") for (int _i = 0; _i < 2; ++_i) \
        __builtin_amdgcn_global_load_lds((const unsigned*)((const char*)(gbase) + (voff)[_i]), (LAS unsigned*)(lds + (bufoff) + ldsw + _i * 8192), 16, 0, 0); } while (0)
#define PG8_LDA(dst, b, h) do { _Pragma("unroll") for (int m = 0; m < 4; ++m) _Pragma("unroll") for (int k = 0; k < 2; ++k) dst[m][k] = *(const LAS bf16x8*)(lds + PG8_SA(b, h) + aoff + m * 2048 + k * 1024); } while (0)
#define PG8_LDB(dst, b, h) do { _Pragma("unroll") for (int n = 0; n < 2; ++n) _Pragma("unroll") for (int k = 0; k < 2; ++k) dst[n][k] = *(const LAS bf16x8*)(lds + PG8_SB(b, h) + boff + n * 2048 + k * 1024); } while (0)
#define PG8_MMA(ai, bj, At, Bt) do { __builtin_amdgcn_s_setprio(1); _Pragma("unroll") for (int m = 0; m < 4; ++m) _Pragma("unroll") for (int n = 0; n < 2; ++n) _Pragma("unroll") for (int k = 0; k < 2; ++k) \
        acc[ai][bj][m][n] = __builtin_amdgcn_mfma_f32_16x16x32_bf16(Bt[n][k], At[m][k], acc[ai][bj][m][n], 0, 0, 0); __builtin_amdgcn_s_setprio(0); } while (0)
#define PG8_WAIT_V(n) asm volatile("s_waitcnt vmcnt(" #n ")" ::: "memory")
#define PG8_WAIT_L(n) asm volatile("s_waitcnt lgkmcnt(" #n ")" ::: "memory")
#define PG8_BAR __builtin_amdgcn_s_barrier()
#define PG8_SCHED __builtin_amdgcn_sched_barrier(0)
    Unit cur, nxt; int ui = 0;
    if (!S.next(0, cur)) return;
    f32x4 acc[2][2][4][2];
#pragma unroll
    for (int a = 0; a < 2; ++a)
#pragma unroll
        for (int b = 0; b < 2; ++b)
#pragma unroll
            for (int m = 0; m < 4; ++m)
#pragma unroll
                for (int n = 0; n < 2; ++n) acc[a][b][m][n] = (f32x4){0.f, 0.f, 0.f, 0.f};
    bf16x8 At[4][2], B0[2][2], B1[2][2];
    const char* cA = (const char*)(g.A + MP.a_off(cur)); const char* cB = (const char*)(g.Bt + MP.b_off(cur));
    PG8_STAGE(PG8_SB(0, 0), cB, voffB); PG8_STAGE(PG8_SB(0, 1), cB + hstepB, voffB); PG8_STAGE(PG8_SA(0, 0), cA, voffA); PG8_STAGE(PG8_SA(0, 1), cA + hstepA, voffA);
    if (wr == 1) PG8_BAR;
    PG8_WAIT_V(2); PG8_BAR;
    PG8_STAGE(PG8_SB(1, 0), cB + kstep, voffB); PG8_STAGE(PG8_SA(1, 0), cA + kstep, voffA); PG8_STAGE(PG8_SB(1, 1), cB + hstepB + kstep, voffB);
    PG8_WAIT_V(6); PG8_BAR;
    for (;;) {
        const bool has_next = S.next(ui + 1, nxt);
        const char* nA = has_next ? (const char*)(g.A + MP.a_off(nxt)) : cA; const char* nB = has_next ? (const char*)(g.Bt + MP.b_off(nxt)) : cB;
        for (int t = 0; t < nt; t += 2) {
            const bool last = (t == nt - 2);
            const char* a1 = cA + (size_t)(t + 1) * kstep;
            const char* a2 = last ? nA : cA + (size_t)(t + 2) * kstep; const char* b2 = last ? nB : cB + (size_t)(t + 2) * kstep;
            const char* a3 = a2 + kstep; const char* b3 = b2 + kstep;
            PG8_LDB(B0, 0, 0); PG8_LDB(B1, 0, 1); PG8_SCHED; PG8_LDA(At, 0, 0); PG8_STAGE(PG8_SA(1, 1), a1 + hstepA, voffA);
            PG8_WAIT_V(8); PG8_WAIT_L(0); PG8_BAR; PG8_MMA(0, 0, At, B0); PG8_MMA(0, 1, At, B1); PG8_BAR; PG8_SCHED;
            PG8_LDA(At, 0, 1); PG8_STAGE(PG8_SB(0, 0), b2, voffB); PG8_STAGE(PG8_SB(0, 1), b2 + hstepB, voffB); PG8_STAGE(PG8_SA(0, 0), a2, voffA);
            PG8_WAIT_V(8); PG8_WAIT_L(0); PG8_BAR; PG8_MMA(1, 0, At, B0); PG8_MMA(1, 1, At, B1); PG8_BAR; PG8_SCHED;
            PG8_LDB(B0, 1, 0); PG8_LDB(B1, 1, 1); PG8_SCHED; PG8_LDA(At, 1, 0); PG8_STAGE(PG8_SA(0, 1), a2 + hstepA, voffA);
            PG8_WAIT_V(8); PG8_WAIT_L(0); PG8_BAR; PG8_MMA(0, 0, At, B0); PG8_MMA(0, 1, At, B1); PG8_BAR; PG8_SCHED;
            PG8_LDA(At, 1, 1); PG8_STAGE(PG8_SB(1, 0), b3, voffB); PG8_STAGE(PG8_SB(1, 1), b3 + hstepB, voffB); PG8_STAGE(PG8_SA(1, 0), a3, voffA);
            PG8_WAIT_V(8); PG8_WAIT_L(0); PG8_BAR; PG8_MMA(1, 0, At, B0); PG8_MMA(1, 1, At, B1); PG8_BAR; PG8_SCHED;
        }
        if (wr == 0) PG8_BAR;
        if constexpr (!Epi::AFTER_DRAIN) E(acc, cur, wr, wc, fr, fq);
        if (!has_next) break;
#pragma unroll
        for (int a = 0; a < 2; ++a)
#pragma unroll
            for (int b = 0; b < 2; ++b)
#pragma unroll
                for (int m = 0; m < 4; ++m)
#pragma unroll
                    for (int n = 0; n < 2; ++n) acc[a][b][m][n] = (f32x4){0.f, 0.f, 0.f, 0.f};
        cur = nxt; cA = nA; cB = nB; ++ui;
        if (wr == 1) PG8_BAR;
    }
    PG8_WAIT_V(0);
    PG8_BAR;
    if constexpr (Epi::AFTER_DRAIN) E(acc, cur, wr, wc, fr, fq);
#undef PG8_SA
#undef PG8_SB
#undef PG8_STAGE
#undef PG8_LDA
#undef PG8_LDB
#undef PG8_MMA
#undef PG8_WAIT_V
#undef PG8_WAIT_L
#undef PG8_BAR
#undef PG8_SCHED
}

template <int ldc, int tiles_per_dst, int silu_dst> struct EpiSplit {
    static constexpr int PERM = 1; static constexpr bool AFTER_DRAIN = false;
    bf16_t *d0, *d1, *d2, *d3;
    __device__ __forceinline__ void operator()(const f32x4 (&acc)[2][2][4][2], const Unit& u, int wr, int wc, int fr, int fq) const {
        const int di = u.pn / tiles_per_dst, ct = u.pn - di * tiles_per_dst;
        bf16_t* base = di == 0 ? d0 : di == 1 ? d1 : di == 2 ? d2 : d3; const bool act = (di == silu_dst);
        const int row0 = u.pm * BM + wr * 64 + fr, col0 = ct * BM + wc * 32 + 8 * fq;
#pragma unroll
        for (int ai = 0; ai < 2; ++ai)
#pragma unroll
            for (int m = 0; m < 4; ++m) { bf16_t* rowp = base + (size_t)(row0 + ai * HALF + m * 16) * ldc + col0;
#pragma unroll
                for (int bj = 0; bj < 2; ++bj) { f32x4 v0 = acc[ai][bj][m][0], v1 = acc[ai][bj][m][1];
                    if (act) { v0 = (f32x4){silu_f(v0[0]), silu_f(v0[1]), silu_f(v0[2]), silu_f(v0[3])}; v1 = (f32x4){silu_f(v1[0]), silu_f(v1[1]), silu_f(v1[2]), silu_f(v1[3])}; }
                    u32x4 w; w.x = cvt_pk_bf16(v0[0], v0[1]); w.y = cvt_pk_bf16(v0[2], v0[3]); w.z = cvt_pk_bf16(v1[0], v1[1]); w.w = cvt_pk_bf16(v1[2], v1[3]);
                    *(u32x4*)(rowp + bj * HALF) = w; } }
    }
};
struct EpiGate {
    static constexpr int PERM = 1; static constexpr bool AFTER_DRAIN = false; static constexpr int ldc = DI;
    bf16_t* Y; const bf16_t* SZ; const float* scale;
    __device__ __forceinline__ void operator()(const f32x4 (&acc)[2][2][4][2], const Unit& u, int wr, int wc, int fr, int fq) const {
        const int row0 = u.pm * BM + wr * 64 + fr, col0 = u.pn * BM + wc * 32 + 8 * fq;
        f32x4 sc[2][2];
#pragma unroll
        for (int bj = 0; bj < 2; ++bj) { sc[bj][0] = *(const f32x4*)(scale + col0 + bj * HALF); sc[bj][1] = *(const f32x4*)(scale + col0 + bj * HALF + 4); }
#pragma unroll
        for (int ai = 0; ai < 2; ++ai)
#pragma unroll
            for (int m = 0; m < 4; ++m) { const size_t off = (size_t)(row0 + ai * HALF + m * 16) * ldc + col0;
#pragma unroll
                for (int bj = 0; bj < 2; ++bj) { const u32x4 z = *(const u32x4*)(SZ + off + bj * HALF);
                    const f32x4 v0 = acc[ai][bj][m][0] * sc[bj][0], v1 = acc[ai][bj][m][1] * sc[bj][1];
                    u32x4 w; w.x = cvt_pk_bf16(v0[0] * bf_lo(z.x), v0[1] * bf_hi(z.x)); w.y = cvt_pk_bf16(v0[2] * bf_lo(z.y), v0[3] * bf_hi(z.y));
                    w.z = cvt_pk_bf16(v1[0] * bf_lo(z.z), v1[1] * bf_hi(z.z)); w.w = cvt_pk_bf16(v1[2] * bf_lo(z.w), v1[3] * bf_hi(z.w));
                    *(u32x4*)(Y + off + bj * HALF) = w; } }
    }
};
struct EpiRes {
    static constexpr int PERM = 0; static constexpr bool AFTER_DRAIN = false; static constexpr int ldc = D;
    const float* base; float* out;
    __device__ __forceinline__ void operator()(const f32x4 (&acc)[2][2][4][2], const Unit& u, int wr, int wc, int fr, int fq) const {
        const int row0 = u.pm * BM + wr * 64 + fr, col0 = u.pn * BM + wc * 32 + 4 * fq;
#pragma unroll
        for (int ai = 0; ai < 2; ++ai)
#pragma unroll
            for (int m = 0; m < 4; ++m) { const size_t off = (size_t)(row0 + ai * HALF + m * 16) * ldc + col0;
#pragma unroll
                for (int bj = 0; bj < 2; ++bj)
#pragma unroll
                    for (int n = 0; n < 2; ++n) { const f32x4 b = *(const f32x4*)(base + off + bj * HALF + n * 16); *(f32x4*)(out + off + bj * HALF + n * 16) = b + acc[ai][bj][m][n]; } }
    }
};
struct EpiQkvz {
    static constexpr int PERM = 2; static constexpr bool AFTER_DRAIN = false;
    bf16_t *q, *k, *v, *sz; const float *gq, *gk; const f32x2* tab; float* kmean; LAS unsigned char* xl;
    __device__ __forceinline__ void operator()(const f32x4 (&acc)[2][2][4][2], const Unit& u, int wr_, int wc_, int fr_, int fq_) const {
        int wr = wr_, wc = wc_, fr = fr_, fq = fq_;
        asm volatile("" : "+s"(wr), "+s"(wc), "+v"(fr), "+v"(fq));
        const int part = u.pn >> 1, ct = u.pn & 1;
        const int row0 = u.pm * BM + wr * 64 + fr, colb = ct * BM + wc * 16 + fq * 4;
        if (part >= 2) {
            bf16_t* base = part == 2 ? v : sz; const int ld = part == 2 ? GW : DI;
#pragma unroll
            for (int ai = 0; ai < 2; ++ai)
#pragma unroll
                for (int m = 0; m < 4; ++m) { bf16_t* rowp = base + (size_t)(row0 + ai * HALF + m * 16) * ld + colb;
#pragma unroll
                    for (int bj = 0; bj < 2; ++bj)
#pragma unroll
                        for (int n = 0; n < 2; ++n) { f32x4 t = acc[ai][bj][m][n];
                            if (part == 3) t = (f32x4){silu_f(t[0]), silu_f(t[1]), silu_f(t[2]), silu_f(t[3])};
                            u32x2 w; w.x = cvt_pk_bf16(t[0], t[1]); w.y = cvt_pk_bf16(t[2], t[3]); *(u32x2*)(rowp + bj * HALF + n * 64) = w; } }
        } else {
            LAS float* P = (LAS float*)xl;
#pragma unroll
            for (int ai = 0; ai < 2; ++ai)
#pragma unroll
                for (int m = 0; m < 4; ++m)
#pragma unroll
                    for (int bj = 0; bj < 2; ++bj) { const f32x4 a = acc[ai][bj][m][0], b = acc[ai][bj][m][1];
                        float sq = (a[0] * a[0] + a[1] * a[1]) + (a[2] * a[2] + a[3] * a[3]) + (b[0] * b[0] + b[1] * b[1]) + (b[2] * b[2] + b[3] * b[3]);
                        sq += __shfl_xor(sq, 16); sq += __shfl_xor(sq, 32);
                        if (fq == 0) P[(ai * HALF + wr * 64 + m * 16 + fr) * 8 + bj * 4 + wc] = sq; }
            asm volatile("s_waitcnt lgkmcnt(0)" ::: "memory"); __builtin_amdgcn_s_barrier(); asm volatile("" ::: "memory");
            const float* gain = part == 0 ? gq : gk; const float sc = part == 0 ? QSCALE : 1.0f;
            const f32x4 g1 = *(const f32x4*)(gain + wc * 16 + fq * 4), g2 = *(const f32x4*)(gain + 64 + wc * 16 + fq * 4);
            bf16_t* base = part == 0 ? q : k;
            f32x4 ks[2][2];
#pragma unroll
            for (int bj = 0; bj < 2; ++bj) { ks[bj][0] = (f32x4){0.f, 0.f, 0.f, 0.f}; ks[bj][1] = (f32x4){0.f, 0.f, 0.f, 0.f}; }
#pragma unroll
            for (int ai = 0; ai < 2; ++ai)
#pragma unroll
                for (int m = 0; m < 4; ++m) { const int r = ai * HALF + wr * 64 + m * 16 + fr, R = u.pm * BM + r, pos = R & (SEQ - 1);
                    const f32x4* tp = (const f32x4*)(tab + pos * 64 + wc * 16 + fq * 4);
                    const f32x4 t0 = tp[0], t1 = tp[1];
                    const f32x4 cs = {t0.x, t0.z, t1.x, t1.z}, sn = {t0.y, t0.w, t1.y, t1.w};
                    bf16_t* rowp = base + (size_t)R * GW + colb;
#pragma unroll
                    for (int bj = 0; bj < 2; ++bj) { const f32x4 pp = *(const LAS f32x4*)(P + r * 8 + bj * 4);
                        const float rstd = sc / sqrtf(((pp.x + pp.y) + (pp.z + pp.w)) * (1.f / HD) + EPS);
                        const f32x4 x1 = acc[ai][bj][m][0] * rstd * g1, x2 = acc[ai][bj][m][1] * rstd * g2;
                        const f32x4 o1 = x1 * cs - x2 * sn, o2 = x2 * cs + x1 * sn;
                        ks[bj][0] += o1; ks[bj][1] += o2; asm volatile("" : "+v"(ks[bj][0]), "+v"(ks[bj][1]));
                        u32x2 w1, w2; w1.x = cvt_pk_bf16(o1[0], o1[1]); w1.y = cvt_pk_bf16(o1[2], o1[3]); w2.x = cvt_pk_bf16(o2[0], o2[1]); w2.y = cvt_pk_bf16(o2[2], o2[3]);
                        *(u32x2*)(rowp + bj * HALF) = w1; *(u32x2*)(rowp + bj * HALF + 64) = w2; }
                    asm volatile("" ::: "memory"); }
            if (part == 1) {
                LAS float* KS = (LAS float*)(xl + 8192);
#pragma unroll
                for (int bj = 0; bj < 2; ++bj)
#pragma unroll
                    for (int n = 0; n < 2; ++n)
#pragma unroll
                        for (int e = 0; e < 4; ++e) { float vsum = ks[bj][n][e]; vsum += __shfl_xor(vsum, 1); vsum += __shfl_xor(vsum, 2); vsum += __shfl_xor(vsum, 4); vsum += __shfl_xor(vsum, 8);
                            if (fr == 0) KS[wr * 256 + bj * HALF + n * 64 + wc * 16 + fq * 4 + e] = vsum; }
                asm volatile("s_waitcnt lgkmcnt(0)" ::: "memory"); __builtin_amdgcn_s_barrier(); asm volatile("" ::: "memory");
                const int t_ = threadIdx.x;
                if (t_ < 256) { const float vv = KS[t_] + KS[256 + t_]; const int hl = ct * 2 + (t_ >> 7), d = t_ & 127, b = u.pm >> 5, nb = u.pm & 31;
                    kmean[((size_t)(b * HG + hl) * NB + nb) * HD + d] = vv * (1.f / BLK); }
            }
        }
    }
};
struct MapPlain_marker_unused {};
template <int lda, int ldb> struct MapPlain { __device__ __forceinline__ size_t a_off(const Unit& u) const { return (size_t)u.pm * BM * lda; } __device__ __forceinline__ size_t b_off(const Unit& u) const { return (size_t)u.pn * BM * ldb; } };
struct MapPool { __device__ __forceinline__ size_t a_off(const Unit& u) const { return (size_t)u.pm * BM * DI + (size_t)(u.pn >> 1) * 512; } __device__ __forceinline__ size_t b_off(const Unit& u) const { return (size_t)u.pn * BM * 512; } };
struct MapQkvz { int g; __device__ __forceinline__ size_t a_off(const Unit& u) const { return (size_t)u.pm * BM * D; } __device__ __forceinline__ size_t b_off(const Unit& u) const { return (size_t)((u.pn >> 1) * DI + g * GW + (u.pn & 1) * BM) * D; } };
}

#define XB_TMO      128
#define XB_XCNT(j)  (256  + 64 * (j))
#define XB_XSUB(j)  (1280 + 64 * (j))
#define XB_XGEN(j)  (2304 + 64 * (j))
#define XB_TOP      3328
#define XB_TOPGEN   3392
#define XCD_BAR_WORDS 3456
#define XB_SPIN_CAP (1u << 18)
__device__ __forceinline__ unsigned xb_ld(unsigned* p)              { return __hip_atomic_load(p, __ATOMIC_RELAXED, __HIP_MEMORY_SCOPE_AGENT); }
__device__ __forceinline__ unsigned xb_add(unsigned* p, unsigned v) { return __hip_atomic_fetch_add(p, v, __ATOMIC_RELAXED, __HIP_MEMORY_SCOPE_AGENT); }
__device__ __forceinline__ unsigned xb_xcc_id() { return (unsigned)__builtin_amdgcn_s_getreg((3 << 11) | 20) & 0xFu; }
#define XB_SPIN(cond, bar) do { unsigned _sp = 0; while (cond) { __builtin_amdgcn_s_sleep(1); \
    if ((++_sp & 255u) == 0u) { if (xb_ld(&(bar)[XB_TMO])) break; if (_sp > XB_SPIN_CAP) { atomicAdd(&(bar)[XB_TMO], 1u); break; } } } } while (0)
struct XcdBarrier { unsigned* bar; unsigned x; volatile LAS unsigned* st; };
__device__ __forceinline__ XcdBarrier xcd_barrier_post(unsigned* bar, volatile LAS unsigned* st) {
    XcdBarrier b; b.bar = bar; b.x = xb_xcc_id(); b.st = st;
    if (threadIdx.x == 0) (void)xb_add(&bar[XB_XCNT(b.x)], 1u);
    return b;
}
__device__ __forceinline__ void xcd_barrier_complete(unsigned* bar, unsigned x, unsigned& nloc, unsigned& nx) {
    const unsigned G = gridDim.x * gridDim.y * gridDim.z;
    unsigned sum, cnt, mine, sp = 0u;
    for (;;) {
        sum = 0u; cnt = 0u; mine = 0u;
#pragma unroll
        for (unsigned j = 0; j < 16; ++j) { const unsigned c = xb_ld(&bar[XB_XCNT(j)]); sum += c; cnt += (c > 0u) ? 1u : 0u; mine = (j == x) ? c : mine; }
        if (sum == G) break;
        __builtin_amdgcn_s_sleep(1);
        if ((++sp & 255u) == 0u) { if (xb_ld(&bar[XB_TMO])) break; if (sp > XB_SPIN_CAP) { atomicAdd(&bar[XB_TMO], 1u); break; } }
    }
    nloc = mine > 0u ? mine : 1u; nx = cnt > 0u ? cnt : 1u;
}
__device__ __forceinline__ void xcd_barrier(const XcdBarrier& b) {
    asm volatile("s_waitcnt vmcnt(0)" ::: "memory");
    __syncthreads();
    if (threadIdx.x == 0) {
        unsigned* bar = b.bar;
        __builtin_amdgcn_s_waitcnt(0);
        unsigned nloc = b.st[0], nx = b.st[1];
        if (nloc == 0u) { xcd_barrier_complete(bar, b.x, nloc, nx); b.st[0] = nloc; b.st[1] = nx; }
        const unsigned old = xb_add(&bar[XB_XSUB(b.x)], 1u);
        const unsigned gen = old / nloc;
        if (old + 1u == (gen + 1u) * nloc) {
            __builtin_amdgcn_fence(__ATOMIC_RELEASE, "agent");
            asm volatile("s_waitcnt vmcnt(0)" ::: "memory");
            const unsigned og = xb_add(&bar[XB_TOP], 1u);
            const unsigned tg = og / nx;
            if (og + 1u == (tg + 1u) * nx) xb_add(&bar[XB_TOPGEN], 1u);
            else XB_SPIN(xb_ld(&bar[XB_TOPGEN]) == tg, bar);
            __builtin_amdgcn_fence(__ATOMIC_ACQUIRE, "agent");
            xb_add(&bar[XB_XGEN(b.x)], 1u);
            asm volatile("s_waitcnt vmcnt(0)" ::: "memory");
        } else {
            XB_SPIN(xb_ld(&bar[XB_XGEN(b.x)]) == gen, bar);
            __builtin_amdgcn_fence(__ATOMIC_ACQUIRE, "agent");
            asm volatile("s_waitcnt vmcnt(0)" ::: "memory");
        }
    }
    __syncthreads();
}

struct Args { const float* in[11]; float* out; unsigned char* ws; int ph_lo, ph_hi, coop, pad; };

__device__ __forceinline__ void transpose_item(const float* W, int K, int N, bf16_t* WT, LAS float* scr, int item, int lane) {
    const int nblk = N / 32, kb = item / nblk, nb = item % nblk, k0 = 64 * kb, n0 = 32 * nb;
#pragma unroll 8
    for (int i = 0; i < 32; ++i) { const int kk = 2 * i + (lane >> 5); scr[kk * 33 + (lane & 31)] = W[(size_t)(k0 + kk) * N + n0 + (lane & 31)]; }
    asm volatile("s_waitcnt lgkmcnt(0)" ::: "memory");
    const int c = lane & 7;
#pragma unroll
    for (int j = 0; j < 4; ++j) { const int n = (lane >> 3) + 8 * j; const LAS float* s = scr + (8 * c) * 33 + n;
        u32x4 o; o.x = cvt_pk_bf16(s[0 * 33], s[1 * 33]); o.y = cvt_pk_bf16(s[2 * 33], s[3 * 33]); o.z = cvt_pk_bf16(s[4 * 33], s[5 * 33]); o.w = cvt_pk_bf16(s[6 * 33], s[7 * 33]);
        *(u32x4*)(WT + (size_t)(n0 + n) * K + k0 + 8 * c) = o; }
    asm volatile("s_waitcnt lgkmcnt(0)" ::: "memory");
}
template <int NR>
__device__ __forceinline__ void rms_rows(const float* xbase, const float* gain, bf16_t* obase, int m, int stride, int lane) {
    f32x4 v[NR][4]; float s[NR];
#pragma unroll
    for (int r = 0; r < NR; ++r) { const f32x4* xr = (const f32x4*)(xbase + (size_t)(m + r * stride) * D) + lane;
#pragma unroll
        for (int j = 0; j < 4; ++j) v[r][j] = xr[64 * j]; }
#pragma unroll
    for (int r = 0; r < NR; ++r) { float a = 0.f;
#pragma unroll
        for (int j = 0; j < 4; ++j) a += (v[r][j].x * v[r][j].x + v[r][j].y * v[r][j].y) + (v[r][j].z * v[r][j].z + v[r][j].w * v[r][j].w);
        s[r] = 1.0f / sqrtf(wave_sum(a) * (1.f / D) + EPS); }
    const f32x4* gr = (const f32x4*)gain + lane;
#pragma unroll
    for (int j = 0; j < 4; ++j) { const f32x4 gg = gr[64 * j];
#pragma unroll
        for (int r = 0; r < NR; ++r) { u32x2 w; w.x = cvt_pk_bf16(v[r][j].x * s[r] * gg.x, v[r][j].y * s[r] * gg.y); w.y = cvt_pk_bf16(v[r][j].z * s[r] * gg.z, v[r][j].w * s[r] * gg.w);
            ((u32x2*)(obase + (size_t)(m + r * stride) * D) + lane)[64 * j] = w; } }
}
__device__ __forceinline__ void rope_entry(int idx, f32x2* tab) {
    const int pos = idx >> 6, i = idx & 63;
    const float inv = (float)exp2(-(double)(2 * i) * (13.287712379549449 / 128.0));
    const float angf = (float)pos * inv;
    const double a = (double)angf; const double q = rint(a * 0.6366197723675814); const double r = a - q * 1.5707963267948966;
    const double r2 = r * r;
    double sn = r * (1.0 - r2 / 6.0 * (1.0 - r2 / 20.0 * (1.0 - r2 / 42.0 * (1.0 - r2 / 72.0 * (1.0 - r2 / 110.0 * (1.0 - r2 / 156.0))))));
    double cs = 1.0 - r2 / 2.0 * (1.0 - r2 / 12.0 * (1.0 - r2 / 30.0 * (1.0 - r2 / 56.0 * (1.0 - r2 / 90.0 * (1.0 - r2 / 132.0)))));
    const int qi = ((int)q) & 3;
    double c2, s2;
    if (qi == 0) { c2 = cs; s2 = sn; } else if (qi == 1) { c2 = -sn; s2 = cs; } else if (qi == 2) { c2 = -cs; s2 = -sn; } else { c2 = sn; s2 = -cs; }
    tab[idx] = (f32x2){(float)c2, (float)s2};
}

__global__ void __launch_bounds__(NTHREADS, 2) mega_fwd(Args args) {
    extern __shared__ __attribute__((aligned(16))) unsigned char lds_raw[];
    LAS unsigned char* lds = (LAS unsigned char*)lds_raw;
    cg::grid_group grid = cg::this_grid();
    const int G = gridDim.x, bx = blockIdx.x;
    volatile LAS unsigned* bst = (volatile LAS unsigned*)(lds + LDS_BYTES - 16);
    if (threadIdx.x < 4) bst[threadIdx.x] = 0u;
    __syncthreads();
    XcdBarrier xbar; xbar.bar = (unsigned*)(args.ws + WS_BAR); xbar.x = 0; xbar.st = bst;
    if (args.coop) xbar = xcd_barrier_post((unsigned*)(args.ws + WS_BAR), bst);
    unsigned char* ws = args.ws;
#define XIN (args.in[0])
#define norm0 (args.in[1])
#define w_in0 (args.in[2])
#define w_pool0 (args.in[3])
#define pool_scale0 (args.in[4])
#define w_out0 (args.in[5])
#define norm1 (args.in[6])
#define w_in1 (args.in[7])
#define q_norm1 (args.in[8])
#define k_norm1 (args.in[9])
#define w_out1 (args.in[10])
    float* out = args.out;
#define WIN0 ((bf16_t*)(ws + WS_WIN0))
#define WP ((bf16_t*)(ws + WS_WP))
#define WOUT0 ((bf16_t*)(ws + WS_WOUT0))
#define WIN1 ((bf16_t*)(ws + WS_WIN1))
#define WOUT1 ((bf16_t*)(ws + WS_WOUT1))
#define H0 ((bf16_t*)(ws + WS_H0))
#define POOLED ((bf16_t*)(ws + WS_POOLED))
#define U ((bf16_t*)(ws + WS_U))
#define SZ0 ((bf16_t*)(ws + WS_SZ0))
#define H1 ((bf16_t*)(ws + WS_H1))
#define QG ((bf16_t*)(ws + WS_QG))
#define KG ((bf16_t*)(ws + WS_KG))
#define VG ((bf16_t*)(ws + WS_VG))
#define SZG ((bf16_t*)(ws + WS_SZG))
#define OPART ((bf16_t*)(ws + WS_OPART))
#define AT ((bf16_t*)(ws + WS_A))
#define KMEAN ((float*)(ws + WS_KMEAN))
#define SEL ((unsigned*)(ws + WS_SEL))
#define LPART ((float*)(ws + WS_LPART))
#define TAB ((f32x2*)(ws + WS_TAB))
#define LIST ((unsigned short*)(ws + WS_LIST))
#define CNT ((unsigned*)(ws + WS_CTL))
    const int lo = args.ph_lo, hi = args.ph_hi;
#define IN(k) (lo <= (k) && (k) < hi)
#define SYNC(k) do { if (IN(k) && IN((k) + 1) && args.coop) { if (args.coop == 2) grid.sync(); else xcd_barrier(xbar); } } while (0)
    {
        if (IN(0) && (PH_MASK & 1)) {
            int tid = threadIdx.x; asm volatile("" : "+v"(tid)); const int lane = tid & 63, wave = __builtin_amdgcn_readfirstlane(tid >> 6); (void)lane; (void)wave;
            LAS float* scr = (LAS float*)(lds + wave * 16384);
            const int gw = bx * 8 + wave, NGW = G * 8;
            constexpr int I0 = (D / 64) * (2 * DI / 32), IP = (512 / 64) * (512 / 32), I1 = (DI / 64) * (D / 32), I2 = (D / 64) * (4 * DI / 32), I3 = I1;
            constexpr int NITEMS = I0 + 4 * IP + I1 + I2 + I3;
            for (int it = gw; it < NITEMS; it += NGW) {
                int r = it;
                if (r < I0) { transpose_item(w_in0, D, 2 * DI, WIN0, scr, r, lane); continue; } r -= I0;
                if (r < 4 * IP) { const int gp = r / IP; transpose_item(w_pool0 + (size_t)gp * 512 * 512, 512, 512, WP + (size_t)gp * 512 * 512, scr, r - gp * IP, lane); continue; } r -= 4 * IP;
                if (r < I1) { transpose_item(w_out0, DI, D, WOUT0, scr, r, lane); continue; } r -= I1;
                if (r < I2) { transpose_item(w_in1, D, 4 * DI, WIN1, scr, r, lane); continue; } r -= I2;
                transpose_item(w_out1, DI, D, WOUT1, scr, r, lane);
            }
            for (int idx = bx * NTHREADS + tid; idx < SEQ * 64; idx += G * NTHREADS) rope_entry(idx, TAB);
            for (int m = gw; m < M; m += 4 * NGW) { if (m + 3 * NGW < M) rms_rows<4>(XIN, norm0, H0, m, NGW, lane); else for (int r = 0; r < 4; ++r) if (m + r * NGW < M) rms_rows<1>(XIN, norm0, H0, m + r * NGW, 0, lane); }
        }
        SYNC(0);
        if (IN(1) && (PH_MASK & 2)) {
            int tid = threadIdx.x; asm volatile("" : "+v"(tid)); const int lane = tid & 63, wave = __builtin_amdgcn_readfirstlane(tid >> 6); (void)lane; (void)wave;
            pg8::Gemm<D, D, D> g{H0, WIN0}; pg8::StaticOrder S; S.init(M, 2 * DI, G, bx);
            pg8::EpiSplit<DI, 8, 1> E{U, SZ0, U, U}; pg8::MapPlain<D, D> MP;
            pg8::gemm_phase(lds, g, S, MP, E);
        }
        SYNC(1);
        if (IN(2) && (PH_MASK & 4)) {
            int tid = threadIdx.x; asm volatile("" : "+v"(tid)); const int lane = tid & 63, wave = __builtin_amdgcn_readfirstlane(tid >> 6); (void)lane; (void)wave;
            const int cgp = tid & 255, hh = tid >> 8, col = cgp * 8, w = 2 << (cgp >> 6);
            for (int unit = bx; unit < M / 64; unit += G) {
                const int r0 = unit * 64 + hh * 32, p0 = r0 & (SEQ - 1);
                float sum[8];
#pragma unroll
                for (int e = 0; e < 8; ++e) sum[e] = 0.f;
                for (int i = 1; i < w; ++i) { if (p0 - i >= 0) { const u32x4 v = *(const u32x4*)(U + (size_t)(r0 - i) * DI + col);
                    sum[0] += bf_lo(v.x); sum[1] += bf_hi(v.x); sum[2] += bf_lo(v.y); sum[3] += bf_hi(v.y); sum[4] += bf_lo(v.z); sum[5] += bf_hi(v.z); sum[6] += bf_lo(v.w); sum[7] += bf_hi(v.w); } }
#pragma unroll 1
                for (int tb = 0; tb < 32; tb += 8) {
                    u32x4 nw[8], tr[8];
#pragma unroll
                    for (int t = 0; t < 8; ++t) nw[t] = *(const u32x4*)(U + (size_t)(r0 + tb + t) * DI + col);
#pragma unroll
                    for (int t = 0; t < 8; ++t) { const int pl = p0 + tb + t - w + 1; tr[t] = (u32x4){0u, 0u, 0u, 0u}; if (pl >= 0) tr[t] = *(const u32x4*)(U + (size_t)(r0 + tb + t - w + 1) * DI + col); }
#pragma unroll
                    for (int t = 0; t < 8; ++t) {
                        const int p = p0 + tb + t; const u32x4 v = nw[t];
                        float c[8] = {bf_lo(v.x), bf_hi(v.x), bf_lo(v.y), bf_hi(v.y), bf_lo(v.z), bf_hi(v.z), bf_lo(v.w), bf_hi(v.w)};
                        const float rc = 1.0f / (float)((p + 1) < w ? (p + 1) : w);
                        float o[8];
#pragma unroll
                        for (int e = 0; e < 8; ++e) { sum[e] += c[e]; o[e] = sum[e] * rc - c[e]; }
                        u32x4 wv; wv.x = cvt_pk_bf16(o[0], o[1]); wv.y = cvt_pk_bf16(o[2], o[3]); wv.z = cvt_pk_bf16(o[4], o[5]); wv.w = cvt_pk_bf16(o[6], o[7]);
                        *(u32x4*)(POOLED + (size_t)(r0 + tb + t) * DI + col) = wv;
                        const u32x4 q = tr[t];
                        sum[0] -= bf_lo(q.x); sum[1] -= bf_hi(q.x); sum[2] -= bf_lo(q.y); sum[3] -= bf_hi(q.y); sum[4] -= bf_lo(q.z); sum[5] -= bf_hi(q.z); sum[6] -= bf_lo(q.w); sum[7] -= bf_hi(q.w);
                    }
                }
            }
        }
        SYNC(2);
        if (IN(3) && (PH_MASK & 8)) {
            int tid = threadIdx.x; asm volatile("" : "+v"(tid)); const int lane = tid & 63, wave = __builtin_amdgcn_readfirstlane(tid >> 6); (void)lane; (void)wave;
            pg8::Gemm<DI, 512, 512> g{POOLED, WP}; pg8::StaticOrder S; S.init(M, DI, G, bx);
            pg8::EpiGate E{U, SZ0, pool_scale0}; pg8::MapPool MP;
            pg8::gemm_phase(lds, g, S, MP, E);
        }
        SYNC(3);
        if (IN(4) && (PH_MASK & 16)) {
            int tid = threadIdx.x; asm volatile("" : "+v"(tid)); const int lane = tid & 63, wave = __builtin_amdgcn_readfirstlane(tid >> 6); (void)lane; (void)wave;
            pg8::Gemm<DI, DI, DI> g{U, WOUT0}; pg8::StaticOrder S; S.init(M, D, G, bx);
            pg8::EpiRes E{XIN, out}; pg8::MapPlain<DI, DI> MP;
            pg8::gemm_phase(lds, g, S, MP, E);
        }
        SYNC(4);
        if (IN(5) && (PH_MASK & 32)) {
            int tid = threadIdx.x; asm volatile("" : "+v"(tid)); const int lane = tid & 63, wave = __builtin_amdgcn_readfirstlane(tid >> 6); (void)lane; (void)wave;
            const int gw = bx * 8 + wave, NGW = G * 8;
            for (int m = gw; m < M; m += 4 * NGW) { if (m + 3 * NGW < M) rms_rows<4>(out, norm1, H1, m, NGW, lane); else for (int r = 0; r < 4; ++r) if (m + r * NGW < M) rms_rows<1>(out, norm1, H1, m + r * NGW, 0, lane); }
        }
        SYNC(5);
#pragma unroll
        for (int g = 0; g < NG; ++g) {
            const int pb = 6 + 3 * g;
            if (IN(pb) && (PH_MASK & 64)) {
            int tid = threadIdx.x; asm volatile("" : "+v"(tid)); const int lane = tid & 63, wave = __builtin_amdgcn_readfirstlane(tid >> 6); (void)lane; (void)wave;
                if (g > 0) { const int gc = g - 1;
#pragma unroll 2
                for (int idx = bx * NTHREADS + tid; idx < M * HG * 16; idx += G * NTHREADS) {
                    const int pair = idx >> 4, ch = idx & 15, m = pair >> 2, hl = pair & 3;
                    const unsigned sel = SEL[(size_t)m * NH + gc * HG + hl];
                    const f32x4 lp = *(const f32x4*)(LPART + (size_t)pair * 4);
                    u32x4 pv[4];
#pragma unroll
                    for (int e = 0; e < 4; ++e) pv[e] = *(const u32x4*)(OPART + ((size_t)pair * 4 + e) * HD + ch * 8);
                    float o[8]; float l = lp.w;
                    o[0] = bf_lo(pv[3].x); o[1] = bf_hi(pv[3].x); o[2] = bf_lo(pv[3].y); o[3] = bf_hi(pv[3].y); o[4] = bf_lo(pv[3].z); o[5] = bf_hi(pv[3].z); o[6] = bf_lo(pv[3].w); o[7] = bf_hi(pv[3].w);
#pragma unroll
                    for (int e = 0; e < 3; ++e) { const bool ok = ((sel >> (8 * e)) & 0xffu) != 0xffu; const u32x4 v = pv[e];
                        l += ok ? lp[e] : 0.f;
                        o[0] += ok ? bf_lo(v.x) : 0.f; o[1] += ok ? bf_hi(v.x) : 0.f; o[2] += ok ? bf_lo(v.y) : 0.f; o[3] += ok ? bf_hi(v.y) : 0.f;
                        o[4] += ok ? bf_lo(v.z) : 0.f; o[5] += ok ? bf_hi(v.z) : 0.f; o[6] += ok ? bf_lo(v.w) : 0.f; o[7] += ok ? bf_hi(v.w) : 0.f; }
                    const float rl = 1.0f / l;
                    u32x4* ap = (u32x4*)(AT + (size_t)m * DI + gc * GW + hl * HD + ch * 8);
                    const u32x4 z = *ap;
                    u32x4 w; w.x = cvt_pk_bf16(o[0] * rl * bf_lo(z.x), o[1] * rl * bf_hi(z.x)); w.y = cvt_pk_bf16(o[2] * rl * bf_lo(z.y), o[3] * rl * bf_hi(z.y));
                    w.z = cvt_pk_bf16(o[4] * rl * bf_lo(z.z), o[5] * rl * bf_hi(z.z)); w.w = cvt_pk_bf16(o[6] * rl * bf_lo(z.w), o[7] * rl * bf_hi(z.w));
                    *ap = w;
                }
                }
                pg8::Gemm<D, D, D> gm{H1, WIN1}; pg8::StaticOrder S; S.init(M, 4 * GW, G, bx);
                pg8::EpiQkvz E{QG, KG, VG, AT + (size_t)g * GW, q_norm1, k_norm1, TAB, KMEAN + (size_t)g * 8 * NB * HD, lds + 131072}; pg8::MapQkvz MP{g};
                pg8::gemm_phase(lds, gm, S, MP, E);
            }
            SYNC(pb);
            if (IN(pb + 1) && (PH_MASK & 256)) {
            int tid = threadIdx.x; asm volatile("" : "+v"(tid)); const int lane = tid & 63, wave = __builtin_amdgcn_readfirstlane(tid >> 6); (void)lane; (void)wave;
                LAS unsigned char* kmh = lds;
                LAS unsigned char* kml = lds + 32 * 272;
                LAS unsigned* lcnt = (LAS unsigned*)(lds + 2 * 32 * 272);
                LAS unsigned* lbase = lcnt + 32;
                if (tid < 32) lcnt[tid] = 0u;
                __syncthreads();
                const int fr = lane & 15, fq = lane >> 4;
#define TOP3_INS(val, idx) do { const float v_ = (val); const int n_ = (idx); \
        if (v_ > v0 || (v_ == v0 && n_ < i0)) { v2 = v1; i2 = i1; v1 = v0; i1 = i0; v0 = v_; i0 = n_; } \
        else if (v_ > v1 || (v_ == v1 && n_ < i1)) { v2 = v1; i2 = i1; v1 = v_; i1 = n_; } \
        else if (v_ > v2 || (v_ == v2 && n_ < i2)) { v2 = v_; i2 = n_; } } while (0)
#pragma unroll 1
                for (int unit = bx; unit < 8 * NB; unit += G) {
                    const int bh = unit >> 5, qb = unit & 31, b = bh >> 2, hl = bh & 3;
                    if (qb > 0) {
                        for (int idx = tid; idx < qb * 32; idx += NTHREADS) { const int n = idx >> 5, c4 = idx & 31;
                            const f32x4 v = *(const f32x4*)(KMEAN + ((size_t)(g * 8 + bh) * NB + n) * HD + c4 * 4);
                            u32x2 h; h.x = cvt_pk_bf16(v.x, v.y); h.y = cvt_pk_bf16(v.z, v.w);
                            u32x2 l; l.x = cvt_pk_bf16(v.x - bf_lo(h.x), v.y - bf_hi(h.x)); l.y = cvt_pk_bf16(v.z - bf_lo(h.y), v.w - bf_hi(h.y));
                            *(LAS u32x2*)(kmh + n * 272 + c4 * 8) = h; *(LAS u32x2*)(kml + n * 272 + c4 * 8) = l; }
                        bf16x8 qf[2][4];
#pragma unroll
                        for (int t = 0; t < 2; ++t) { const bf16_t* qp = QG + ((size_t)b * SEQ + qb * BLK + wave * 32 + t * 16 + fr) * GW + hl * HD + fq * 8;
#pragma unroll
                            for (int ks = 0; ks < 4; ++ks) qf[t][ks] = *(const bf16x8*)(qp + ks * 32); }
                        __syncthreads();
                        f32x4 sacc[2][2];
#pragma unroll
                        for (int nt = 0; nt < 2; ++nt) { sacc[nt][0] = (f32x4){0.f, 0.f, 0.f, 0.f}; sacc[nt][1] = (f32x4){0.f, 0.f, 0.f, 0.f}; }
#pragma unroll
                        for (int nt = 0; nt < 2; ++nt) if (nt * 16 < qb) {
#pragma unroll
                            for (int ks = 0; ks < 4; ++ks) { const bf16x8 ah = *(const LAS bf16x8*)(kmh + (nt * 16 + fr) * 272 + ks * 64 + fq * 16), al = *(const LAS bf16x8*)(kml + (nt * 16 + fr) * 272 + ks * 64 + fq * 16);
#pragma unroll
                                for (int t = 0; t < 2; ++t) { sacc[nt][t] = __builtin_amdgcn_mfma_f32_16x16x32_bf16(ah, qf[t][ks], sacc[nt][t], 0, 0, 0); sacc[nt][t] = __builtin_amdgcn_mfma_f32_16x16x32_bf16(al, qf[t][ks], sacc[nt][t], 0, 0, 0); } } }
                        float tv[2][3]; int ti[2][3];
#pragma unroll
                        for (int t = 0; t < 2; ++t) {
                            float v0 = -INFINITY, v1 = -INFINITY, v2 = -INFINITY; int i0 = 255, i1 = 255, i2 = 255;
#pragma unroll
                            for (int nt = 0; nt < 2; ++nt)
#pragma unroll
                                for (int j = 0; j < 4; ++j) { const int n = nt * 16 + fq * 4 + j; if (n < qb) TOP3_INS(sacc[nt][t][j], n); }
#pragma unroll
                            for (int st = 16; st <= 32; st <<= 1) {
                                const float a0 = __shfl_xor(v0, st), a1 = __shfl_xor(v1, st), a2 = __shfl_xor(v2, st); const int b0 = __shfl_xor(i0, st), b1 = __shfl_xor(i1, st), b2 = __shfl_xor(i2, st);
                                if (b0 < 255) TOP3_INS(a0, b0); if (b1 < 255) TOP3_INS(a1, b1); if (b2 < 255) TOP3_INS(a2, b2);
                            }
                            tv[t][0] = v0; tv[t][1] = v1; tv[t][2] = v2; ti[t][0] = i0; ti[t][1] = i1; ti[t][2] = i2;
                        }
                        const int i0 = fq == 0 ? ti[0][0] : ti[1][0], i1 = fq == 0 ? ti[0][1] : ti[1][1], i2 = fq == 0 ? ti[0][2] : ti[1][2];
                        const int s = qb * BLK + wave * 32 + lane; const size_t mrow = (size_t)b * SEQ + s;
                        unsigned rk0 = 0, rk1 = 0, rk2 = 0;
                        if (lane < 32) {
                            SEL[mrow * NH + g * HG + hl] = (unsigned)i0 | ((unsigned)i1 << 8) | ((unsigned)i2 << 16);
                            if (i0 < 255) rk0 = atomicAdd((unsigned*)&lcnt[i0], 1u);
                            if (i1 < 255) rk1 = atomicAdd((unsigned*)&lcnt[i1], 1u);
                            if (i2 < 255) rk2 = atomicAdd((unsigned*)&lcnt[i2], 1u);
                        }
                        __syncthreads();
                        if (tid < 32) { const unsigned c = lcnt[tid]; lbase[tid] = c ? atomicAdd(&CNT[g * 256 + bh * NB + tid], c) : 0u; lcnt[tid] = 0u; }
                        __syncthreads();
                        if (lane < 32) {
                            if (i0 < 255) LIST[(size_t)(bh * NB + i0) * SEQ + lbase[i0] + rk0] = (unsigned short)(s | (0 << 13));
                            if (i1 < 255) LIST[(size_t)(bh * NB + i1) * SEQ + lbase[i1] + rk1] = (unsigned short)(s | (1 << 13));
                            if (i2 < 255) LIST[(size_t)(bh * NB + i2) * SEQ + lbase[i2] + rk2] = (unsigned short)(s | (2 << 13));
                        }
                        __syncthreads();
                    } else if (tid < 256) {
                        SEL[((size_t)b * SEQ + tid) * NH + g * HG + hl] = 0x00ffffffu;
                    }
                }
#undef TOP3_INS
            }
            SYNC(pb + 1);
            if (IN(pb + 2) && (PH_MASK & 512)) {
            int tid = threadIdx.x; asm volatile("" : "+v"(tid)); const int lane = tid & 63, wave = __builtin_amdgcn_readfirstlane(tid >> 6); (void)lane; (void)wave;
                LAS unsigned char* Ks = lds;
                LAS unsigned char* Vt = lds + 256 * 272;
                LAS int* pre = (LAS int*)(lds + 256 * 272 + 128 * 528);
                LAS float* red = (LAS float*)(lds + 256 * 272 + 128 * 528 + 2048);
                {
                    float mq = 0.f, mk = 0.f;
                    if (tid < 128) { mq = fabsf(q_norm1[tid]); mk = fabsf(k_norm1[tid]); }
#pragma unroll
                    for (int o = 1; o < 64; o <<= 1) { mq = fmaxf(mq, __shfl_xor(mq, o)); mk = fmaxf(mk, __shfl_xor(mk, o)); }
                    if (lane == 0) { red[wave * 2] = mq; red[wave * 2 + 1] = mk; }
                    if (tid < 256) pre[tid + 1] = 1 + (int)((CNT[g * 256 + tid] + 255u) >> 8);
                    if (tid == 0) pre[0] = 0;
                    __syncthreads();
                    if (tid == 0) { int a = 0; for (int i = 1; i <= 256; ++i) { a += pre[i]; pre[i] = a; } }
                    __syncthreads();
                }
                const float MSH = 128.0f * QSCALE * fmaxf(red[0], red[2]) * fmaxf(red[1], red[3]) * 1.02f;
                const int total = pre[256];
                const int fr = lane & 15, fq = lane >> 4;
                const int istart = (int)(((long)total * bx) / G), iend = (int)(((long)total * (bx + 1)) / G);
                int cur_li = -1;
#pragma unroll 1
                for (int item = istart; item < iend; ++item) {
                    int loi = 0, hii = 256;
                    while (hii - loi > 1) { const int mid = (loi + hii) >> 1; if (pre[mid] <= item) loi = mid; else hii = mid; }
                    const int li = loi, c = item - pre[li], bh = li >> 5, n = li & 31, b = bh >> 2, hl = bh & 3;
                    const int cnt = (int)CNT[g * 256 + li];
                    const size_t rowbase = (size_t)b * SEQ;
                    const bool restage = (li != cur_li); cur_li = li;
                    if (restage) {
                    __syncthreads();
                    for (int cc = tid; cc < 256 * 16; cc += NTHREADS) { const int r = cc >> 4, c16 = cc & 15;
                        *(LAS u32x4*)(Ks + r * 272 + c16 * 16) = *(const u32x4*)(KG + (rowbase + n * BLK + r) * GW + hl * HD + c16 * 8); }
                    for (int task = tid; task < 1024; task += NTHREADS) {
                        const int a = (task & 15) | ((task >> 5) & 3) << 4, cch = ((task >> 4) & 1) | ((task >> 7) << 1);
                        u32x4 v[4];
#pragma unroll
                        for (int kk = 0; kk < 4; ++kk) v[kk] = *(const u32x4*)(VG + (rowbase + n * BLK + a * 4 + kk) * GW + hl * HD + cch * 8);
#pragma unroll
                        for (int e = 0; e < 4; ++e) {
                            const unsigned w0 = e == 0 ? v[0].x : e == 1 ? v[0].y : e == 2 ? v[0].z : v[0].w, w1 = e == 0 ? v[1].x : e == 1 ? v[1].y : e == 2 ? v[1].z : v[1].w;
                            const unsigned w2 = e == 0 ? v[2].x : e == 1 ? v[2].y : e == 2 ? v[2].z : v[2].w, w3 = e == 0 ? v[3].x : e == 1 ? v[3].y : e == 2 ? v[3].z : v[3].w;
                            u32x2 lo2, hi2;
                            lo2.x = (w0 & 0xffffu) | (w1 << 16); lo2.y = (w2 & 0xffffu) | (w3 << 16);
                            hi2.x = (w0 >> 16) | (w1 & 0xffff0000u); hi2.y = (w2 >> 16) | (w3 & 0xffff0000u);
                            *(LAS u32x2*)(Vt + (cch * 8 + 2 * e) * 528 + a * 8) = lo2;
                            *(LAS u32x2*)(Vt + (cch * 8 + 2 * e + 1) * 528 + a * 8) = hi2;
                        }
                    }
                    }
                    int qpos[2], qslot[2]; bool qok[2];
                    bf16x8 qf[2][4];
#pragma unroll
                    for (int t = 0; t < 2; ++t) {
                        const int ridx = wave * 32 + t * 16 + fr;
                        if (c == 0) { qpos[t] = n * BLK + ridx; qslot[t] = 3; qok[t] = true; }
                        else { const int lidx = (c - 1) * 256 + ridx; qok[t] = lidx < cnt; const unsigned e = LIST[(size_t)li * SEQ + (qok[t] ? lidx : 0)]; qpos[t] = e & 8191; qslot[t] = e >> 13; }
                        const bf16_t* qp = QG + (rowbase + qpos[t]) * GW + hl * HD + fq * 8;
#pragma unroll
                        for (int ks = 0; ks < 4; ++ks) qf[t][ks] = *(const bf16x8*)(qp + ks * 32);
                    }
                    if (restage) __syncthreads();
                    f32x4 oacc[2][8], lacc[2];
#pragma unroll
                    for (int t = 0; t < 2; ++t) { lacc[t] = (f32x4){0.f, 0.f, 0.f, 0.f};
#pragma unroll
                        for (int dt = 0; dt < 8; ++dt) oacc[t][dt] = (f32x4){0.f, 0.f, 0.f, 0.f}; }
                    const int qrel0 = qpos[0] - n * BLK, qrel1 = qpos[1] - n * BLK;
                    const int kg_end = (c == 0) ? wave + 1 : 8;
                    const bf16x8 ones = {0x3F80, 0x3F80, 0x3F80, 0x3F80, 0x3F80, 0x3F80, 0x3F80, 0x3F80};
                    bf16x8 kf[2][4];
#pragma unroll
                    for (int kt = 0; kt < 2; ++kt)
#pragma unroll
                        for (int ks = 0; ks < 4; ++ks) kf[kt][ks] = *(const LAS bf16x8*)(Ks + (kt * 16 + fr) * 272 + ks * 64 + fq * 16);
#pragma unroll 1
                    for (int kg = 0; kg < kg_end; ++kg) {
                        u32x2 va[8], vb[8];
#pragma unroll
                        for (int dt = 0; dt < 8; ++dt) { va[dt] = *(const LAS u32x2*)(Vt + (dt * 16 + fr) * 528 + kg * 64 + fq * 8); vb[dt] = *(const LAS u32x2*)(Vt + (dt * 16 + fr) * 528 + kg * 64 + 32 + fq * 8); }
                        __builtin_amdgcn_sched_barrier(0);
                        f32x4 sacc[2][2];
#pragma unroll
                        for (int kt = 0; kt < 2; ++kt) { sacc[kt][0] = (f32x4){-MSH, -MSH, -MSH, -MSH}; sacc[kt][1] = (f32x4){-MSH, -MSH, -MSH, -MSH}; }
#pragma unroll
                        for (int ks = 0; ks < 4; ++ks)
#pragma unroll
                            for (int kt = 0; kt < 2; ++kt) {
                                sacc[kt][0] = __builtin_amdgcn_mfma_f32_16x16x32_bf16(kf[kt][ks], qf[0][ks], sacc[kt][0], 0, 0, 0);
                                sacc[kt][1] = __builtin_amdgcn_mfma_f32_16x16x32_bf16(kf[kt][ks], qf[1][ks], sacc[kt][1], 0, 0, 0); }
                        __builtin_amdgcn_sched_barrier(0);
                        if (kg + 1 < kg_end) {
#pragma unroll
                            for (int kt = 0; kt < 2; ++kt)
#pragma unroll
                                for (int ks = 0; ks < 4; ++ks) kf[kt][ks] = *(const LAS bf16x8*)(Ks + ((kg + 1) * 32 + kt * 16 + fr) * 272 + ks * 64 + fq * 16);
                        }
                        bf16x8 pb[2];
                        if (c == 0 && kg == wave) {
#pragma unroll
                            for (int t = 0; t < 2; ++t) {
                                float p[8];
#pragma unroll
                                for (int kt = 0; kt < 2; ++kt)
#pragma unroll
                                    for (int j = 0; j < 4; ++j) { float pv = __builtin_amdgcn_exp2f(sacc[kt][t][j]);
                                        const int key = kg * 32 + kt * 16 + fq * 4 + j; if (key > (t == 0 ? qrel0 : qrel1)) pv = 0.f;
                                        p[kt * 4 + j] = pv; }
                                u32x4 w; w.x = cvt_pk_bf16(p[0], p[1]); w.y = cvt_pk_bf16(p[2], p[3]); w.z = cvt_pk_bf16(p[4], p[5]); w.w = cvt_pk_bf16(p[6], p[7]);
                                pb[t] = __builtin_bit_cast(bf16x8, w);
                            }
                        } else {
#pragma unroll
                            for (int t = 0; t < 2; ++t) {
                                u32x4 w;
                                w.x = cvt_pk_bf16(__builtin_amdgcn_exp2f(sacc[0][t][0]), __builtin_amdgcn_exp2f(sacc[0][t][1])); w.y = cvt_pk_bf16(__builtin_amdgcn_exp2f(sacc[0][t][2]), __builtin_amdgcn_exp2f(sacc[0][t][3]));
                                w.z = cvt_pk_bf16(__builtin_amdgcn_exp2f(sacc[1][t][0]), __builtin_amdgcn_exp2f(sacc[1][t][1])); w.w = cvt_pk_bf16(__builtin_amdgcn_exp2f(sacc[1][t][2]), __builtin_amdgcn_exp2f(sacc[1][t][3]));
                                pb[t] = __builtin_bit_cast(bf16x8, w);
                            }
                        }
                        __builtin_amdgcn_sched_barrier(0);
                        lacc[0] = __builtin_amdgcn_mfma_f32_16x16x32_bf16(ones, pb[0], lacc[0], 0, 0, 0);
                        lacc[1] = __builtin_amdgcn_mfma_f32_16x16x32_bf16(ones, pb[1], lacc[1], 0, 0, 0);
#pragma unroll
                        for (int dt = 0; dt < 8; ++dt) {
                            u32x4 vv; vv.x = va[dt].x; vv.y = va[dt].y; vv.z = vb[dt].x; vv.w = vb[dt].y; const bf16x8 vf = __builtin_bit_cast(bf16x8, vv);
                            oacc[0][dt] = __builtin_amdgcn_mfma_f32_16x16x32_bf16(vf, pb[0], oacc[0][dt], 0, 0, 0);
                            oacc[1][dt] = __builtin_amdgcn_mfma_f32_16x16x32_bf16(vf, pb[1], oacc[1][dt], 0, 0, 0);
                        }
                    }
#pragma unroll
                    for (int t = 0; t < 2; ++t) {
                        const float l = lacc[t][0];
                        if (qok[t]) {
                            const size_t pair = (rowbase + qpos[t]) * HG + hl;
                            bf16_t* op = OPART + (pair * 4 + qslot[t]) * HD + fq * 4;
#pragma unroll
                            for (int dt = 0; dt < 8; ++dt) { u32x2 w; w.x = cvt_pk_bf16(oacc[t][dt][0], oacc[t][dt][1]); w.y = cvt_pk_bf16(oacc[t][dt][2], oacc[t][dt][3]); *(u32x2*)(op + dt * 16) = w; }
                            if (fq == 0) LPART[pair * 4 + qslot[t]] = l;
                        }
                    }
                }
            }
            SYNC(pb + 2);
        }
        if (IN(6 + 3 * NG) && (PH_MASK & 1024)) {
            int tid = threadIdx.x; asm volatile("" : "+v"(tid)); const int lane = tid & 63, wave = __builtin_amdgcn_readfirstlane(tid >> 6); (void)lane; (void)wave;
            { const int gc = NG - 1;
#pragma unroll 2
                for (int idx = bx * NTHREADS + tid; idx < M * HG * 16; idx += G * NTHREADS) {
                    const int pair = idx >> 4, ch = idx & 15, m = pair >> 2, hl = pair & 3;
                    const unsigned sel = SEL[(size_t)m * NH + gc * HG + hl];
                    const f32x4 lp = *(const f32x4*)(LPART + (size_t)pair * 4);
                    u32x4 pv[4];
#pragma unroll
                    for (int e = 0; e < 4; ++e) pv[e] = *(const u32x4*)(OPART + ((size_t)pair * 4 + e) * HD + ch * 8);
                    float o[8]; float l = lp.w;
                    o[0] = bf_lo(pv[3].x); o[1] = bf_hi(pv[3].x); o[2] = bf_lo(pv[3].y); o[3] = bf_hi(pv[3].y); o[4] = bf_lo(pv[3].z); o[5] = bf_hi(pv[3].z); o[6] = bf_lo(pv[3].w); o[7] = bf_hi(pv[3].w);
#pragma unroll
                    for (int e = 0; e < 3; ++e) { const bool ok = ((sel >> (8 * e)) & 0xffu) != 0xffu; const u32x4 v = pv[e];
                        l += ok ? lp[e] : 0.f;
                        o[0] += ok ? bf_lo(v.x) : 0.f; o[1] += ok ? bf_hi(v.x) : 0.f; o[2] += ok ? bf_lo(v.y) : 0.f; o[3] += ok ? bf_hi(v.y) : 0.f;
                        o[4] += ok ? bf_lo(v.z) : 0.f; o[5] += ok ? bf_hi(v.z) : 0.f; o[6] += ok ? bf_lo(v.w) : 0.f; o[7] += ok ? bf_hi(v.w) : 0.f; }
                    const float rl = 1.0f / l;
                    u32x4* ap = (u32x4*)(AT + (size_t)m * DI + gc * GW + hl * HD + ch * 8);
                    const u32x4 z = *ap;
                    u32x4 w; w.x = cvt_pk_bf16(o[0] * rl * bf_lo(z.x), o[1] * rl * bf_hi(z.x)); w.y = cvt_pk_bf16(o[2] * rl * bf_lo(z.y), o[3] * rl * bf_hi(z.y));
                    w.z = cvt_pk_bf16(o[4] * rl * bf_lo(z.z), o[5] * rl * bf_hi(z.z)); w.w = cvt_pk_bf16(o[6] * rl * bf_lo(z.w), o[7] * rl * bf_hi(z.w));
                    *ap = w;
                }
            }
        }
        SYNC(6 + 3 * NG);
        if (IN(7 + 3 * NG) && (PH_MASK & 2048)) {
            int tid = threadIdx.x; asm volatile("" : "+v"(tid)); const int lane = tid & 63, wave = __builtin_amdgcn_readfirstlane(tid >> 6); (void)lane; (void)wave;
            pg8::Gemm<DI, DI, DI> gm{AT, WOUT1}; pg8::StaticOrder S; S.init(M, D, G, bx);
            pg8::EpiRes E{out, out}; pg8::MapPlain<DI, DI> MP;
            pg8::gemm_phase(lds, gm, S, MP, E);
        }
    }
}

constexpr int NPHASES = 6 + 3 * NG + 2;

extern "C" void kernel_launch(void* const* d_in, const int* in_sizes, int n_in, void* d_out, int out_size, void* d_ws, size_t ws_size, hipStream_t stream) {
    static int grid = 0;
    if (grid == 0) {
        int dev = 0, cus = 0, per_cu = 0;
        hipGetDevice(&dev);
        hipDeviceGetAttribute(&cus, hipDeviceAttributeMultiprocessorCount, dev);
        hipFuncSetAttribute((const void*)mega_fwd, hipFuncAttributeMaxDynamicSharedMemorySize, LDS_BYTES);
        hipOccupancyMaxActiveBlocksPerMultiprocessor(&per_cu, (const void*)mega_fwd, NTHREADS, LDS_BYTES);
        if (per_cu < 1) { fprintf(stderr, "kernel_launch: occupancy query says %d blocks per CU\n", per_cu); per_cu = 1; }
        grid = cus;
        if (ws_size < WS_END) fprintf(stderr, "kernel_launch: workspace too small: %zu < %zu\n", ws_size, (size_t)WS_END);
    }
    hipMemsetAsync((char*)d_ws + WS_CTL, 0, CTL_BYTES, stream);
    Args a{};
    for (int i = 0; i < 11; ++i) a.in[i] = (const float*)d_in[i];
    a.out = (float*)d_out; a.ws = (unsigned char*)d_ws; a.pad = 0;
#if defined(MK_PER_PHASE)
    for (int ph = 0; ph < NPHASES; ++ph) { a.ph_lo = ph; a.ph_hi = ph + 1; a.coop = 0; hipLaunchKernelGGL(mega_fwd, dim3(grid), dim3(NTHREADS), LDS_BYTES, stream, a); }
#else
    a.ph_lo = 0; a.ph_hi = NPHASES; a.coop = 1;
    void* kargs[] = {&a};
    hipError_t e = hipLaunchCooperativeKernel((const void*)mega_fwd, dim3(grid), dim3(NTHREADS), kargs, LDS_BYTES, stream);
    if (e != hipSuccess) fprintf(stderr, "cooperative launch failed: %s (grid %d)\n", hipGetErrorString(e), grid);
#endif
}
```
